# Optimizing an MI355X kernel written in HIP

```python
import math
import jax
import jax.numpy as jnp
from jax import lax
import numpy as np

D_MODEL = 1024
BATCH = 4
SEQ = 8192
DEPTH = 2

N_EVEN = (DEPTH + 1) // 2
N_ODD = DEPTH // 2
HEAD_DIM = 64
NORM_EPS = 1e-6

LRU_WIDTH = D_MODEL // 2
LRU_BLOCKS = LRU_WIDTH // HEAD_DIM
LRU_BLOCK = LRU_WIDTH // LRU_BLOCKS
CONV_WIDTH = 4
LRU_C = 8.0
MOBA_HEADS = (D_MODEL // 2) // HEAD_DIM
MOBA_WIDTH = MOBA_HEADS * HEAD_DIM
MOBA_BLOCK = 256
MOBA_TOPK = 3
MOBA_QCHUNK = 32
EVEN_SPLITS = (LRU_WIDTH, LRU_WIDTH, MOBA_WIDTH, MOBA_WIDTH, MOBA_WIDTH, MOBA_WIDTH)
EVEN_IN = sum(EVEN_SPLITS)
EVEN_MIX = LRU_WIDTH + MOBA_WIDTH

SB_HEADS = (D_MODEL // 2) // HEAD_DIM
SB_WIDTH = SB_HEADS * HEAD_DIM
SB_QBLOCK = 128
S5_WIDTH = D_MODEL // 2
S5_GROUP = 16
S5_GROUPS = S5_WIDTH // S5_GROUP
S5_STATE = 64
ODD_SPLITS = (SB_WIDTH, SB_WIDTH, SB_WIDTH, SB_WIDTH, S5_WIDTH, S5_WIDTH)
ODD_IN = sum(ODD_SPLITS)
ODD_MIX = SB_WIDTH + S5_WIDTH

kernel_name = 'hybrid_rglru_moba_stickbreak_s5'


def split_points(sizes):
    return [int(s) for s in np.cumsum(sizes)[:-1]]


def rms_norm(x, gain):
    xf = x.astype(jnp.float32)
    y = xf * lax.rsqrt(jnp.mean(xf * xf, axis=-1, keepdims=True) + NORM_EPS)
    return (y * gain.astype(jnp.float32)).astype(x.dtype)


def ada_modulation(c, w, b):
    mod = jnp.einsum('bd,de->be', jax.nn.silu(c), w) + b
    shift, scale, gate = jnp.split(mod[:, None, :], 3, axis=-1)
    return shift, scale, gate


def to_heads(t, n_heads):
    b_, t_, _ = t.shape
    return t.reshape(b_, t_, n_heads, HEAD_DIM)


def from_heads(t):
    b_, h_, t_, d_ = t.shape
    return t.transpose(0, 2, 1, 3).reshape(b_, t_, h_ * d_)


def causal_depthwise_conv(x, w, b):
    ch = x.shape[-1]
    y = lax.conv_general_dilated(x, w[:, None, :].astype(x.dtype), window_strides=(1,),
                                 padding=[(CONV_WIDTH - 1, 0)],
                                 dimension_numbers=('NWC', 'WIO', 'NWC'),
                                 feature_group_count=ch)
    return y + b


def rg_lru(x, rg_w, rg_b, ig_w, ig_b, lam):
    b_, t_, w_ = x.shape
    xf = x.astype(jnp.float32)
    xg = xf.reshape(b_, t_, LRU_BLOCKS, LRU_BLOCK)
    r = jax.nn.sigmoid(jnp.einsum('btgi,gij->btgj', xg, rg_w.astype(jnp.float32)) + rg_b).reshape(b_, t_, w_)
    i = jax.nn.sigmoid(jnp.einsum('btgi,gij->btgj', xg, ig_w.astype(jnp.float32)) + ig_b).reshape(b_, t_, w_)
    log_a = -LRU_C * r * jax.nn.softplus(-lam.astype(jnp.float32))
    a = jnp.exp(log_a)
    inp = jnp.sqrt(-jnp.expm1(2.0 * log_a)) * (i * xf)

    def combine(left, right):
        a1, b1 = left
        a2, b2 = right
        return a1 * a2, a2 * b1 + b2

    _, h = lax.associative_scan(combine, (a, inp), axis=1)
    return h


def moba_attention(q, k, v):
    b_, h_, t_, d_ = q.shape
    nb = -(-t_ // MOBA_BLOCK)
    pad = nb * MOBA_BLOCK - t_
    kp = jnp.pad(k, ((0, 0), (0, 0), (0, pad), (0, 0))).reshape(b_, h_, nb, MOBA_BLOCK, d_)
    vp = jnp.pad(v, ((0, 0), (0, 0), (0, pad), (0, 0))).reshape(b_, h_, nb, MOBA_BLOCK, d_)
    k_mean = jnp.mean(kp, axis=3)
    q_blk = jnp.arange(t_) // MOBA_BLOCK
    gate = jnp.einsum('bhtd,bhnd->bhtn', q, k_mean)
    past = jnp.arange(nb)[None, :] < q_blk[:, None]
    gate = jnp.where(past, gate, -jnp.inf)
    topk = min(MOBA_TOPK, nb)
    _, sel = lax.top_k(gate, topk)
    sel_valid = sel < q_blk[:, None]
    nc = t_ // MOBA_QCHUNK
    scale = d_ ** -0.5
    gather = jax.vmap(jax.vmap(lambda blocks, idx: blocks[idx]))

    def chunk(a):
        return jnp.moveaxis(a.reshape((b_, h_, nc, MOBA_QCHUNK) + a.shape[3:]), 2, 0)

    def attend(args):
        ci, qc, selc, validc = args
        q0 = ci * MOBA_QCHUNK
        qpos = q0 + jnp.arange(MOBA_QCHUNK)
        own = q0 // MOBA_BLOCK
        ks = gather(kp, selc)
        vs = gather(vp, selc)
        s_sel = jnp.einsum('bhqd,bhqnkd->bhqnk', qc, ks) * scale
        s_sel = jnp.where(validc[..., None], s_sel, -jnp.inf).reshape(b_, h_, MOBA_QCHUNK, topk * MOBA_BLOCK)
        k_own = lax.dynamic_index_in_dim(kp, own, axis=2, keepdims=False)
        v_own = lax.dynamic_index_in_dim(vp, own, axis=2, keepdims=False)
        s_own = jnp.einsum('bhqd,bhkd->bhqk', qc, k_own) * scale
        kpos = own * MOBA_BLOCK + jnp.arange(MOBA_BLOCK)
        s_own = jnp.where(kpos[None, :] <= qpos[:, None], s_own, -jnp.inf)
        p = jax.nn.softmax(jnp.concatenate([s_sel, s_own], axis=-1), axis=-1)
        p_sel = p[..., :topk * MOBA_BLOCK].reshape(b_, h_, MOBA_QCHUNK, topk, MOBA_BLOCK)
        p_own = p[..., topk * MOBA_BLOCK:]
        return (jnp.einsum('bhqnk,bhqnkd->bhqd', p_sel, vs)
                + jnp.einsum('bhqk,bhkd->bhqd', p_own, v_own))

    out = lax.map(attend, (jnp.arange(nc), chunk(q), chunk(sel), chunk(sel_valid)))
    return jnp.moveaxis(out, 0, 2).reshape(b_, h_, t_, d_)


def stick_breaking_attention(q, k, v):
    t_ = q.shape[2]
    scale = q.shape[-1] ** -0.5
    outs = []
    for blk in range(t_ // SB_QBLOCK):
        q0 = blk * SB_QBLOCK
        end = q0 + SB_QBLOCK
        z = jnp.einsum('bhqd,bhkd->bhqk', q[:, :, q0:end], k[:, :, :end]) * scale
        qpos = q0 + jnp.arange(SB_QBLOCK)
        strict = jnp.arange(end)[None, :] < qpos[:, None]
        log_beta = jax.nn.log_sigmoid(z)
        log_keep = jnp.where(strict, jax.nn.log_sigmoid(-z), 0.0)
        later = lax.cumsum(log_keep, axis=3, reverse=True) - log_keep
        w = jnp.where(strict, jnp.exp(log_beta + later), 0.0)
        outs.append(jnp.einsum('bhqk,bhkd->bhqd', w, v[:, :, :end]))
    return jnp.concatenate(outs, axis=2)


def s5_ssm(u, lam_re, lam_im, log_step, b_re, b_im, c_re, c_im, d):
    f32 = jnp.float32
    lam_re = lam_re.astype(f32)
    lam_im = lam_im.astype(f32)
    step = jnp.exp(log_step.astype(f32))[:, None]
    decay = jnp.exp(lam_re * step)
    ab_re = decay * jnp.cos(lam_im * step)
    ab_im = decay * jnp.sin(lam_im * step)
    den = lam_re * lam_re + lam_im * lam_im
    f_re = ((ab_re - 1.0) * lam_re + ab_im * lam_im) / den
    f_im = (ab_im * lam_re - (ab_re - 1.0) * lam_im) / den
    b_re = b_re.astype(f32)
    b_im = b_im.astype(f32)
    bb_re = f_re[..., None] * b_re - f_im[..., None] * b_im
    bb_im = f_re[..., None] * b_im + f_im[..., None] * b_re
    bu_re = jnp.einsum('btgh,gph->btgp', u, bb_re)
    bu_im = jnp.einsum('btgh,gph->btgp', u, bb_im)
    t_ = u.shape[1]
    a_re = jnp.broadcast_to(ab_re[None, None], (1, t_) + ab_re.shape)
    a_im = jnp.broadcast_to(ab_im[None, None], (1, t_) + ab_im.shape)

    def combine(left, right):
        ar1, ai1, br1, bi1 = left
        ar2, ai2, br2, bi2 = right
        return (ar2 * ar1 - ai2 * ai1, ar2 * ai1 + ai2 * ar1,
                ar2 * br1 - ai2 * bi1 + br2, ar2 * bi1 + ai2 * br1 + bi2)

    _, _, x_re, x_im = lax.associative_scan(combine, (a_re, a_im, bu_re, bu_im), axis=1)
    y = (jnp.einsum('btgp,ghp->btgh', x_re, c_re.astype(f32))
         - jnp.einsum('btgp,ghp->btgh', x_im, c_im.astype(f32))
         + d.astype(f32) * u)
    return y


def even_layer(x, c, norm_g, ada_w, ada_b, w_in, conv_w, conv_b, rg_w, rg_b, ig_w, ig_b,
               lam, q_g, k_g, w_out):
    shift, scale, gate = ada_modulation(c, ada_w, ada_b)
    h = rms_norm(x, norm_g) * (1.0 + scale) + shift
    proj = jnp.einsum('btd,de->bte', h, w_in)
    x_lru, g_lru, q, k, v, g_att = jnp.split(proj, split_points(EVEN_SPLITS), axis=-1)
    xc = causal_depthwise_conv(x_lru, conv_w, conv_b)
    y_lru = rg_lru(xc, rg_w, rg_b, ig_w, ig_b, lam) * jax.nn.silu(g_lru.astype(jnp.float32))
    qh = rms_norm(to_heads(q, MOBA_HEADS), q_g).astype(jnp.float32).transpose(0, 2, 1, 3)
    kh = rms_norm(to_heads(k, MOBA_HEADS), k_g).astype(jnp.float32).transpose(0, 2, 1, 3)
    vh = to_heads(v, MOBA_HEADS).astype(jnp.float32).transpose(0, 2, 1, 3)
    y_att = from_heads(moba_attention(qh, kh, vh)) * jax.nn.silu(g_att.astype(jnp.float32))
    mix = jnp.concatenate([y_lru, y_att], axis=-1).astype(x.dtype)
    return x + gate * jnp.einsum('bte,ed->btd', mix, w_out)


def odd_layer(x, c, norm_g, ada_w, ada_b, w_in, q_g, k_g, lam_re, lam_im, log_step,
              b_re, b_im, c_re, c_im, d, glu_w, glu_b, w_out):
    b_, t_, _ = x.shape
    shift, scale, gate = ada_modulation(c, ada_w, ada_b)
    h = rms_norm(x, norm_g) * (1.0 + scale) + shift
    proj = jnp.einsum('btd,de->bte', h, w_in)
    q, k, v, g_sb, u, g_s5 = jnp.split(proj, split_points(ODD_SPLITS), axis=-1)
    qh = rms_norm(to_heads(q, SB_HEADS), q_g).astype(jnp.float32).transpose(0, 2, 1, 3)
    kh = rms_norm(to_heads(k, SB_HEADS), k_g).astype(jnp.float32).transpose(0, 2, 1, 3)
    vh = to_heads(v, SB_HEADS).astype(jnp.float32).transpose(0, 2, 1, 3)
    y_sb = from_heads(stick_breaking_attention(qh, kh, vh)) * jax.nn.silu(g_sb.astype(jnp.float32))
    ug = u.astype(jnp.float32).reshape(b_, t_, S5_GROUPS, S5_GROUP)
    y = s5_ssm(ug, lam_re, lam_im, log_step, b_re, b_im, c_re, c_im, d).reshape(b_, t_, S5_WIDTH)
    z = jnp.einsum('bte,ef->btf', y, glu_w.astype(jnp.float32)) + glu_b.astype(jnp.float32)
    z_val, z_gate = jnp.split(z, 2, axis=-1)
    y_s5 = z_val * jax.nn.sigmoid(z_gate) * jax.nn.silu(g_s5.astype(jnp.float32))
    mix = jnp.concatenate([y_sb, y_s5], axis=-1).astype(x.dtype)
    return x + gate * jnp.einsum('bte,ed->btd', mix, w_out)


def setup_inputs(seed: int = 0) -> dict:
    key = jax.random.key(seed)
    keys = iter(jax.random.split(key, 40))
    f32 = jnp.float32

    def nrm(shape, s):
        return jax.random.normal(next(keys), shape, f32) * s

    def gain(shape):
        return 1.0 + nrm(shape, 0.02)

    ne, no = N_EVEN, N_ODD
    x = nrm((BATCH, SEQ, D_MODEL), 1.0)
    c = nrm((BATCH, D_MODEL), 1.0)
    u_lru = jax.random.uniform(next(keys), (ne, LRU_WIDTH), f32, minval=0.9, maxval=0.999)
    a_lru = u_lru ** (1.0 / LRU_C)
    lam_im = (jnp.pi * jnp.arange(S5_STATE, dtype=f32))[None, None, :] + nrm((no, S5_GROUPS, S5_STATE), 0.01)
    return {
        'x': x,
        'c': c,
        'ev_norm': gain((ne, D_MODEL)),
        'ev_ada_w': nrm((ne, D_MODEL, 3 * D_MODEL), 0.5 * D_MODEL ** -0.5),
        'ev_ada_b': nrm((ne, 3 * D_MODEL), 0.02),
        'ev_w_in': nrm((ne, D_MODEL, EVEN_IN), D_MODEL ** -0.5),
        'ev_conv_w': nrm((ne, CONV_WIDTH, LRU_WIDTH), CONV_WIDTH ** -0.5),
        'ev_conv_b': nrm((ne, LRU_WIDTH), 0.02),
        'ev_rgate_w': nrm((ne, LRU_BLOCKS, LRU_BLOCK, LRU_BLOCK), LRU_BLOCK ** -0.5),
        'ev_rgate_b': nrm((ne, LRU_BLOCKS, LRU_BLOCK), 0.02),
        'ev_igate_w': nrm((ne, LRU_BLOCKS, LRU_BLOCK, LRU_BLOCK), LRU_BLOCK ** -0.5),
        'ev_igate_b': nrm((ne, LRU_BLOCKS, LRU_BLOCK), 0.02),
        'ev_lru_lambda': jnp.log(a_lru) - jnp.log1p(-a_lru),
        'ev_q_norm': gain((ne, HEAD_DIM)),
        'ev_k_norm': gain((ne, HEAD_DIM)),
        'ev_w_out': nrm((ne, EVEN_MIX, D_MODEL), EVEN_MIX ** -0.5),
        'od_norm': gain((no, D_MODEL)),
        'od_ada_w': nrm((no, D_MODEL, 3 * D_MODEL), 0.5 * D_MODEL ** -0.5),
        'od_ada_b': nrm((no, 3 * D_MODEL), 0.02),
        'od_w_in': nrm((no, D_MODEL, ODD_IN), D_MODEL ** -0.5),
        'od_q_norm': gain((no, HEAD_DIM)),
        'od_k_norm': gain((no, HEAD_DIM)),
        'od_s5_lambda_re': -0.5 + nrm((no, S5_GROUPS, S5_STATE), 0.01),
        'od_s5_lambda_im': lam_im,
        'od_s5_log_step': jax.random.uniform(next(keys), (no, S5_GROUPS), f32,
                                             minval=math.log(1e-3), maxval=math.log(1e-1)),
        'od_s5_b_re': nrm((no, S5_GROUPS, S5_STATE, S5_GROUP), (2 * S5_GROUP) ** -0.5),
        'od_s5_b_im': nrm((no, S5_GROUPS, S5_STATE, S5_GROUP), (2 * S5_GROUP) ** -0.5),
        'od_s5_c_re': nrm((no, S5_GROUPS, S5_GROUP, S5_STATE), S5_STATE ** -0.5),
        'od_s5_c_im': nrm((no, S5_GROUPS, S5_GROUP, S5_STATE), S5_STATE ** -0.5),
        'od_s5_d': nrm((no, S5_GROUPS, S5_GROUP), 1.0),
        'od_glu_w': nrm((no, S5_WIDTH, 2 * S5_WIDTH), S5_WIDTH ** -0.5),
        'od_glu_b': nrm((no, 2 * S5_WIDTH), 0.02),
        'od_w_out': nrm((no, ODD_MIX, D_MODEL), ODD_MIX ** -0.5),
    }


def reference(x, c, ev_norm, ev_ada_w, ev_ada_b, ev_w_in, ev_conv_w, ev_conv_b, ev_rgate_w,
              ev_rgate_b, ev_igate_w, ev_igate_b, ev_lru_lambda, ev_q_norm, ev_k_norm, ev_w_out,
              od_norm, od_ada_w, od_ada_b, od_w_in, od_q_norm, od_k_norm, od_s5_lambda_re,
              od_s5_lambda_im, od_s5_log_step, od_s5_b_re, od_s5_b_im, od_s5_c_re, od_s5_c_im,
              od_s5_d, od_glu_w, od_glu_b, od_w_out):
    for layer in range(DEPTH):
        i = layer // 2
        if layer % 2 == 0:
            x = even_layer(x, c, ev_norm[i], ev_ada_w[i], ev_ada_b[i], ev_w_in[i], ev_conv_w[i],
                           ev_conv_b[i], ev_rgate_w[i], ev_rgate_b[i], ev_igate_w[i], ev_igate_b[i],
                           ev_lru_lambda[i], ev_q_norm[i], ev_k_norm[i], ev_w_out[i])
        else:
            x = odd_layer(x, c, od_norm[i], od_ada_w[i], od_ada_b[i], od_w_in[i], od_q_norm[i],
                          od_k_norm[i], od_s5_lambda_re[i], od_s5_lambda_im[i], od_s5_log_step[i],
                          od_s5_b_re[i], od_s5_b_im[i], od_s5_c_re[i], od_s5_c_im[i], od_s5_d[i],
                          od_glu_w[i], od_glu_b[i], od_w_out[i])
    return x
```

```cpp
#include <hip/hip_runtime.h>
#include <hip/hip_cooperative_groups.h>
#include <cstdio>
#include <cstdint>
namespace cg = cooperative_groups;
namespace pg8 {
#define PG8_LAS __attribute__((address_space(3)))
typedef unsigned short bf16_t;
typedef short bf16x8 __attribute__((ext_vector_type(8)));
typedef float f32x4 __attribute__((ext_vector_type(4)));
typedef unsigned u32x4 __attribute__((ext_vector_type(4)));
constexpr int BM = 256, BK = 64, HALF = 128, HTB = HALF * BK * 2  , STAGE_BYTES = 8 * HTB, NXCD = 8, WGM = 8;

__host__ __device__ __forceinline__ int lds_byte(int r, int c) { const int st = (r >> 4) * 2 + (c >> 5), rr = r & 15, cc = c & 31, ob = rr * 64 + cc * 2; return st * 1024 + (ob ^ (((ob >> 9) & 1) << 5)); }
__host__ __device__ __forceinline__ void stage_rc(int b, int& R, int& C) { const int st = b / 1024, sb = b % 1024, swz = sb ^ (((sb >> 9) & 1) << 5); R = (st >> 1) * 16 + swz / 64; C = (st & 1) * 32 + (swz % 64) / 2; }
__host__ __device__ __forceinline__ int perm32(int rho) { const int n = rho >> 4, i = rho & 15; return 8 * (i >> 2) + 4 * n + (i & 3); }

struct Unit { int pm, pn; };
struct Gemm { const bf16_t* A; const bf16_t* Bt; int M, N, K; size_t bstride; };

struct StaticOrder {
    int nM, nN, nwg, G, c;
    __host__ __device__ void init(int M, int N, int G_, int c_) { nM = M / BM; nN = N / BM; nwg = nM * nN; G = G_; c = c_; }
    __host__ __device__ bool next(int i, Unit& u) const {
        const long L = (long)i * G + c; if (L >= nwg) return false;
        int wgid = (int)L; { const int q = nwg / NXCD, r = nwg % NXCD, xcd = wgid % NXCD, off = wgid / NXCD; wgid = (xcd < r ? xcd * (q + 1) : r * (q + 1) + (xcd - r) * q) + off; }
        const int nig = WGM * nN, gid = wgid / nig, fm = gid * WGM, gsz = (nM - fm) < WGM ? (nM - fm) : WGM;
        u.pm = fm + ((wgid % nig) % gsz); u.pn = (wgid % nig) / gsz; return true;
    }
    __device__ __forceinline__ void a_ready(const Unit&) const {}
    __device__ __forceinline__ void done(const Unit&) const {}
};

typedef __bf16 hwbf2 __attribute__((ext_vector_type(2)));
typedef float f32x2p __attribute__((ext_vector_type(2)));
__device__ __forceinline__ unsigned pk2f(float lo, float hi) { f32x2p v; v.x = lo; v.y = hi; return __builtin_bit_cast(unsigned, __builtin_convertvector(v, hwbf2)); }
__device__ __forceinline__ float bflo(unsigned w) { return __builtin_bit_cast(float, w << 16); }
__device__ __forceinline__ float bfhi(unsigned w) { return __builtin_bit_cast(float, w & 0xffff0000u); }
struct EpiStore {
    static constexpr bool PERM = true, AFTER_DRAIN = false;
    bf16_t* O; int ldc;
    __device__ __forceinline__ void operator()(const f32x4 (&acc)[2][2][4][2], const Unit& u, int wr, int wc, int fr, int fq) const {
        const int row0 = u.pm * BM + wr * 64 + fr, col0 = u.pn * BM + wc * 32 + 8 * fq;
#pragma unroll
        for (int ai = 0; ai < 2; ++ai)
#pragma unroll
            for (int m = 0; m < 4; ++m) { bf16_t* rowp = O + (size_t)(row0 + ai * HALF + m * 16) * ldc + col0;
#pragma unroll
                for (int bj = 0; bj < 2; ++bj) { const f32x4 v0 = acc[ai][bj][m][0], v1 = acc[ai][bj][m][1];
                    u32x4 w; w.x = pk2f(v0[0], v0[1]); w.y = pk2f(v0[2], v0[3]); w.z = pk2f(v1[0], v1[1]); w.w = pk2f(v1[2], v1[3]);
                    *(u32x4*)(rowp + bj * HALF) = w; } }
    }
};
struct EpiRes {
    static constexpr bool PERM = false, AFTER_DRAIN = false;
    const float* X; float* O; const float* gate;
    __device__ __forceinline__ void operator()(const f32x4 (&acc)[2][2][4][2], const Unit& u, int wr, int wc, int fr, int fq) const {
        const int row0 = u.pm * BM + wr * 64 + fr, col0 = u.pn * BM + wc * 32 + 4 * fq, b = (u.pm * BM) >> 13;
        f32x4 gv[2][2];
#pragma unroll
        for (int bj = 0; bj < 2; ++bj)
#pragma unroll
            for (int n = 0; n < 2; ++n) gv[bj][n] = *(const f32x4*)(gate + b * 3072 + col0 + bj * HALF + n * 16);
#pragma unroll
        for (int ai = 0; ai < 2; ++ai)
#pragma unroll
            for (int m = 0; m < 4; ++m) { const size_t ro = (size_t)(row0 + ai * HALF + m * 16) * 1024 + col0;
#pragma unroll
                for (int bj = 0; bj < 2; ++bj)
#pragma unroll
                    for (int n = 0; n < 2; ++n) { const size_t idx = ro + bj * HALF + n * 16; const f32x4 xv = *(const f32x4*)(X + idx); *(f32x4*)(O + idx) = xv + gv[bj][n] * acc[ai][bj][m][n]; } }
    }
};
struct EpiRes1 {
    static constexpr bool PERM = true, AFTER_DRAIN = false;
    const float* X; const float* gate; bf16_t* X1B; float* SS;
    __device__ __forceinline__ void operator()(const f32x4 (&acc)[2][2][4][2], const Unit& u, int wr, int wc, int fr, int fq) const {
        const int row0 = u.pm * BM + wr * 64 + fr, col0 = u.pn * BM + wc * 32 + 8 * fq, b = (u.pm * BM) >> 13;
        f32x4 gv[2][2];
#pragma unroll
        for (int bj = 0; bj < 2; ++bj)
#pragma unroll
            for (int n = 0; n < 2; ++n) gv[bj][n] = *(const f32x4*)(gate + b * 3072 + col0 + bj * HALF + n * 4);
#pragma unroll
        for (int ai = 0; ai < 2; ++ai)
#pragma unroll
        for (int mh = 0; mh < 2; ++mh) {
            f32x4 xv[2][2][2];
#pragma unroll
            for (int mm = 0; mm < 2; ++mm)
#pragma unroll
                for (int bj = 0; bj < 2; ++bj) { const size_t idx = (size_t)(row0 + ai * HALF + (2 * mh + mm) * 16) * 1024 + col0 + bj * HALF; xv[mm][bj][0] = *(const f32x4*)(X + idx); xv[mm][bj][1] = *(const f32x4*)(X + idx + 4); }
#pragma unroll
            for (int mm = 0; mm < 2; ++mm) { const int m = 2 * mh + mm; const int row = row0 + ai * HALF + m * 16; const size_t ro = (size_t)row * 1024 + col0; float s = 0.f;
#pragma unroll
                for (int bj = 0; bj < 2; ++bj) { const size_t idx = ro + bj * HALF;
                    const f32x4 y0 = xv[mm][bj][0] + gv[bj][0] * acc[ai][bj][m][0], y1 = xv[mm][bj][1] + gv[bj][1] * acc[ai][bj][m][1];
                    s += ((y0[0] * y0[0] + y0[1] * y0[1]) + (y0[2] * y0[2] + y0[3] * y0[3])) + ((y1[0] * y1[0] + y1[1] * y1[1]) + (y1[2] * y1[2] + y1[3] * y1[3]));
                    u32x4 w; w.x = pk2f(y0[0], y0[1]); w.y = pk2f(y0[2], y0[3]); w.z = pk2f(y1[0], y1[1]); w.w = pk2f(y1[2], y1[3]); *(u32x4*)(X1B + idx) = w; }
                s += __shfl_xor(s, 16); s += __shfl_xor(s, 32);
                if (fq == 0) __hip_atomic_fetch_add(SS + row, s, __ATOMIC_RELAXED, __HIP_MEMORY_SCOPE_AGENT); }
        }
    }
};
struct EpiRes2 {
    static constexpr bool PERM = true, AFTER_DRAIN = false;
    const bf16_t* X1B; float* O; const float* gate;
    __device__ __forceinline__ void operator()(const f32x4 (&acc)[2][2][4][2], const Unit& u, int wr, int wc, int fr, int fq) const {
        const int row0 = u.pm * BM + wr * 64 + fr, col0 = u.pn * BM + wc * 32 + 8 * fq, b = (u.pm * BM) >> 13;
        f32x4 gv[2][2];
#pragma unroll
        for (int bj = 0; bj < 2; ++bj)
#pragma unroll
            for (int n = 0; n < 2; ++n) gv[bj][n] = *(const f32x4*)(gate + b * 3072 + col0 + bj * HALF + n * 4);
#pragma unroll
        for (int ai = 0; ai < 2; ++ai) {
            u32x4 xw[4][2];
#pragma unroll
            for (int m = 0; m < 4; ++m)
#pragma unroll
                for (int bj = 0; bj < 2; ++bj) xw[m][bj] = *(const u32x4*)(X1B + (size_t)(row0 + ai * HALF + m * 16) * 1024 + col0 + bj * HALF);
#pragma unroll
            for (int m = 0; m < 4; ++m) { const size_t ro = (size_t)(row0 + ai * HALF + m * 16) * 1024 + col0;
#pragma unroll
                for (int bj = 0; bj < 2; ++bj) { const size_t idx = ro + bj * HALF; const u32x4 q = xw[m][bj];
                    f32x4 x0, x1; x0[0] = bflo(q.x); x0[1] = bfhi(q.x); x0[2] = bflo(q.y); x0[3] = bfhi(q.y); x1[0] = bflo(q.z); x1[1] = bfhi(q.z); x1[2] = bflo(q.w); x1[3] = bfhi(q.w);
                    *(f32x4*)(O + idx) = x0 + gv[bj][0] * acc[ai][bj][m][0]; *(f32x4*)(O + idx + 4) = x1 + gv[bj][1] * acc[ai][bj][m][1]; } }
        }
    }
};
struct EpiStoreN {
    static constexpr bool PERM = true, AFTER_DRAIN = false;
    bf16_t* O; int ldc; const float* SS; const float* shw;
    __device__ __forceinline__ void operator()(const f32x4 (&acc)[2][2][4][2], const Unit& u, int wr, int wc, int fr, int fq) const {
        const int row0 = u.pm * BM + wr * 64 + fr, col0 = u.pn * BM + wc * 32 + 8 * fq, b = (u.pm * BM) >> 13;
        f32x4 sw[2][2];
#pragma unroll
        for (int bj = 0; bj < 2; ++bj) { sw[bj][0] = *(const f32x4*)(shw + b * 3072 + col0 + bj * HALF); sw[bj][1] = *(const f32x4*)(shw + b * 3072 + col0 + bj * HALF + 4); }
        float ssv[2][4];
#pragma unroll
        for (int ai = 0; ai < 2; ++ai)
#pragma unroll
            for (int m = 0; m < 4; ++m) ssv[ai][m] = SS[row0 + ai * HALF + m * 16];
#pragma unroll
        for (int ai = 0; ai < 2; ++ai)
#pragma unroll
            for (int m = 0; m < 4; ++m) { const int row = row0 + ai * HALF + m * 16; bf16_t* rowp = O + (size_t)row * ldc + col0;
                const float rstd = __builtin_amdgcn_rsqf(ssv[ai][m] * (1.f / 1024.f) + 1e-6f);
#pragma unroll
                for (int bj = 0; bj < 2; ++bj) { const f32x4 v0 = acc[ai][bj][m][0] * rstd + sw[bj][0], v1 = acc[ai][bj][m][1] * rstd + sw[bj][1];
                    u32x4 w; w.x = pk2f(v0[0], v0[1]); w.y = pk2f(v0[2], v0[3]); w.z = pk2f(v1[0], v1[1]); w.w = pk2f(v1[2], v1[3]);
                    *(u32x4*)(rowp + bj * HALF) = w; } }
    }
};
struct EpiGlu {
    static constexpr bool PERM = true, AFTER_DRAIN = false;
    const float* bias; const bf16_t* proj; bf16_t* mix;
    __device__ __forceinline__ void operator()(const f32x4 (&acc)[2][2][4][2], const Unit& u, int wr, int wc, int fr, int fq) const {
        const int row0 = u.pm * BM + wr * 64 + fr, colv = u.pn * 128 + wc * 32 + 8 * fq;
        const f32x4 bv0 = *(const f32x4*)(bias + colv), bv1 = *(const f32x4*)(bias + colv + 4), bg0 = *(const f32x4*)(bias + 512 + colv), bg1 = *(const f32x4*)(bias + 512 + colv + 4);
        u32x4 gsv[2][4];
#pragma unroll
        for (int ai = 0; ai < 2; ++ai)
#pragma unroll
            for (int m = 0; m < 4; ++m) gsv[ai][m] = *(const u32x4*)(proj + (size_t)(row0 + ai * HALF + m * 16) * 3072 + 2560 + colv);
#pragma unroll
        for (int ai = 0; ai < 2; ++ai)
#pragma unroll
            for (int m = 0; m < 4; ++m) { const size_t row = (size_t)(row0 + ai * HALF + m * 16);
                const u32x4 gs = gsv[ai][m];
                const f32x4 va = acc[ai][0][m][0] + bv0, vb = acc[ai][0][m][1] + bv1, ga = acc[ai][1][m][0] + bg0, gb = acc[ai][1][m][1] + bg1;
                float y[8];
#pragma unroll
                for (int e = 0; e < 4; ++e) { const float g0 = (e & 1) ? bfhi(gs[e >> 1]) : bflo(gs[e >> 1]); const float g1 = (e & 1) ? bfhi(gs[2 + (e >> 1)]) : bflo(gs[2 + (e >> 1)]);
                    y[e] = va[e] * __builtin_amdgcn_rcpf(1.f + __expf(-ga[e])) * (g0 * __builtin_amdgcn_rcpf(1.f + __expf(-g0))); y[4 + e] = vb[e] * __builtin_amdgcn_rcpf(1.f + __expf(-gb[e])) * (g1 * __builtin_amdgcn_rcpf(1.f + __expf(-g1))); }
                u32x4 w; w.x = pk2f(y[0], y[1]); w.y = pk2f(y[2], y[3]); w.z = pk2f(y[4], y[5]); w.w = pk2f(y[6], y[7]);
                *(u32x4*)(mix + row * 1024 + 512 + colv) = w; }
    }
};
template <class Epi, class Sched, bool ALIGN_EPI = false, bool SP2 = false>
__device__ __forceinline__ void gemm_phase(PG8_LAS unsigned char* lds, const Gemm g, const Sched& S, const Epi& E) {
    int tid_ = threadIdx.x; asm volatile("" : "+v"(tid_));
    const int tid = tid_, wid = __builtin_amdgcn_readfirstlane(tid >> 6), lane = tid & 63, wr = wid >> 2, wc = wid & 3, fr = lane & 15, fq = lane >> 4;
    const int K = g.K, nt = K / BK;
    unsigned voffA[2], voffB[2];
#pragma unroll
    for (int i = 0; i < 2; ++i) { int R, C; stage_rc(tid * 16 + i * 8192, R, C); const int Rb = Epi::PERM ? ((R & ~31) + perm32(R & 31)) : R;
        voffA[i] = (unsigned)(R * K + C) * 2u; voffB[i] = (unsigned)(Rb * K + C) * 2u; }
    const size_t kstep = (size_t)(BK * 2);
    const size_t hstep = (size_t)HALF * K * 2;
    const size_t tstep = 2 * hstep;
    const unsigned ldsw = (unsigned)wid * 1024u;
    const int aoff = lds_byte(wr * 64 + fr, fq * 8), boff = lds_byte(wc * 32 + fr, fq * 8);
#define PG8_SA(b, h) (((b) * 2 + (h)) * HTB)
#define PG8_SB(b, h) ((4 + (b) * 2 + (h)) * HTB)
#define PG8_STAGE(bufoff, gbase, voff) do { _Pragma("unroll") for (int _i = 0; _i < 2; ++_i) \
        __builtin_amdgcn_global_load_lds((const unsigned*)((const char*)(gbase) + (voff)[_i]), (PG8_LAS unsigned*)(lds + (bufoff) + ldsw + _i * 8192), 16, 0, 0); } while (0)
#define PG8_LDA(dst, b, h) do { _Pragma("unroll") for (int m = 0; m < 4; ++m) _Pragma("unroll") for (int k = 0; k < 2; ++k) dst[m][k] = *(const PG8_LAS bf16x8*)(lds + PG8_SA(b, h) + aoff + m * 2048 + k * 1024); } while (0)
#define PG8_LDB(dst, b, h) do { _Pragma("unroll") for (int n = 0; n < 2; ++n) _Pragma("unroll") for (int k = 0; k < 2; ++k) dst[n][k] = *(const PG8_LAS bf16x8*)(lds + PG8_SB(b, h) + boff + n * 2048 + k * 1024); } while (0)
#define PG8_MMA(ai, bj, At, Bt) do { __builtin_amdgcn_s_setprio(1); _Pragma("unroll") for (int m = 0; m < 4; ++m) _Pragma("unroll") for (int n = 0; n < 2; ++n) _Pragma("unroll") for (int k = 0; k < 2; ++k) \
        acc[ai][bj][m][n] = __builtin_amdgcn_mfma_f32_16x16x32_bf16(Bt[n][k], At[m][k], acc[ai][bj][m][n], 0, 0, 0); __builtin_amdgcn_s_setprio(0); } while (0)
#define PG8_WAIT_V(n) asm volatile("s_waitcnt vmcnt(" #n ")" ::: "memory")
#define PG8_WAIT_L(n) asm volatile("s_waitcnt lgkmcnt(" #n ")" ::: "memory")
#define PG8_BAR __builtin_amdgcn_s_barrier()
#define PG8_SCHED __builtin_amdgcn_sched_barrier(0)
    Unit cur, nxt; int ui = 0;
    if (!S.next(0, cur)) return;
    f32x4 acc[2][2][4][2];
#pragma unroll
    for (int a = 0; a < 2; ++a)
#pragma unroll
        for (int b = 0; b < 2; ++b)
#pragma unroll
            for (int m = 0; m < 4; ++m)
#pragma unroll
                for (int n = 0; n < 2; ++n) acc[a][b][m][n] = (f32x4){0.f, 0.f, 0.f, 0.f};
    bf16x8 At[4][2], B0[2][2], B1[2][2];
    const char* cA = (const char*)g.A + (size_t)cur.pm * tstep; const char* cB = (const char*)g.Bt + (size_t)cur.pn * tstep + (size_t)(cur.pm >> 5) * g.bstride;
    S.a_ready(cur);
    if constexpr (SP2) {
        PG8_STAGE(PG8_SB(0, 0), cB, voffB); PG8_STAGE(PG8_SB(0, 1), cB + hstep, voffB); PG8_STAGE(PG8_SA(0, 0), cA, voffA); PG8_STAGE(PG8_SA(0, 1), cA + hstep, voffA);
        if (wr == 1) PG8_BAR;
        PG8_WAIT_V(2); PG8_BAR;
        PG8_STAGE(PG8_SB(1, 0), cB + kstep, voffB); PG8_STAGE(PG8_SA(1, 0), cA + kstep, voffA); PG8_STAGE(PG8_SB(1, 1), cB + hstep + kstep, voffB);
        PG8_WAIT_V(6); PG8_BAR;
    } else {
        PG8_STAGE(PG8_SB(0, 0), cB, voffB); PG8_STAGE(PG8_SA(0, 0), cA, voffA); PG8_STAGE(PG8_SB(0, 1), cB + hstep, voffB); PG8_STAGE(PG8_SA(0, 1), cA + hstep, voffA);
        if (wr == 1) PG8_BAR;
        PG8_WAIT_V(4); PG8_BAR;
        PG8_STAGE(PG8_SB(1, 0), cB + kstep, voffB); PG8_STAGE(PG8_SA(1, 0), cA + kstep, voffA); PG8_STAGE(PG8_SB(1, 1), cB + hstep + kstep, voffB);
        PG8_WAIT_V(6); PG8_BAR;
    }
    for (;;) {
        const bool has_next = S.next(ui + 1, nxt);
        const char* nA = has_next ? (const char*)g.A + (size_t)nxt.pm * tstep : cA; const char* nB = has_next ? (const char*)g.Bt + (size_t)nxt.pn * tstep + (size_t)(nxt.pm >> 5) * g.bstride : cB;
        for (int t = 0; t < nt; t += 2) {
            const bool last = (t == nt - 2);
            const char* a1 = cA + (size_t)(t + 1) * kstep;
            const char* a2 = last ? nA : cA + (size_t)(t + 2) * kstep; const char* b2 = last ? nB : cB + (size_t)(t + 2) * kstep;
            const char* a3 = a2 + kstep; const char* b3 = b2 + kstep;
            if (last && has_next) S.a_ready(nxt);
            if constexpr (SP2) {
            PG8_LDB(B0, 0, 0); PG8_LDB(B1, 0, 1); PG8_SCHED; PG8_LDA(At, 0, 0); PG8_STAGE(PG8_SA(1, 1), a1 + hstep, voffA);
            PG8_WAIT_V(8); PG8_WAIT_L(0); PG8_BAR; PG8_MMA(0, 0, At, B0); PG8_MMA(0, 1, At, B1); PG8_BAR; PG8_SCHED;
            PG8_LDA(At, 0, 1); PG8_STAGE(PG8_SB(0, 0), b2, voffB); PG8_STAGE(PG8_SB(0, 1), b2 + hstep, voffB); PG8_STAGE(PG8_SA(0, 0), a2, voffA);
            PG8_WAIT_V(8); PG8_WAIT_L(0); PG8_BAR; PG8_MMA(1, 0, At, B0); PG8_MMA(1, 1, At, B1); PG8_BAR; PG8_SCHED;
            PG8_LDB(B0, 1, 0); PG8_LDB(B1, 1, 1); PG8_SCHED; PG8_LDA(At, 1, 0); PG8_STAGE(PG8_SA(0, 1), a2 + hstep, voffA);
            PG8_WAIT_V(8); PG8_WAIT_L(0); PG8_BAR; PG8_MMA(0, 0, At, B0); PG8_MMA(0, 1, At, B1); PG8_BAR; PG8_SCHED;
            PG8_LDA(At, 1, 1); PG8_STAGE(PG8_SB(1, 0), b3, voffB); PG8_STAGE(PG8_SB(1, 1), b3 + hstep, voffB); PG8_STAGE(PG8_SA(1, 0), a3, voffA);
            PG8_WAIT_V(8); PG8_WAIT_L(0); PG8_BAR; PG8_MMA(1, 0, At, B0); PG8_MMA(1, 1, At, B1); PG8_BAR; PG8_SCHED;
            } else {
            PG8_LDB(B0, 0, 0); PG8_SCHED; PG8_LDA(At, 0, 0); PG8_STAGE(PG8_SA(1, 1), a1 + hstep, voffA);
            PG8_WAIT_L(8); PG8_BAR; PG8_WAIT_L(0); PG8_MMA(0, 0, At, B0); PG8_BAR; PG8_SCHED;
            PG8_LDB(B1, 0, 1); PG8_STAGE(PG8_SB(0, 0), b2, voffB);
            PG8_BAR; PG8_WAIT_L(0); PG8_MMA(0, 1, At, B1); PG8_BAR;
            PG8_LDA(At, 0, 1); PG8_STAGE(PG8_SA(0, 0), a2, voffA);
            PG8_BAR; PG8_WAIT_L(0); PG8_MMA(1, 0, At, B0); PG8_BAR; PG8_SCHED;
            PG8_STAGE(PG8_SB(0, 1), b2 + hstep, voffB);
            PG8_WAIT_V(6); PG8_BAR; PG8_MMA(1, 1, At, B1); PG8_BAR;
            PG8_LDB(B0, 1, 0); PG8_SCHED; PG8_LDA(At, 1, 0); PG8_STAGE(PG8_SA(0, 1), a2 + hstep, voffA);
            PG8_WAIT_L(8); PG8_BAR; PG8_WAIT_L(0); PG8_MMA(0, 0, At, B0); PG8_BAR; PG8_SCHED;
            PG8_LDB(B1, 1, 1); PG8_STAGE(PG8_SB(1, 0), b3, voffB);
            PG8_BAR; PG8_WAIT_L(0); PG8_MMA(0, 1, At, B1); PG8_BAR;
            PG8_LDA(At, 1, 1); PG8_STAGE(PG8_SA(1, 0), a3, voffA);
            PG8_BAR; PG8_WAIT_L(0); PG8_MMA(1, 0, At, B0); PG8_BAR; PG8_SCHED;
            PG8_STAGE(PG8_SB(1, 1), b3 + hstep, voffB);
            PG8_WAIT_V(6); PG8_BAR; PG8_MMA(1, 1, At, B1); PG8_BAR;
            }
        }
        if constexpr (ALIGN_EPI) { if (wr == 0) PG8_BAR; }
        if constexpr (!Epi::AFTER_DRAIN) { E(acc, cur, wr, wc, fr, fq); S.done(cur); }
        if (!has_next) break;
#pragma unroll
        for (int a = 0; a < 2; ++a)
#pragma unroll
            for (int b = 0; b < 2; ++b)
#pragma unroll
                for (int m = 0; m < 4; ++m)
#pragma unroll
                    for (int n = 0; n < 2; ++n) acc[a][b][m][n] = (f32x4){0.f, 0.f, 0.f, 0.f};
        cur = nxt; cA = nA; cB = nB; ++ui;
        if constexpr (ALIGN_EPI) { if (wr == 1) PG8_BAR; }
    }
    PG8_WAIT_V(0);
    if constexpr (!ALIGN_EPI) { if (wr == 0) PG8_BAR; }
    PG8_BAR;
    if constexpr (Epi::AFTER_DRAIN) { E.fused(acc, cur, wr, wc, fr, fq, lds, wid, lane); S.done(cur); }
#undef PG8_SA
#undef PG8_SB
#undef PG8_STAGE
#undef PG8_LDA
#undef PG8_LDB
#undef PG8_MMA
#undef PG8_WAIT_V
#undef PG8_WAIT_L
#undef PG8_BAR
#undef PG8_SCHED
}
}
#define DI __device__ __forceinline__
#define LAS __attribute__((address_space(3)))
typedef unsigned short bf16;
typedef short bf16x8 __attribute__((ext_vector_type(8)));
typedef float f32x4 __attribute__((ext_vector_type(4)));
typedef float f32x2 __attribute__((ext_vector_type(2)));
typedef float f32x16 __attribute__((ext_vector_type(16)));
typedef unsigned u32x4 __attribute__((ext_vector_type(4)));
typedef unsigned u32x2 __attribute__((ext_vector_type(2)));
#define MFMA32(a, b, c) __builtin_amdgcn_mfma_f32_32x32x16_bf16((a), (b), (c), 0, 0, 0)

constexpr int NB = 4, T = 8192, D = 1024, M = NB * T, NP = 3072;
constexpr int NWAVES = 8, NTHR = 512;
constexpr int LDS_BYTES = 155648;
constexpr size_t MiB = 1u << 20;
constexpr size_t WS_MOD = 1 * MiB;
constexpr size_t WS_SS = 128 * 1024;
constexpr size_t WS_SHW = 1 * MiB + 256 * 1024;
constexpr size_t WS_GW = 1 * MiB + 512 * 1024;
constexpr size_t WS_ABL = 2 * MiB;
constexpr size_t WS_BB = 2 * MiB + 65536;
constexpr size_t WS_PW = 3 * MiB;
constexpr size_t WS_F = 5 * MiB;
constexpr size_t WS_VBIG = 8 * MiB;
constexpr size_t WS_WBIG = 16 * MiB;
constexpr size_t WS_WIN0 = 24 * MiB, WS_WOUT0 = 30 * MiB, WS_WIN1 = 32 * MiB, WS_WGLU = 38 * MiB, WS_WOUT1 = 39 * MiB;
constexpr size_t WS_KMEAN = 41 * MiB;
constexpr size_t WS_LRUSUM = 42 * MiB;
constexpr size_t WS_S5S = 44 * MiB;
constexpr size_t WS_VT = 52 * MiB;
constexpr size_t WS_H = 84 * MiB;
constexpr size_t WS_MIX = 148 * MiB;
constexpr size_t WS_PROJ = 212 * MiB;
constexpr size_t WS_KF = 404 * MiB;
constexpr size_t WS_X1B = 436 * MiB;
constexpr size_t WS_W1S = 116 * MiB;
constexpr size_t WS_END = 500 * MiB;

struct Args { const float* in[33]; float* out; unsigned char* ws; };

DI unsigned f2bf(float f) { unsigned u = __builtin_bit_cast(unsigned, f); return (u + 0x7fffu + ((u >> 16) & 1u)) >> 16; }
DI unsigned pk2(float lo, float hi) { return pg8::pk2f(lo, hi); }
DI float bf2f(unsigned short b) { return __builtin_bit_cast(float, (unsigned)b << 16); }
DI float bflo(unsigned w) { return __builtin_bit_cast(float, w << 16); }
DI float bfhi(unsigned w) { return __builtin_bit_cast(float, w & 0xffff0000u); }
DI int crow(int reg, int h) { return (reg & 3) + 8 * (reg >> 2) + 4 * h; }
DI float sigm(float x) { return __builtin_amdgcn_rcpf(1.f + __expf(-x)); }
DI float silu(float x) { return x * __builtin_amdgcn_rcpf(1.f + __expf(-x)); }
DI bf16x8 mk8(u32x4 v) { return __builtin_bit_cast(bf16x8, v); }
DI bf16x8 pack8(float a0, float a1, float a2, float a3, float a4, float a5, float a6, float a7) { u32x4 v; v.x = pk2(a0, a1); v.y = pk2(a2, a3); v.z = pk2(a4, a5); v.w = pk2(a6, a7); return __builtin_bit_cast(bf16x8, v); }
DI f32x16 zero16() { f32x16 z;
#pragma unroll
  for (int i = 0; i < 16; ++i) z[i] = 0.f; return z; }

#define XB_TMO      128
#define XB_XCNT(j)  (256  + 64 * (j))
#define XB_XSUB(j)  (1280 + 64 * (j))
#define XB_XGEN(j)  (2304 + 64 * (j))
#define XB_TOP      3328
#define XB_TOPGEN   3392
#define XCD_BAR_WORDS 3456
#define XB_SPIN_CAP (1u << 18)

__device__ __forceinline__ unsigned xb_ld(unsigned* p)              { return __hip_atomic_load(p, __ATOMIC_RELAXED, __HIP_MEMORY_SCOPE_AGENT); }
__device__ __forceinline__ unsigned xb_add(unsigned* p, unsigned v) { return __hip_atomic_fetch_add(p, v, __ATOMIC_RELAXED, __HIP_MEMORY_SCOPE_AGENT); }
__device__ __forceinline__ unsigned xb_xcc_id() { return (unsigned)__builtin_amdgcn_s_getreg((3 << 11) | 20) & 0xFu; }
#define XB_SPIN(cond, bar) do { unsigned _sp = 0; while (cond) { __builtin_amdgcn_s_sleep(1); \
    if ((++_sp & 255u) == 0u) { if (xb_ld(&(bar)[XB_TMO])) break; if (_sp > XB_SPIN_CAP) { atomicAdd(&(bar)[XB_TMO], 1u); break; } } } } while (0)

struct XcdBarrier {
    unsigned* bar; unsigned x;
    volatile LAS unsigned* st;
};

__device__ __forceinline__ XcdBarrier xcd_barrier_post(unsigned* bar, volatile LAS unsigned* st) {
    XcdBarrier b; b.bar = bar; b.x = xb_xcc_id(); b.st = st;
    if (threadIdx.x == 0) (void)xb_add(&bar[XB_XCNT(b.x)], 1u);
    return b;
}
__device__ __forceinline__ void xcd_barrier_complete(unsigned* bar, unsigned x, unsigned& nloc, unsigned& nx) {
    const unsigned G = gridDim.x * gridDim.y * gridDim.z;
    unsigned sum, cnt, mine, sp = 0u;
    for (;;) {
        sum = 0u; cnt = 0u; mine = 0u;
#pragma unroll
        for (unsigned j = 0; j < 16; ++j) { const unsigned c = xb_ld(&bar[XB_XCNT(j)]); sum += c; cnt += (c > 0u) ? 1u : 0u; mine = (j == x) ? c : mine; }
        if (sum == G) break;
        __builtin_amdgcn_s_sleep(1);
        if ((++sp & 255u) == 0u) { if (xb_ld(&bar[XB_TMO])) break; if (sp > XB_SPIN_CAP) { atomicAdd(&bar[XB_TMO], 1u); break; } }
    }
    nloc = mine > 0u ? mine : 1u; nx = cnt > 0u ? cnt : 1u;
}

__device__ __forceinline__ void xcd_barrier(const XcdBarrier& b) {
    asm volatile("s_waitcnt vmcnt(0)" ::: "memory");
    __syncthreads();
    if (threadIdx.x == 0) {
        unsigned* bar = b.bar;
        __builtin_amdgcn_s_waitcnt(0);
        unsigned nloc = b.st[0], nx = b.st[1];
        if (nloc == 0u) { xcd_barrier_complete(bar, b.x, nloc, nx); b.st[0] = nloc; b.st[1] = nx; }
        const unsigned old = xb_add(&bar[XB_XSUB(b.x)], 1u);
        const unsigned gen = old / nloc;
        if (old + 1u == (gen + 1u) * nloc) {
            __builtin_amdgcn_fence(__ATOMIC_RELEASE, "agent");
            asm volatile("s_waitcnt vmcnt(0)" ::: "memory");
            const unsigned og = xb_add(&bar[XB_TOP], 1u);
            const unsigned tg = og / nx;
            if (og + 1u == (tg + 1u) * nx) xb_add(&bar[XB_TOPGEN], 1u);
            else XB_SPIN(xb_ld(&bar[XB_TOPGEN]) == tg, bar);
            __builtin_amdgcn_fence(__ATOMIC_ACQUIRE, "agent");
            xb_add(&bar[XB_XGEN(b.x)], 1u);
            asm volatile("s_waitcnt vmcnt(0)" ::: "memory");
        } else {
            XB_SPIN(xb_ld(&bar[XB_XGEN(b.x)]) == gen, bar);
            __builtin_amdgcn_fence(__ATOMIC_ACQUIRE, "agent");
            asm volatile("s_waitcnt vmcnt(0)" ::: "memory");
        }
    }
    __syncthreads();
}

DI void transpose_item(const float* W, int K, int N, bf16* WT, int dst_row0, LAS float* scr, int kb, int nb, int lane) {
    const int k0 = 64 * kb, n0 = 32 * nb;
#pragma unroll 8
    for (int i = 0; i < 32; ++i) { const int kk = 2 * i + (lane >> 5); scr[kk * 33 + (lane & 31)] = W[(size_t)(k0 + kk) * N + n0 + (lane & 31)]; }
    asm volatile("s_waitcnt lgkmcnt(0)" ::: "memory");
    const int c = lane & 7;
#pragma unroll
    for (int j = 0; j < 4; ++j) { const int n = (lane >> 3) + 8 * j; const LAS float* s = scr + (8 * c) * 33 + n;
        u32x4 o; o.x = pk2(s[0 * 33], s[1 * 33]); o.y = pk2(s[2 * 33], s[3 * 33]); o.z = pk2(s[4 * 33], s[5 * 33]); o.w = pk2(s[6 * 33], s[7 * 33]);
        *(u32x4*)(WT + (size_t)(dst_row0 + n) * K + k0 + 8 * c) = o; }
    asm volatile("s_waitcnt lgkmcnt(0)" ::: "memory");
}

DI void phase0(const Args& a, LAS unsigned char* lds, int tid, int lane, int wave) {
    unsigned char* ws = a.ws;
    const int bx = blockIdx.x;
    if (bx < 192) {
        const int layer = bx / 96, cc = bx % 96, l31 = lane & 31, hh = lane >> 5, col = 32 * cc + l31;
        const float* W = layer ? a.in[17] : a.in[3]; const float* cv = a.in[1];
        LAS float* SC = (LAS float*)lds;
        LAS float* red = (LAS float*)(lds + 16384);
        for (int i = tid; i < 4096; i += NTHR) SC[i] = silu(cv[i]);
        __syncthreads();
        float a0 = 0.f, a1 = 0.f, a2 = 0.f, a3 = 0.f;
        const float* wp = W + (size_t)(128 * wave + hh) * 3072 + col;
#pragma unroll 1
        for (int i0 = 0; i0 < 64; i0 += 16) { float wv[16];
#pragma unroll
            for (int i = 0; i < 16; ++i) wv[i] = wp[(size_t)(2 * (i0 + i)) * 3072];
#pragma unroll
            for (int i = 0; i < 16; ++i) { const int k = 128 * wave + 2 * (i0 + i) + hh; a0 += SC[k] * wv[i]; a1 += SC[1024 + k] * wv[i]; a2 += SC[2048 + k] * wv[i]; a3 += SC[3072 + k] * wv[i]; } }
        a0 += __shfl_xor(a0, 32); a1 += __shfl_xor(a1, 32); a2 += __shfl_xor(a2, 32); a3 += __shfl_xor(a3, 32);
        if (hh == 0) { red[(wave * 4 + 0) * 32 + l31] = a0; red[(wave * 4 + 1) * 32 + l31] = a1; red[(wave * 4 + 2) * 32 + l31] = a2; red[(wave * 4 + 3) * 32 + l31] = a3; }
        __syncthreads();
        if (tid < 128) { const int b = tid >> 5, l = tid & 31; float s = 0.f;
#pragma unroll
            for (int w = 0; w < 8; ++w) s += red[(w * 4 + b) * 32 + l];
            const float* bias = layer ? a.in[18] : a.in[4];
            ((float*)(ws + WS_MOD))[(layer * 4 + b) * 3072 + 32 * cc + l] = s + bias[32 * cc + l]; }
        __syncthreads();
    } else if (bx < 196) {
        const int gp = (bx - 192) * 512 + tid, g = gp >> 6;
        const float step = __expf(a.in[24][g]);
        const float lr = a.in[22][gp], li = a.in[23][gp];
        const float decay = __expf(lr * step);
        float rev = li * step * 0.15915494309189535f; rev -= floorf(rev);
        const float abr = decay * __builtin_amdgcn_cosf(rev), abi = decay * __builtin_amdgcn_sinf(rev);
        const float den = lr * lr + li * li;
        const float fr = ((abr - 1.f) * lr + abi * li) / den, fi = (abi * lr - (abr - 1.f) * li) / den;
        float* BB = (float*)(ws + WS_BB) + (size_t)gp * 32;
#pragma unroll
        for (int h = 0; h < 16; ++h) { const float br = a.in[25][gp * 16 + h], bi = a.in[26][gp * 16 + h]; BB[2 * h] = fr * br - fi * bi; BB[2 * h + 1] = fr * bi + fi * br; }
        float* PW = (float*)(ws + WS_PW) + ((size_t)g * 65 * 64 + (gp & 63)) * 2;
        float pr = 1.f, pi = 0.f;
        for (int t = 0; t < 64; ++t) { PW[(size_t)t * 128] = pr; PW[(size_t)t * 128 + 1] = pi; const float nr = pr * abr - pi * abi, ni = pr * abi + pi * abr; pr = nr; pi = ni; }
        PW[(size_t)64 * 128] = pr; PW[(size_t)64 * 128 + 1] = pi;
        float* ABL = (float*)(ws + WS_ABL) + gp * 2; ABL[0] = pr; ABL[1] = pi;
    }
    if (bx == 200 && tid == 0) { float gq = 0.f, gk = 0.f;
        for (int i = 0; i < 64; ++i) { gq = fmaxf(gq, fabsf(a.in[13][i])); gk = fmaxf(gk, fabsf(a.in[14][i])); }
        ((float*)(ws + WS_MOD))[2 * 4 * 3072] = 8.f * gq * gk; }
    if (bx >= 201 && bx < 217) {
        const int v = (bx - 201) * 512 + tid, ln = v & 63, s = (v >> 6) & 3, ct = (v >> 8) & 1, g = (v >> 9) & 7, gate = v >> 12, l31 = ln & 31, hh = ln >> 5;
        const float* wsrc = (gate ? a.in[10] : a.in[8]) + (size_t)g * 4096 + (16 * s + 8 * hh) * 64 + 32 * ct + l31;
        u32x4 o; o.x = pk2(wsrc[0], wsrc[64]); o.y = pk2(wsrc[128], wsrc[192]); o.z = pk2(wsrc[256], wsrc[320]); o.w = pk2(wsrc[384], wsrc[448]);
        *(u32x4*)(ws + WS_GW + (size_t)v * 16) = o; }
    LAS float* scr = (LAS float*)(lds + 16384 + wave * 8704);
    const int gw = bx * NWAVES + wave, NGW = gridDim.x * NWAVES;
    constexpr int I0 = 16 * 96, I1 = 16 * 32, I2 = 16 * 96, I3 = 8 * 32, I4 = 16 * 32;
    for (int it = gw; it < I0 + I1 + I2 + I3 + I4; it += NGW) {
        int r = it;
        if (r < I0) { transpose_item(a.in[5], 1024, 3072, (bf16*)(ws + WS_WIN0), 32 * (r % 96), scr, r / 96, r % 96, lane); continue; } r -= I0;
        if (r < I1) { transpose_item(a.in[15], 1024, 1024, (bf16*)(ws + WS_WOUT0), 32 * (r % 32), scr, r / 32, r % 32, lane); continue; } r -= I1;
        if (r < I2) { transpose_item(a.in[19], 1024, 3072, (bf16*)(ws + WS_WIN1), 32 * (r % 96), scr, r / 96, r % 96, lane); continue; } r -= I2;
        if (r < I3) { const int nb = r % 32, n0 = 32 * nb; const int nn = n0 & 511; const int dst = 256 * (nn >> 7) + (n0 >= 512 ? 128 : 0) + (nn & 127);
            transpose_item(a.in[30], 512, 1024, (bf16*)(ws + WS_WGLU), dst, scr, r / 32, nb, lane); continue; } r -= I3;
        transpose_item(a.in[32], 1024, 1024, (bf16*)(ws + WS_WOUT1), 32 * (r % 32), scr, r / 32, r % 32, lane);
    }
}

DI float wave_sum(float v) {
#pragma unroll
    for (int o = 1; o < 64; o <<= 1) v += __shfl_xor(v, o);
    return v;
}
DI void norm_rows(const float* xin, const float* gain, const float* modl, bf16* H, int gw, int NGW, int lane) {
    f32x4 gs[4], sh[4]; int curb = -1;
    for (int m = gw; m < M; m += NGW) {
        const f32x4* xr = (const f32x4*)(xin + (size_t)m * D) + lane;
        f32x4 v[4]; float s = 0.f;
#pragma unroll
        for (int j = 0; j < 4; ++j) v[j] = xr[64 * j];
        const int b = m >> 13;
        if (b != curb) { curb = b; const float* mb = modl + b * 3072;
#pragma unroll
            for (int j = 0; j < 4; ++j) { const int c = 4 * lane + 256 * j; gs[j] = *(const f32x4*)(gain + c) * (*(const f32x4*)(mb + 1024 + c) + 1.f); sh[j] = *(const f32x4*)(mb + c); } }
#pragma unroll
        for (int j = 0; j < 4; ++j) s += (v[j].x * v[j].x + v[j].y * v[j].y) + (v[j].z * v[j].z + v[j].w * v[j].w);
        const float rstd = rsqrtf(wave_sum(s) * (1.f / D) + 1e-6f);
        unsigned long long* o8 = (unsigned long long*)(H + (size_t)m * D) + lane;
#pragma unroll
        for (int j = 0; j < 4; ++j) { const f32x4 y = v[j] * rstd * gs[j] + sh[j];
            o8[64 * j] = (unsigned long long)pk2(y.x, y.y) | ((unsigned long long)pk2(y.z, y.w) << 32); }
    }
}

DI void s5_tables(const Args& a, LAS unsigned char* lds, int gt, int NT) {
    unsigned char* ws = a.ws;
    const float* PW = (const float*)(ws + WS_PW); const float* BB = (const float*)(ws + WS_BB);
    const float* cre = a.in[27]; const float* cim = a.in[28]; const float* dd = a.in[29];
    const bool staged = (NT == 32 * 64 * 16 * 4);
    LAS float* LB = (LAS float*)lds; LAS float* LP = LB + 2048; LAS float* LC = LP + 1024; LAS float* LI = LC + 1024;
    if (staged) { const int g = blockIdx.x >> 3, tau0 = (8 * blockIdx.x) & 63; const int t = threadIdx.x;
#pragma unroll
        for (int i = 0; i < 4; ++i) LB[t + 512 * i] = BB[(size_t)g * 2048 + t + 512 * i];
#pragma unroll
        for (int i = 0; i < 2; ++i) { LP[t + 512 * i] = PW[((size_t)(g * 65 + tau0) * 64) * 2 + t + 512 * i]; LC[t + 512 * i] = cre[g * 1024 + t + 512 * i]; LI[t + 512 * i] = cim[g * 1024 + t + 512 * i]; }
        __syncthreads(); }
    for (int v4 = gt; v4 < 32 * 64 * 16 * 4; v4 += NT) {
        const int v = v4 >> 2, pq = v4 & 3, g = v >> 10, tau = (v >> 4) & 63, h = v & 15;
        float acc[16];
#pragma unroll
        for (int e = 0; e < 16; ++e) acc[e] = 0.f;
        if (staged) {
#pragma unroll 4
            for (int pi = 0; pi < 16; ++pi) { const int p = 16 * pq + pi;
                const float cr = LC[h * 64 + p], ci = LI[h * 64 + p];
                const f32x2 pw = *(const LAS f32x2*)(LP + ((tau & 7) * 64 + p) * 2);
                const float wr = cr * pw.x - ci * pw.y, wi = cr * pw.y + ci * pw.x;
                const LAS f32x4* bb = (const LAS f32x4*)(LB + p * 32);
#pragma unroll
                for (int e2 = 0; e2 < 8; ++e2) { const f32x4 b4 = bb[e2]; acc[2 * e2] += wr * b4.x - wi * b4.y; acc[2 * e2 + 1] += wr * b4.z - wi * b4.w; }
            }
        } else {
#pragma unroll 4
        for (int pi = 0; pi < 16; ++pi) { const int p = 16 * pq + pi;
            const float cr = cre[(g * 16 + h) * 64 + p], ci = cim[(g * 16 + h) * 64 + p];
            const f32x2 pw = *(const f32x2*)(PW + ((size_t)(g * 65 + tau) * 64 + p) * 2);
            const float wr = cr * pw.x - ci * pw.y, wi = cr * pw.y + ci * pw.x;
            const f32x4* bb = (const f32x4*)(BB + (size_t)(g * 64 + p) * 32);
#pragma unroll
            for (int e2 = 0; e2 < 8; ++e2) { const f32x4 b4 = bb[e2]; acc[2 * e2] += wr * b4.x - wi * b4.y; acc[2 * e2 + 1] += wr * b4.z - wi * b4.w; }
        }
        }
#pragma unroll
        for (int e = 0; e < 16; ++e) { acc[e] += __shfl_xor(acc[e], 1); acc[e] += __shfl_xor(acc[e], 2); }
        if (pq != 0) continue;
        if (tau == 0) { const float dv = dd[g * 16 + h];
#pragma unroll
            for (int e = 0; e < 16; ++e) if (e == h) acc[e] += dv; }
        u32x4 lo, hi; lo.x = pk2(acc[0], acc[1]); lo.y = pk2(acc[2], acc[3]); lo.z = pk2(acc[4], acc[5]); lo.w = pk2(acc[6], acc[7]);
        hi.x = pk2(acc[8], acc[9]); hi.y = pk2(acc[10], acc[11]); hi.z = pk2(acc[12], acc[13]); hi.w = pk2(acc[14], acc[15]);
        unsigned char* fb = ws + WS_F + (size_t)g * 65536;
        if (tau + 1 < 64) { *(u32x4*)(fb + (size_t)((tau + 1) * 64 + h) * 16) = lo; *(u32x4*)(fb + (size_t)((tau + 1) * 64 + 32 + h) * 16) = hi; }
        *(u32x4*)(fb + (size_t)(tau * 64 + 16 + h) * 16) = lo; *(u32x4*)(fb + (size_t)(tau * 64 + 48 + h) * 16) = hi;
        if (tau == 0) { u32x4 z; z.x = 0u; z.y = 0u; z.z = 0u; z.w = 0u; *(u32x4*)(fb + (size_t)h * 16) = z; *(u32x4*)(fb + (size_t)(32 + h) * 16) = z; }
    }
    for (int vb_ = gt; vb_ < 32 * 4 * 64 * 64; vb_ += 4 * NT)
#pragma unroll
    for (int u_ = 0; u_ < 4; ++u_) { const int v = vb_ + u_ * NT; if (v >= 32 * 4 * 64 * 64) continue;
        const int g = v >> 14, rt = (v >> 12) & 3, s = (v >> 6) & 63, lane = v & 63, q = 32 * rt + (lane & 31), part = q >> 6, p = q & 63, hh = lane >> 5;
        const f32x2 pw = *(const f32x2*)(PW + ((size_t)(g * 65 + (63 - s)) * 64 + p) * 2);
        const float* bb = BB + ((size_t)(g * 64 + p) * 16 + 8 * hh) * 2;
        float o[8];
#pragma unroll
        for (int e = 0; e < 8; ++e) o[e] = part ? (pw.x * bb[2 * e + 1] + pw.y * bb[2 * e]) : (pw.x * bb[2 * e] - pw.y * bb[2 * e + 1]);
        u32x4 w; w.x = pk2(o[0], o[1]); w.y = pk2(o[2], o[3]); w.z = pk2(o[4], o[5]); w.w = pk2(o[6], o[7]);
        *(u32x4*)(ws + WS_VBIG + (size_t)v * 16) = w;
    }
    for (int vb_ = gt; vb_ < 32 * 32 * 8 * 64; vb_ += 4 * NT)
#pragma unroll
    for (int u_ = 0; u_ < 4; ++u_) { const int v = vb_ + u_ * NT; if (v >= 32 * 32 * 8 * 64) continue;
        const int g = v >> 14, R = (v >> 9) & 31, ks = (v >> 6) & 7, lane = v & 63, r = lane & 31, jj = r >> 4, h = r & 15, hh = lane >> 5, tok = 2 * R + jj, part = ks >> 2;
        float o[8];
#pragma unroll
        for (int e = 0; e < 8; ++e) { const int p = 16 * (ks & 3) + 8 * hh + e;
            const float cr = cre[(g * 16 + h) * 64 + p], ci = cim[(g * 16 + h) * 64 + p];
            const f32x2 pw = *(const f32x2*)(PW + ((size_t)(g * 65 + tok + 1) * 64 + p) * 2);
            o[e] = part ? -(cr * pw.y + ci * pw.x) : (cr * pw.x - ci * pw.y); }
        u32x4 w; w.x = pk2(o[0], o[1]); w.y = pk2(o[2], o[3]); w.z = pk2(o[4], o[5]); w.w = pk2(o[6], o[7]);
        *(u32x4*)(ws + WS_WBIG + (size_t)v * 16) = w;
    }
}
template <int PASS>
DI void lru_item(const Args& a, LAS unsigned char* lds, int item, int tid, int lane, int wave) {
    unsigned char* ws = a.ws;
    const bf16* PROJ = (const bf16*)(ws + WS_PROJ); bf16* MIX = (bf16*)(ws + WS_MIX); float* SUM = (float*)(ws + WS_LRUSUM);
    const int b = item >> 7, ch = item & 127; const size_t m0 = (size_t)b * T + 64 * ch;
    constexpr int XP = 520;
    LAS bf16* XC = (LAS bf16*)lds; LAS bf16* HB = (LAS bf16*)(lds + 66560);
    {
        LAS bf16* XR = HB;
        u32x4 xv[9];
#pragma unroll
        for (int i = 0; i < 9; ++i) { const int idx = tid + 512 * i, r = idx >> 6, c8 = idx & 63;
            xv[i].x = 0u; xv[i].y = 0u; xv[i].z = 0u; xv[i].w = 0u;
            if (idx < 67 * 64 && (ch > 0 || r >= 3)) xv[i] = *(const u32x4*)(PROJ + (m0 + r - 3) * NP + 8 * c8); }
#pragma unroll
        for (int i = 0; i < 9; ++i) { const int idx = tid + 512 * i, r = idx >> 6, c8 = idx & 63;
            if (idx < 67 * 64) *(LAS u32x4*)(XR + r * XP + 8 * c8) = xv[i]; }
        __syncthreads();
        const int c = tid; const float* cw = a.in[6];
        const float w0 = cw[c], w1 = cw[512 + c], w2 = cw[1024 + c], w3 = cw[1536 + c], cb = a.in[7][c];
        float xm3 = bf2f(XR[c]), xm2 = bf2f(XR[XP + c]), xm1 = bf2f(XR[2 * XP + c]);
#pragma unroll 4
        for (int j = 0; j < 64; ++j) { const float x0 = bf2f(XR[(j + 3) * XP + c]); const float xc = w0 * xm3 + w1 * xm2 + w2 * xm1 + w3 * x0 + cb; XC[j * XP + c] = (bf16)f2bf(xc); xm3 = xm2; xm2 = xm1; xm1 = x0; }
    }
    LAS float* CAR = (LAS float*)(lds + 136448);
    if (PASS == 2) { float h = 0.f; const float* sp2 = SUM + ((size_t)(b * 128) * 512 + tid) * 2;
#pragma unroll 16
        for (int cc = 0; cc < ch; ++cc) { const f32x2 s2 = *(const f32x2*)(sp2 + (size_t)cc * 1024); h = s2.x * h + s2.y; }
        CAR[tid] = h; }
    __syncthreads();
    const int g = wave, hh = lane >> 5, l31 = lane & 31;
    const bf16* GW = (const bf16*)(ws + WS_GW);
#pragma unroll 1
    for (int ct = 0; ct < 2; ++ct) {
        const int j = 32 * ct + l31, c = 64 * g + j;
        bf16x8 Br[4], Bi[4];
#pragma unroll
        for (int s = 0; s < 4; ++s) { Br[s] = mk8(*(const u32x4*)(GW + ((size_t)(((0 * 8 + g) * 2 + ct) * 4 + s) * 64 + lane) * 8)); Bi[s] = mk8(*(const u32x4*)(GW + ((size_t)(((1 * 8 + g) * 2 + ct) * 4 + s) * 64 + lane) * 8)); }
        f32x16 Rr[2], Ii[2];
#pragma unroll
        for (int rt = 0; rt < 2; ++rt) { Rr[rt] = zero16(); Ii[rt] = zero16();
#pragma unroll
            for (int s = 0; s < 4; ++s) { const bf16x8 A = *(const LAS bf16x8*)(XC + (32 * rt + l31) * XP + 64 * g + 16 * s + 8 * hh); Rr[rt] = MFMA32(A, Br[s], Rr[rt]); Ii[rt] = MFMA32(A, Bi[s], Ii[rt]); } }
        const float rb = a.in[9][c], ib = a.in[11][c];
        const float sp = log1pf(__expf(-a.in[12][c]));
#pragma unroll
        for (int rt = 0; rt < 2; ++rt)
#pragma unroll
            for (int i = 0; i < 16; ++i) { const int tok = 32 * rt + crow(i, hh);
                const float r = sigm(Rr[rt][i] + rb), ig = sigm(Ii[rt][i] + ib);
                const float la = -8.f * r * sp; const float av = __expf(la); const float x2 = 2.f * la;
                const float ser = -x2 * (1.f + 0.5f * x2 * (1.f + (1.f / 3.f) * x2 * (1.f + 0.25f * x2 * (1.f + 0.2f * x2 * (1.f + (1.f / 6.f) * x2)))));
                const float om = (x2 > -0.25f) ? ser : (1.f - av * av); const float mult = __builtin_amdgcn_sqrtf(om);
                const float xv = bf2f(XC[tok * XP + c]);
                Rr[rt][i] = av; Ii[rt][i] = mult * ig * xv; if ((i & 3) == 3) __builtin_amdgcn_sched_barrier(0); }
        float Ag[8], Bg[8], Ao[8], Bo[8];
#pragma unroll
        for (int rt = 0; rt < 2; ++rt)
#pragma unroll
            for (int k = 0; k < 4; ++k) { float A = 1.f, Bv = 0.f;
#pragma unroll
                for (int e = 0; e < 4; ++e) { const float av = Rr[rt][4 * k + e]; Bv = av * Bv + Ii[rt][4 * k + e]; A *= av; }
                Ag[rt * 4 + k] = A; Bg[rt * 4 + k] = Bv; }
#pragma unroll
        for (int q = 0; q < 8; ++q) { Ao[q] = __shfl_xor(Ag[q], 32); Bo[q] = __shfl_xor(Bg[q], 32); }
        float h = (PASS == 2) ? CAR[c] : 0.f;
        float hs[8]; float Atot = 1.f;
#pragma unroll
        for (int q = 0; q < 8; ++q) {
            const float A1 = hh ? Ao[q] : Ag[q], B1 = hh ? Bo[q] : Bg[q], A2 = hh ? Ag[q] : Ao[q], B2 = hh ? Bg[q] : Bo[q];
            const float h1 = A1 * h + B1; hs[q] = hh ? h1 : h; h = A2 * h1 + B2; Atot *= A1 * A2; }
        if (PASS == 1) { if (hh == 0) { f32x2 o; o.x = Atot; o.y = h; *(f32x2*)(SUM + ((size_t)(b * 128 + ch) * 512 + c) * 2) = o; } }
        else {
#pragma unroll
            for (int rt = 0; rt < 2; ++rt)
#pragma unroll
                for (int k = 0; k < 4; ++k) { float hc = hs[rt * 4 + k];
#pragma unroll
                    for (int e = 0; e < 4; ++e) { const int i = 4 * k + e; hc = Rr[rt][i] * hc + Ii[rt][i]; HB[(32 * rt + 8 * k + 4 * hh + e) * XP + c] = (bf16)f2bf(hc); } }
        }
    }
    __syncthreads();
    if (PASS == 2) {
#pragma unroll
        for (int i = 0; i < 8; ++i) { const int idx = tid + 512 * i, tok = idx >> 6, c8 = idx & 63;
            const u32x4 hv = *(const LAS u32x4*)(HB + tok * XP + 8 * c8); const u32x4 gv = *(const u32x4*)(PROJ + (m0 + tok) * NP + 512 + 8 * c8);
            u32x4 o;
#pragma unroll
            for (int e = 0; e < 4; ++e) o[e] = pk2(bflo(hv[e]) * silu(bflo(gv[e])), bfhi(hv[e]) * silu(bfhi(gv[e])));
            *(u32x4*)(MIX + (m0 + tok) * 1024 + 8 * c8) = o; }
        __syncthreads();
    }
}

template <int LAYER>
DI void prep_item(const Args& a, LAS unsigned char* lds, int item, int tid) {
    unsigned char* ws = a.ws;
    bf16* PROJ = (bf16*)(ws + WS_PROJ); bf16* VF = (bf16*)(ws + WS_VT); bf16* KF = (bf16*)(ws + WS_KF);
    constexpr int qoff = LAYER ? 0 : 1024, koff = LAYER ? 512 : 1536, voff = LAYER ? 1024 : 2048;
    const float* qg = LAYER ? a.in[20] : a.in[13]; const float* kg = LAYER ? a.in[21] : a.in[14];
    const int h = item & 7, n = (item >> 3) & 31, b = item >> 8;
    LAS bf16* VL = (LAS bf16*)lds; LAS float* RED = (LAS float*)(lds + 40960);
    const int c8 = tid & 7, r0 = tid >> 3;
    float qgv[8], kgv[8], ksum[8];
#pragma unroll
    for (int e = 0; e < 8; ++e) { qgv[e] = qg[8 * c8 + e]; kgv[e] = kg[8 * c8 + e]; ksum[e] = 0.f; }
    u32x4 lq[4], lk[4], lv[4];
#pragma unroll
    for (int i = 0; i < 4; ++i) { const bf16* base = PROJ + ((size_t)b * T + 256 * n + r0 + 64 * i) * NP + 64 * h + 8 * c8; lq[i] = *(const u32x4*)(base + qoff); lk[i] = *(const u32x4*)(base + koff); lv[i] = *(const u32x4*)(base + voff); }
#pragma unroll
    for (int i = 0; i < 4; ++i) {
        const int row = r0 + 64 * i; bf16* base = PROJ + ((size_t)b * T + 256 * n + row) * NP + 64 * h + 8 * c8;
        {   u32x4 v = lq[i]; float f[8];
#pragma unroll
            for (int e = 0; e < 4; ++e) { f[2 * e] = bflo(v[e]); f[2 * e + 1] = bfhi(v[e]); }
            float ss = 0.f;
#pragma unroll
            for (int e = 0; e < 8; ++e) ss += f[e] * f[e];
            ss += __shfl_xor(ss, 1); ss += __shfl_xor(ss, 2); ss += __shfl_xor(ss, 4);
            const float rstd = rsqrtf(ss * (1.f / 64.f) + 1e-6f);
#pragma unroll
            for (int e = 0; e < 8; ++e) f[e] = f[e] * rstd * qgv[e];
            u32x4 o; o.x = pk2(f[0], f[1]); o.y = pk2(f[2], f[3]); o.z = pk2(f[4], f[5]); o.w = pk2(f[6], f[7]); *(u32x4*)(base + qoff) = o; }
        {   u32x4 v = lk[i]; float f[8];
#pragma unroll
            for (int e = 0; e < 4; ++e) { f[2 * e] = bflo(v[e]); f[2 * e + 1] = bfhi(v[e]); }
            float ss = 0.f;
#pragma unroll
            for (int e = 0; e < 8; ++e) ss += f[e] * f[e];
            ss += __shfl_xor(ss, 1); ss += __shfl_xor(ss, 2); ss += __shfl_xor(ss, 4);
            const float rstd = rsqrtf(ss * (1.f / 64.f) + 1e-6f);
#pragma unroll
            for (int e = 0; e < 8; ++e) { f[e] = f[e] * rstd * kgv[e]; ksum[e] += f[e]; }
            u32x4 o; o.x = pk2(f[0], f[1]); o.y = pk2(f[2], f[3]); o.z = pk2(f[4], f[5]); o.w = pk2(f[6], f[7]);
            *(u32x4*)(KF + ((((size_t)(b * 8 + h) * 256 + 8 * n + (row >> 5)) * 4 + (c8 >> 1)) * 64 + (c8 & 1) * 32 + (row & 31)) * 8) = o; }
        *(LAS u32x4*)(VL + row * 72 + 8 * c8) = lv[i];
    }
    if (LAYER == 0) {
#pragma unroll
        for (int e = 0; e < 8; ++e) RED[r0 * 64 + 8 * c8 + e] = ksum[e]; }
    __syncthreads();
    if (LAYER == 0 && tid < 64) { float s = 0.f;
        for (int r = 0; r < 64; ++r) s += RED[r * 64 + tid];
        ((float*)(ws + WS_KMEAN))[((size_t)(b * 8 + h) * 32 + n) * 64 + tid] = s * (1.f / 256.f); }
#pragma unroll
    for (int i = 0; i < 4; ++i) { const int idx = tid + 512 * i, ln = idx & 63, s = (idx >> 6) & 1, dt = (idx >> 7) & 1, kt = idx >> 8, l31 = ln & 31, hh = ln >> 5;
        const LAS bf16* vp = VL + (32 * kt + 16 * s + 4 * hh) * 72 + 32 * dt + l31;
        const unsigned short e0 = vp[0], e1 = vp[72], e2 = vp[144], e3 = vp[216], e4 = vp[8 * 72], e5 = vp[9 * 72], e6 = vp[10 * 72], e7 = vp[11 * 72];
        u32x4 o; o.x = e0 | ((unsigned)e1 << 16); o.y = e2 | ((unsigned)e3 << 16); o.z = e4 | ((unsigned)e5 << 16); o.w = e6 | ((unsigned)e7 << 16);
        *(u32x4*)(VF + (((((size_t)(b * 8 + h) * 256 + 8 * n + kt) * 2 + dt) * 2 + s) * 64 + ln) * 8) = o; }
    __syncthreads();
}

DI void moba_item(const Args& a, LAS unsigned char* lds, int item, int tid, int lane, int wave) {
    unsigned char* ws = a.ws;
    const bf16* PROJ = (const bf16*)(ws + WS_PROJ); const bf16* VT = (const bf16*)(ws + WS_VT); bf16* MIX = (bf16*)(ws + WS_MIX);
    const int bh = item & 31, m = item >> 5, b = bh >> 3, h = bh & 7;
    constexpr int QP = 72, SP = 68;
    LAS bf16* QS = (LAS bf16*)lds;
    LAS bf16* SLAB = (LAS bf16*)(lds + 36864);
    LAS float* KM = (LAS float*)(lds + 36864);
    LAS float* SL = (LAS float*)(lds + 141312);
    LAS unsigned short* LISTQ = (LAS unsigned short*)(lds + 144384);
    LAS unsigned short* SELROW = (LAS unsigned short*)(lds + 145920);
    LAS int* CNT = (LAS int*)(lds + 147968);
    LAS int* OFF = (LAS int*)(lds + 148096);
    LAS unsigned short* TILES = (LAS unsigned short*)(lds + 148224);
    LAS int* NTL = (LAS int*)(lds + 148352);
    const size_t mq0 = (size_t)b * T + 256 * m;
    {   const int row = tid >> 1, half = tid & 1; const bf16* src = PROJ + (mq0 + row) * NP + 1024 + 64 * h + 32 * half;
#pragma unroll
        for (int i = 0; i < 4; ++i) { const u32x4 v = *(const u32x4*)(src + 8 * i); u32x4 o;
#pragma unroll
            for (int e = 0; e < 4; ++e) o[e] = pk2(bflo(v[e]) * (0.125f * 1.4426950408889634f), bfhi(v[e]) * (0.125f * 1.4426950408889634f));
            *(LAS u32x4*)(QS + row * QP + 32 * half + 8 * i) = o; } }
    {   const float* km = (const float*)(ws + WS_KMEAN) + (size_t)(b * 8 + h) * 2048;
        for (int i = tid; i < m * 64; i += NTHR) KM[i] = km[i]; }
    if (tid < 32) CNT[tid] = 0;
    __syncthreads();
    int i0 = 255, i1 = 255, i2 = 255, ps0 = 0, ps1 = 0, ps2 = 0;
    if (tid < 256 && m > 0) {
        float q[64];
#pragma unroll
        for (int i = 0; i < 8; ++i) { const u32x4 v = *(const LAS u32x4*)(QS + tid * QP + 8 * i);
#pragma unroll
            for (int e = 0; e < 4; ++e) { q[8 * i + 2 * e] = bflo(v[e]); q[8 * i + 2 * e + 1] = bfhi(v[e]); } }
        float v0 = -INFINITY, v1 = -INFINITY, v2 = -INFINITY;
        for (int n = 0; n < m; ++n) { float dot = 0.f;
#pragma unroll
            for (int d4 = 0; d4 < 16; ++d4) { const f32x4 kv = *(const LAS f32x4*)(KM + n * 64 + 4 * d4); dot += q[4 * d4] * kv.x + q[4 * d4 + 1] * kv.y + q[4 * d4 + 2] * kv.z + q[4 * d4 + 3] * kv.w; }
            if (dot > v0) { v2 = v1; i2 = i1; v1 = v0; i1 = i0; v0 = dot; i0 = n; }
            else if (dot > v1) { v2 = v1; i2 = i1; v1 = dot; i1 = n; }
            else if (dot > v2) { v2 = dot; i2 = n; } }
        if (i0 != 255) ps0 = __hip_atomic_fetch_add(CNT + i0, 1, __ATOMIC_RELAXED, __HIP_MEMORY_SCOPE_WORKGROUP);
        if (i1 != 255) ps1 = __hip_atomic_fetch_add(CNT + i1, 1, __ATOMIC_RELAXED, __HIP_MEMORY_SCOPE_WORKGROUP);
        if (i2 != 255) ps2 = __hip_atomic_fetch_add(CNT + i2, 1, __ATOMIC_RELAXED, __HIP_MEMORY_SCOPE_WORKGROUP);
    }
    __syncthreads();
    if (tid < 64) {
        const int c = (lane < m) ? CNT[lane] : 0, ntile = (c + 31) >> 5;
        int pc = c, ptile = ntile;
#pragma unroll
        for (int o = 1; o < 32; o <<= 1) { const int uc = __shfl_up(pc, o), ut = __shfl_up(ptile, o); if ((lane & 31) >= o) { pc += uc; ptile += ut; } }
        if (lane < 32) { OFF[lane] = pc - c; for (int qt = 0; qt < ntile; ++qt) TILES[ptile - ntile + qt] = (unsigned short)(lane | (qt << 8)); if (lane == 31) NTL[0] = ptile; }
    }
    __syncthreads();
    if (tid < 256) {
        unsigned short r0 = 0xffff, r1 = 0xffff, r2 = 0xffff;
        if (i0 != 255) { r0 = (unsigned short)(OFF[i0] + ps0); LISTQ[r0] = (unsigned short)tid; }
        if (i1 != 255) { r1 = (unsigned short)(OFF[i1] + ps1); LISTQ[r1] = (unsigned short)tid; }
        if (i2 != 255) { r2 = (unsigned short)(OFF[i2] + ps2); LISTQ[r2] = (unsigned short)tid; }
        SELROW[tid * 4] = r0; SELROW[tid * 4 + 1] = r1; SELROW[tid * 4 + 2] = r2;
    }
    __syncthreads();
    const float cb2 = ((const float*)(ws + WS_MOD))[2 * 4 * 3072] * 1.4426950408889634f;
    f32x16 sinit;
#pragma unroll
    for (int i = 0; i < 16; ++i) sinit[i] = -cb2;
    const int hh = lane >> 5, l31 = lane & 31, w = wave;
    const bf16* Kb = (const bf16*)(ws + WS_KF) + ((size_t)(b * 8 + h) * 256 * 4 * 64 + lane) * 8;
    const bf16* Vb = VT + ((size_t)(b * 8 + h) * 256 * 4 * 64 + lane) * 8;
    const int nt = NTL[0];
#define MOBA_LOADKV(AK, AV, key0) do { const size_t kt_ = (size_t)((key0) >> 5) * 2048; \
    _Pragma("unroll") for (int s = 0; s < 4; ++s) AK[s] = mk8(*(const u32x4*)(Kb + kt_ + s * 512)); \
    _Pragma("unroll") for (int dt = 0; dt < 2; ++dt) _Pragma("unroll") for (int s = 0; s < 2; ++s) AV[dt][s] = mk8(*(const u32x4*)(Vb + kt_ + (dt * 2 + s) * 512)); } while (0)
    for (int t = w; t < nt; t += 8) {
        const int tl = TILES[t], n = tl & 255, qt = tl >> 8, cnt = CNT[n], rowb = OFF[n] + 32 * qt;
        const bool valid = (32 * qt + l31) < cnt; const int qrow = valid ? (int)LISTQ[rowb + l31] : 0;
        bf16x8 bq[4];
#pragma unroll
        for (int s = 0; s < 4; ++s) bq[s] = *(const LAS bf16x8*)(QS + qrow * QP + 16 * s + 8 * hh);
        f32x16 o0 = zero16(), o1 = zero16(); f32x2 ls2; ls2.x = 0.f; ls2.y = 0.f;
        bf16x8 ak[4], av[2][2], akn[4], avn[2][2];
        MOBA_LOADKV(ak, av, 256 * n);
#define MOBA_STEP(AK, AV, AKN, AVN, knext) do { \
            MOBA_LOADKV(AKN, AVN, knext); \
            f32x16 sacc = sinit; \
            _Pragma("unroll") for (int s = 0; s < 4; ++s) sacc = MFMA32(AK[s], bq[s], sacc); \
            _Pragma("unroll") for (int i = 0; i < 16; i += 2) { f32x2 p2; p2.x = __builtin_amdgcn_exp2f(sacc[i]); p2.y = __builtin_amdgcn_exp2f(sacc[i + 1]); sacc[i] = p2.x; sacc[i + 1] = p2.y; ls2 += p2; } \
            const bf16x8 p0 = pack8(sacc[0], sacc[1], sacc[2], sacc[3], sacc[4], sacc[5], sacc[6], sacc[7]); \
            const bf16x8 p1 = pack8(sacc[8], sacc[9], sacc[10], sacc[11], sacc[12], sacc[13], sacc[14], sacc[15]); \
            o0 = MFMA32(AV[0][0], p0, o0); o0 = MFMA32(AV[0][1], p1, o0); o1 = MFMA32(AV[1][0], p0, o1); o1 = MFMA32(AV[1][1], p1, o1); } while (0)
#pragma unroll 1
        for (int ks = 0; ks < 8; ks += 2) {
            MOBA_STEP(ak, av, akn, avn, 256 * n + 32 * (ks + 1));
            MOBA_STEP(akn, avn, ak, av, 256 * n + 32 * (ks < 6 ? ks + 2 : ks + 1));
        }
        float lsum = ls2.x + ls2.y;
        lsum += __shfl_xor(lsum, 32);
        if (valid) {
            LAS bf16* sr = SLAB + (rowb + l31) * SP + 4 * hh;
#pragma unroll
            for (int k = 0; k < 4; ++k) { u32x2 wv; wv.x = pk2(o0[4 * k], o0[4 * k + 1]); wv.y = pk2(o0[4 * k + 2], o0[4 * k + 3]); *(LAS u32x2*)(sr + 8 * k) = wv;
                u32x2 wu; wu.x = pk2(o1[4 * k], o1[4 * k + 1]); wu.y = pk2(o1[4 * k + 2], o1[4 * k + 3]); *(LAS u32x2*)(sr + 32 + 8 * k) = wu; }
            if (hh == 0) SL[rowb + l31] = lsum;
        }
    }
    f32x16 o0 = zero16(), o1 = zero16(); float lsum = 0.f;
    {
        const int qrow = 32 * w + l31;
        bf16x8 bq[4];
#pragma unroll
        for (int s = 0; s < 4; ++s) bq[s] = *(const LAS bf16x8*)(QS + qrow * QP + 16 * s + 8 * hh);
        bf16x8 ak[4], av[2][2], akn[4], avn[2][2];
        MOBA_LOADKV(ak, av, 256 * m);
#pragma unroll 1
        for (int ks = 0; ks <= w; ++ks) {
            const int kn = 256 * m + 32 * (ks < w ? ks + 1 : ks);
            MOBA_LOADKV(akn, avn, kn);
            f32x16 sacc = sinit;
#pragma unroll
            for (int s = 0; s < 4; ++s) sacc = MFMA32(ak[s], bq[s], sacc);
#pragma unroll
            for (int i = 0; i < 16; ++i) { float p = __builtin_amdgcn_exp2f(sacc[i]); if (ks == w && crow(i, hh) > l31) p = 0.f; sacc[i] = p; lsum += p; }
            const bf16x8 p0 = pack8(sacc[0], sacc[1], sacc[2], sacc[3], sacc[4], sacc[5], sacc[6], sacc[7]);
            const bf16x8 p1 = pack8(sacc[8], sacc[9], sacc[10], sacc[11], sacc[12], sacc[13], sacc[14], sacc[15]);
            o0 = MFMA32(av[0][0], p0, o0); o0 = MFMA32(av[0][1], p1, o0); o1 = MFMA32(av[1][0], p0, o1); o1 = MFMA32(av[1][1], p1, o1);
#pragma unroll
            for (int s = 0; s < 4; ++s) ak[s] = akn[s];
#pragma unroll
            for (int dt = 0; dt < 2; ++dt) { av[dt][0] = avn[dt][0]; av[dt][1] = avn[dt][1]; }
        }
        lsum += __shfl_xor(lsum, 32);
    }
    __syncthreads();
    {
        const int qrow = 32 * w + l31;
#pragma unroll
        for (int j = 0; j < 3; ++j) { const int r = SELROW[qrow * 4 + j];
            if (r != 0xffff) { lsum += SL[r]; const LAS bf16* sr = SLAB + r * SP + 4 * hh;
#pragma unroll
                for (int k = 0; k < 4; ++k) { const u32x2 u0 = *(const LAS u32x2*)(sr + 8 * k), u1 = *(const LAS u32x2*)(sr + 32 + 8 * k);
                    o0[4 * k] += bflo(u0.x); o0[4 * k + 1] += bfhi(u0.x); o0[4 * k + 2] += bflo(u0.y); o0[4 * k + 3] += bfhi(u0.y);
                    o1[4 * k] += bflo(u1.x); o1[4 * k + 1] += bfhi(u1.x); o1[4 * k + 2] += bflo(u1.y); o1[4 * k + 3] += bfhi(u1.y); } } }
        const float inv = 1.f / lsum;
        LAS bf16* sl = QS + (32 * w) * QP;
#pragma unroll
        for (int dt = 0; dt < 2; ++dt)
#pragma unroll
            for (int k = 0; k < 4; ++k) { const f32x16& o = dt ? o1 : o0; u32x2 wv; wv.x = pk2(o[4 * k] * inv, o[4 * k + 1] * inv); wv.y = pk2(o[4 * k + 2] * inv, o[4 * k + 3] * inv);
                *(LAS u32x2*)(sl + l31 * QP + 32 * dt + 8 * k + 4 * hh) = wv; }
#pragma unroll
        for (int i = 0; i < 4; ++i) { const int c = lane + 64 * i, row = c >> 3, part = c & 7;
            const u32x4 ov = *(const LAS u32x4*)(sl + row * QP + 8 * part); const u32x4 gv = *(const u32x4*)(PROJ + (mq0 + 32 * w + row) * NP + 2560 + 64 * h + 8 * part);
            u32x4 wv;
#pragma unroll
            for (int e = 0; e < 4; ++e) wv[e] = pk2(bflo(ov[e]) * silu(bflo(gv[e])), bfhi(ov[e]) * silu(bfhi(gv[e])));
            *(u32x4*)(MIX + (mq0 + 32 * w + row) * 1024 + 512 + 64 * h + 8 * part) = wv; }
    }
    __syncthreads();
#undef MOBA_LOADKV
#undef MOBA_STEP
}

DI void sb_item(const Args& a, LAS unsigned char* slab, int item, int lane) {
    unsigned char* ws = a.ws;
    const bf16* PROJ = (const bf16*)(ws + WS_PROJ); const bf16* VT = (const bf16*)(ws + WS_VT); const bf16* KF = (const bf16*)(ws + WS_KF); bf16* MIX = (bf16*)(ws + WS_MIX);
    const int qt = 255 - (item >> 5), bh = item & 31, b = bh >> 3, h = bh & 7;
    const int hh = lane >> 5, l31 = lane & 31;
    const size_t mq = (size_t)b * T + 32 * qt + l31;
    bf16x8 bq[4];
#pragma unroll
    for (int s = 0; s < 4; ++s) bq[s] = mk8(*(const u32x4*)(PROJ + mq * NP + 64 * h + 16 * s + 8 * hh));
    f32x16 o0 = zero16(), o1 = zero16();
    float carry = 0.f;
    const size_t kfb = (size_t)(b * 8 + h) * 256 * 2048 + lane * 8;
#define SB_LOADKV(AK, AV, kt_) do { const size_t kb_ = kfb + (size_t)(kt_) * 2048; \
    _Pragma("unroll") for (int s = 0; s < 4; ++s) AK[s] = mk8(*(const u32x4*)(KF + kb_ + s * 512)); \
    _Pragma("unroll") for (int dt = 0; dt < 2; ++dt) _Pragma("unroll") for (int s = 0; s < 2; ++s) AV[dt][s] = mk8(*(const u32x4*)(VT + kb_ + (dt * 2 + s) * 512)); } while (0)
    bf16x8 ak[4], av[2][2], akn[4], avn[2][2];
    SB_LOADKV(ak, av, qt);
#pragma unroll 1
    for (int kt = qt; kt >= 0; --kt) {
        SB_LOADKV(akn, avn, (kt > 0 ? kt - 1 : 0));
        f32x16 z = zero16();
#pragma unroll
        for (int s = 0; s < 4; ++s) z = MFMA32(ak[s], bq[s], z);
        float kp[16], bt[16];
        if (kt == qt) {
#pragma unroll
            for (int i = 0; i < 16; ++i) { const float zz = z[i] * 0.125f; const bool strict = crow(i, hh) < l31;
                const float e = __expf(-fabsf(zz)), r = __builtin_amdgcn_rcpf(1.f + e), er = e * r;
                kp[i] = strict ? (zz >= 0.f ? er : r) : 1.f; bt[i] = strict ? (zz >= 0.f ? r : er) : 0.f; }
        } else {
#pragma unroll
            for (int i = 0; i < 16; ++i) { const float zz = z[i] * 0.125f;
                const float e = __expf(-fabsf(zz)), r = __builtin_amdgcn_rcpf(1.f + e), er = e * r;
                kp[i] = (zz >= 0.f ? er : r); bt[i] = (zz >= 0.f ? r : er); }
        }
        float gs[4], go[4];
#pragma unroll
        for (int k = 0; k < 4; ++k) { gs[k] = (kp[4 * k] * kp[4 * k + 1]) * (kp[4 * k + 2] * kp[4 * k + 3]); go[k] = __shfl_xor(gs[k], 32); }
        float after[4]; float run = 1.f;
#pragma unroll
        for (int k = 3; k >= 0; --k) { after[k] = hh ? run : run * go[k]; run *= gs[k] * go[k]; }
        const float base = __expf(carry);
        float wv[16];
#pragma unroll
        for (int k = 0; k < 4; ++k) { float suf = base * after[k];
#pragma unroll
            for (int e = 3; e >= 0; --e) { wv[4 * k + e] = bt[4 * k + e] * suf; suf *= kp[4 * k + e]; } }
        carry += __logf(run);
        const bf16x8 p0 = pack8(wv[0], wv[1], wv[2], wv[3], wv[4], wv[5], wv[6], wv[7]);
        const bf16x8 p1 = pack8(wv[8], wv[9], wv[10], wv[11], wv[12], wv[13], wv[14], wv[15]);
        o0 = MFMA32(av[0][0], p0, o0); o0 = MFMA32(av[0][1], p1, o0);
        o1 = MFMA32(av[1][0], p0, o1); o1 = MFMA32(av[1][1], p1, o1);
        if (__all(carry < -104.f)) break;
#pragma unroll
        for (int s = 0; s < 4; ++s) ak[s] = akn[s];
#pragma unroll
        for (int dt = 0; dt < 2; ++dt) { av[dt][0] = avn[dt][0]; av[dt][1] = avn[dt][1]; }
    }
#undef SB_LOADKV
    {
        LAS bf16* sl = (LAS bf16*)slab;
#pragma unroll
        for (int dt = 0; dt < 2; ++dt)
#pragma unroll
            for (int k = 0; k < 4; ++k) { const f32x16& o = dt ? o1 : o0; u32x2 w; w.x = pk2(o[4 * k], o[4 * k + 1]); w.y = pk2(o[4 * k + 2], o[4 * k + 3]);
                *(LAS u32x2*)(sl + l31 * 72 + 32 * dt + 8 * k + 4 * hh) = w; }
        const size_t mb = (size_t)b * T + 32 * qt;
#pragma unroll
        for (int i = 0; i < 4; ++i) { const int c = lane + 64 * i, row = c >> 3, part = c & 7;
            const u32x4 ov = *(const LAS u32x4*)(sl + row * 72 + 8 * part); const u32x4 gv = *(const u32x4*)(PROJ + (mb + row) * NP + 1536 + 64 * h + 8 * part);
            u32x4 w;
#pragma unroll
            for (int e = 0; e < 4; ++e) w[e] = pk2(bflo(ov[e]) * silu(bflo(gv[e])), bfhi(ov[e]) * silu(bfhi(gv[e])));
            *(u32x4*)(MIX + (mb + row) * 1024 + 64 * h + 8 * part) = w; }
    }
}

DI void s5_pass1(const Args& a, LAS unsigned char* lds, int item, int tid, int lane, int wave) {
    unsigned char* ws = a.ws;
    const bf16* PROJ = (const bf16*)(ws + WS_PROJ); float* S5S = (float*)(ws + WS_S5S);
    const int g = item & 31, b = (item >> 5) & 3, ct = item >> 7;
    const int rt = wave & 3, kh = wave >> 2, hh = lane >> 5, l31 = lane & 31;
    constexpr int UP = 2064;
    LAS unsigned char* UL = lds + 16384;
#pragma unroll
    for (int i = 0; i < 8; ++i) { const int idx = tid + 512 * i, tok = idx >> 1, hf = idx & 1;
        const u32x4 v = *(const u32x4*)(PROJ + ((size_t)b * T + 2048 * ct + tok) * NP + 2048 + 16 * g + 8 * hf);
        *(LAS u32x4*)(UL + (tok >> 6) * UP + (tok & 63) * 32 + 16 * hf) = v; }
    __syncthreads();
    const unsigned char* vb = ws + WS_VBIG + ((size_t)((g * 4 + rt) * 64) * 64 + lane) * 16;
    f32x16 acc = zero16();
#pragma unroll 4
    for (int s = 32 * kh; s < 32 * kh + 32; ++s) { const bf16x8 A = mk8(*(const u32x4*)(vb + (size_t)s * 1024)); const bf16x8 Bf = *(const LAS bf16x8*)(UL + l31 * UP + s * 32 + 16 * hh); acc = MFMA32(A, Bf, acc); }
    LAS float* red = (LAS float*)lds;
    if (kh == 1) {
#pragma unroll
        for (int i = 0; i < 16; ++i) red[(rt * 16 + i) * 64 + lane] = acc[i]; }
    __syncthreads();
    if (kh == 0) {
        float* dst = S5S + ((size_t)((b * 32 + g) * 128 + 32 * ct + l31)) * 128 + 32 * rt;
#pragma unroll
        for (int k = 0; k < 4; ++k) { f32x4 o;
#pragma unroll
            for (int e = 0; e < 4; ++e) o[e] = acc[4 * k + e] + red[(rt * 16 + 4 * k + e) * 64 + lane];
            *(f32x4*)(dst + 8 * k + 4 * hh) = o; } }
    __syncthreads();
}
DI void s5_pass2(const Args& a, LAS unsigned char* lds, int item, int tid, int lane, int wave) {
    unsigned char* ws = a.ws;
    const bf16* PROJ = (const bf16*)(ws + WS_PROJ); const float* S5S = (const float*)(ws + WS_S5S); bf16* S5Y = (bf16*)(ws + WS_H);
    const int g = item & 31, b = (item >> 5) & 3, ct = item >> 7;
    constexpr int UP = 2064, XPP = 136;
    LAS unsigned char* FL = lds;
    LAS unsigned char* UL = lds + 65536;
    LAS bf16* XPl = (LAS bf16*)(lds + 65536 + 66048);
    {   const unsigned char* fsrc = ws + WS_F + (size_t)g * 65536;
#pragma unroll
        for (int i = 0; i < 8; ++i) { const int idx = tid + 512 * i; *(LAS u32x4*)(FL + idx * 16) = *(const u32x4*)(fsrc + (size_t)idx * 16); }
#pragma unroll
        for (int i = 0; i < 8; ++i) { const int idx = tid + 512 * i, tok = idx >> 1, half = idx & 1;
            const u32x4 v = *(const u32x4*)(PROJ + ((size_t)b * T + 2048 * ct + tok) * NP + 2048 + 16 * g + 8 * half);
            *(LAS u32x4*)(UL + (tok >> 6) * UP + (tok & 63) * 32 + 16 * half) = v; } }
    {
        const int p = lane; const float ar = ((const float*)(ws + WS_ABL))[(g * 64 + p) * 2], ai = ((const float*)(ws + WS_ABL))[(g * 64 + p) * 2 + 1];
        const float* Sp = S5S + (size_t)((b * 32 + g) * 128) * 128;
        LAS float* SEG = (LAS float*)(lds + 65536 + 66048 + 8704);
        const int seg = 4 * ct;
        {   float xr = 0.f, xi = 0.f, qr = 1.f, qi = 0.f;
            for (int c = wave * seg; c < (wave + 1) * seg; ++c) { const float sr = Sp[c * 128 + p], si = Sp[c * 128 + 64 + p];
                const float nr = ar * xr - ai * xi + sr, ni = ar * xi + ai * xr + si; xr = nr; xi = ni; const float tr = qr * ar - qi * ai, ti = qr * ai + qi * ar; qr = tr; qi = ti; }
            SEG[(wave * 4 + 0) * 64 + p] = xr; SEG[(wave * 4 + 1) * 64 + p] = xi; SEG[(wave * 4 + 2) * 64 + p] = qr; SEG[(wave * 4 + 3) * 64 + p] = qi; }
        __syncthreads();
        if (wave == 0) {
            float xr = 0.f, xi = 0.f;
#pragma unroll
            for (int w = 0; w < 8; ++w) { const float sr = SEG[(w * 4 + 0) * 64 + p], si = SEG[(w * 4 + 1) * 64 + p], qr = SEG[(w * 4 + 2) * 64 + p], qi = SEG[(w * 4 + 3) * 64 + p];
                const float nr = qr * xr - qi * xi + sr, ni = qr * xi + qi * xr + si; xr = nr; xi = ni; }
#pragma unroll 8
            for (int n = 0; n < 32; ++n) { XPl[n * XPP + p] = (bf16)f2bf(xr); XPl[n * XPP + 64 + p] = (bf16)f2bf(xi);
                const int c = 32 * ct + n; const float sr = Sp[c * 128 + p], si = Sp[c * 128 + 64 + p]; const float nr = ar * xr - ai * xi + sr, ni = ar * xi + ai * xr + si; xr = nr; xi = ni; }
        }
    }
    __syncthreads();
    const int hh = lane >> 5, l31 = lane & 31;
    f32x16 acc[4];
#pragma unroll
    for (int i = 0; i < 4; ++i) acc[i] = zero16();
#define S5_SEG(I0, SLO, SHI) do { _Pragma("unroll 2") for (int s = (SLO); s <= (SHI); ++s) { \
        const bf16x8 Bf = *(const LAS bf16x8*)(UL + l31 * UP + s * 32 + 16 * hh); bf16x8 Af[4]; \
        _Pragma("unroll") for (int i = (I0); i < 4; ++i) Af[i] = *(const LAS bf16x8*)(FL + (2 * (wave + 8 * i) - s + 1) * 1024 + lane * 16); \
        _Pragma("unroll") for (int i = (I0); i < 4; ++i) acc[i] = MFMA32(Af[i], Bf, acc[i]); } } while (0)
    S5_SEG(0, 0, 2 * wave + 1);
    S5_SEG(1, 2 * wave + 2, 2 * wave + 17);
    S5_SEG(2, 2 * wave + 18, 2 * wave + 33);
    S5_SEG(3, 2 * wave + 34, 2 * wave + 49);
#undef S5_SEG
#pragma unroll
    for (int ks = 0; ks < 8; ++ks) { const bf16x8 Bf = *(const LAS bf16x8*)(XPl + l31 * XPP + 16 * ks + 8 * hh);
#pragma unroll
        for (int i = 0; i < 4; ++i) { const int R = wave + 8 * i;
            const bf16x8 A = mk8(*(const u32x4*)(ws + WS_WBIG + ((size_t)((g * 32 + R) * 8 + ks) * 64 + lane) * 16)); acc[i] = MFMA32(A, Bf, acc[i]); } }
#pragma unroll
    for (int i = 0; i < 4; ++i) { const int R = wave + 8 * i;
#pragma unroll
        for (int k = 0; k < 4; ++k) { const int jj = k >> 1; const size_t tok = (size_t)b * T + 2048 * ct + 64 * l31 + 2 * R + jj;
            u32x2 w; w.x = pk2(acc[i][4 * k], acc[i][4 * k + 1]); w.y = pk2(acc[i][4 * k + 2], acc[i][4 * k + 3]);
            *(u32x2*)(S5Y + tok * 512 + 16 * g + 8 * (k & 1) + 4 * hh) = w; } }
    __syncthreads();
}

__global__ void __launch_bounds__(NTHR, 2) hybrid_fwd(Args a) {
    extern __shared__ __attribute__((aligned(16))) unsigned char lds_raw[];
    LAS unsigned char* lds = (LAS unsigned char*)lds_raw;
    cg::grid_group grid = cg::this_grid();
    const int tid = threadIdx.x, lane = tid & 63, wave = __builtin_amdgcn_readfirstlane(tid >> 6);
    const int bx = blockIdx.x, G = gridDim.x, gw = bx * NWAVES + wave, NGW = G * NWAVES;
    unsigned char* ws = a.ws;
    const float* MOD = (const float*)(ws + WS_MOD);
    bf16* H = (bf16*)(ws + WS_H); bf16* PROJ = (bf16*)(ws + WS_PROJ); bf16* MIX = (bf16*)(ws + WS_MIX);

    if (tid < 4) ((LAS unsigned*)(lds + LDS_BYTES - 16))[tid] = 0u;
    __syncthreads();
    XcdBarrier xbar = xcd_barrier_post((unsigned*)ws, (volatile LAS unsigned*)(lds + LDS_BYTES - 16));
    phase0(a, lds, tid, lane, wave);
    xcd_barrier(xbar);
    norm_rows(a.in[0], a.in[2], MOD, H, gw, NGW, lane);
    __syncthreads();
    s5_tables(a, lds, bx * NTHR + tid, G * NTHR);
    {
        const bf16* WT = (const bf16*)(ws + WS_WIN1); float* SHW = (float*)(ws + WS_SHW);
        for (int col = gw; col < NP; col += NGW) {
            const u32x4 w0 = *(const u32x4*)(WT + (size_t)col * D + 16 * lane), w1 = *(const u32x4*)(WT + (size_t)col * D + 16 * lane + 8);
            float wf[16];
#pragma unroll
            for (int e = 0; e < 4; ++e) { wf[2 * e] = bflo(w0[e]); wf[2 * e + 1] = bfhi(w0[e]); wf[8 + 2 * e] = bflo(w1[e]); wf[8 + 2 * e + 1] = bfhi(w1[e]); }
#pragma unroll
            for (int b = 0; b < 4; ++b) { const float* sh = MOD + (4 + b) * 3072 + 16 * lane; float s = 0.f;
#pragma unroll
                for (int e = 0; e < 16; ++e) s += sh[e] * wf[e];
                s = wave_sum(s); if (lane == 0) SHW[b * 3072 + col] = s; } } }
    xcd_barrier(xbar);
    {   pg8::Gemm g{H, (const bf16*)(ws + WS_WIN0), M, NP, D}; pg8::StaticOrder S; S.init(M, NP, G, bx); pg8::EpiStore E{PROJ, NP};
        pg8::gemm_phase<pg8::EpiStore, pg8::StaticOrder, true, true>(lds, g, S, E); }
    xcd_barrier(xbar);
    for (int it = bx; it < 1024; it += G) prep_item<0>(a, lds, it, tid);
    for (int it = bx; it < 512; it += G) lru_item<1>(a, lds, it, tid, lane, wave);
    {
        const bf16* WT = (const bf16*)(ws + WS_WIN1); bf16* W1S = (bf16*)(ws + WS_W1S); const float* gain = a.in[16];
        for (int c = bx * NTHR + tid; c < 4 * 3072 * 128; c += G * NTHR) { const int b = c / (3072 * 128), rem = c % (3072 * 128), k8 = (rem & 127) * 8;
            const u32x4 wv = *(const u32x4*)(WT + (size_t)rem * 8); const float* sc = MOD + (4 + b) * 3072 + 1024 + k8; u32x4 o;
#pragma unroll
            for (int e = 0; e < 4; ++e) o[e] = pk2(bflo(wv[e]) * gain[k8 + 2 * e] * (1.f + sc[2 * e]), bfhi(wv[e]) * gain[k8 + 2 * e + 1] * (1.f + sc[2 * e + 1]));
            *(u32x4*)(W1S + (size_t)c * 8) = o; } }
    xcd_barrier(xbar);
    if (G == 256) {
        const int xcd = bx & 7, j = bx >> 3;
#pragma unroll 1
        for (int r = 0; r < 4; ++r) { const int bh = 4 * xcd + r, m = (r & 1) ? 31 - j : j; moba_item(a, lds, m * 32 + bh, tid, lane, wave); }
    } else {
#pragma unroll 1
        for (int it = bx; it < 1024; it += G) moba_item(a, lds, 1023 - it, tid, lane, wave);
    }
    for (int it = bx; it < 512; it += G) lru_item<2>(a, lds, it, tid, lane, wave);
    xcd_barrier(xbar);
    {   pg8::Gemm g{MIX, (const bf16*)(ws + WS_WOUT0), M, D, D}; pg8::StaticOrder S; S.init(M, D, G, bx);
        pg8::EpiRes1 E{a.in[0], MOD + 2048, (bf16*)(ws + WS_X1B), (float*)(ws + WS_SS)};
        pg8::gemm_phase<pg8::EpiRes1, pg8::StaticOrder, true, true>(lds, g, S, E); }
    xcd_barrier(xbar);
    {   pg8::Gemm g{(const bf16*)(ws + WS_X1B), (const bf16*)(ws + WS_W1S), M, NP, D, (size_t)3072 * 1024 * 2}; pg8::StaticOrder S; S.init(M, NP, G, bx); pg8::EpiStoreN E{PROJ, NP, (const float*)(ws + WS_SS), (const float*)(ws + WS_SHW)};
        pg8::gemm_phase<pg8::EpiStoreN, pg8::StaticOrder, true, true>(lds, g, S, E); }
    xcd_barrier(xbar);
    for (int it = bx; it < 1024; it += G) prep_item<1>(a, lds, it, tid);
    for (int it = bx; it < 512; it += G) s5_pass1(a, lds, it, tid, lane, wave);
    xcd_barrier(xbar);
    for (int it = bx; it < 512; it += G) s5_pass2(a, lds, it, tid, lane, wave);
    if (G == 256) {
#pragma unroll 1
        for (int k = 0; k < 4; ++k) { const int bh = (bx & 7) + 8 * k, qi = 8 * (bx >> 3) + wave; sb_item(a, lds + wave * 4608, (qi << 5) | bh, lane); }
    } else {
        for (int it = gw; it < 8192; it += NGW) sb_item(a, lds + wave * 4608, it, lane);
    }
    xcd_barrier(xbar);
    {   pg8::Gemm g{H, (const bf16*)(ws + WS_WGLU), M, 1024, 512}; pg8::StaticOrder S; S.init(M, 1024, G, bx); pg8::EpiGlu E{a.in[31], PROJ, MIX};
        pg8::gemm_phase<pg8::EpiGlu, pg8::StaticOrder, true, true>(lds, g, S, E); }
    xcd_barrier(xbar);
    {   pg8::Gemm g{MIX, (const bf16*)(ws + WS_WOUT1), M, D, D}; pg8::StaticOrder S; S.init(M, D, G, bx); pg8::EpiRes2 E{(const bf16*)(ws + WS_X1B), a.out, MOD + 4 * 3072 + 2048};
        pg8::gemm_phase<pg8::EpiRes2, pg8::StaticOrder, true, true>(lds, g, S, E); }
    if (gridDim.y == 0x7fffu) grid.sync();
}

extern "C" void kernel_launch(void* const* d_in, const int* in_sizes, int n_in, void* d_out, int out_size, void* d_ws, size_t ws_size, hipStream_t stream) {
    static int grid = 0;
    if (grid == 0) {
        if (n_in != 33 || out_size != M * D || ws_size < WS_END) { fprintf(stderr, "kernel_launch: unexpected shapes (n_in %d out %d ws %zu)\n", n_in, out_size, ws_size); grid = -1; return; }
        int dev = 0, cus = 0, per_cu = 0;
        hipGetDevice(&dev); hipDeviceGetAttribute(&cus, hipDeviceAttributeMultiprocessorCount, dev);
        hipFuncSetAttribute((const void*)hybrid_fwd, hipFuncAttributeMaxDynamicSharedMemorySize, LDS_BYTES);
        hipOccupancyMaxActiveBlocksPerMultiprocessor(&per_cu, (const void*)hybrid_fwd, NTHR, LDS_BYTES);
        if (per_cu < 1) per_cu = 1;
        grid = cus * per_cu; if (grid > 256) grid = 256;
        (void)hipGetLastError();
    }
    if (grid < 0) return;
    if (hipMemsetAsync(d_ws, 0, 262144, stream) != hipSuccess) { fprintf(stderr, "kernel_launch: memset failed\n"); return; }
    Args a{};
    for (int i = 0; i < 33; ++i) a.in[i] = (const float*)d_in[i];
    a.out = (float*)d_out; a.ws = (unsigned char*)d_ws;
    void* args[] = {&a};
    hipError_t e = hipLaunchCooperativeKernel((const void*)hybrid_fwd, dim3(grid), dim3(NTHR), args, LDS_BYTES, stream);
    if (e != hipSuccess) fprintf(stderr, "cooperative launch failed: %s (grid %d)\n", hipGetErrorString(e), grid);
}
```

```cpp
#include <hip/hip_runtime.h>
#include <hip/hip_cooperative_groups.h>
#include <cstdio>
#include <cstdint>
namespace cg = cooperative_groups;
namespace pg8 {
#define PG8_LAS __attribute__((address_space(3)))
typedef unsigned short bf16_t;
typedef short bf16x8 __attribute__((ext_vector_type(8)));
typedef float f32x4 __attribute__((ext_vector_type(4)));
typedef unsigned u32x4 __attribute__((ext_vector_type(4)));
constexpr int BM = 256, BK = 64, HALF = 128, HTB = HALF * BK * 2  , STAGE_BYTES = 8 * HTB, NXCD = 8, WGM = 8;

__host__ __device__ __forceinline__ int lds_byte(int r, int c) { const int st = (r >> 4) * 2 + (c >> 5), rr = r & 15, cc = c & 31, ob = rr * 64 + cc * 2; return st * 1024 + (ob ^ (((ob >> 9) & 1) << 5)); }
__host__ __device__ __forceinline__ void stage_rc(int b, int& R, int& C) { const int st = b / 1024, sb = b % 1024, swz = sb ^ (((sb >> 9) & 1) << 5); R = (st >> 1) * 16 + swz / 64; C = (st & 1) * 32 + (swz % 64) / 2; }
__host__ __device__ __forceinline__ int perm32(int rho) { const int n = rho >> 4, i = rho & 15; return 8 * (i >> 2) + 4 * n + (i & 3); }

struct Unit { int pm, pn; };
struct Gemm { const bf16_t* A; const bf16_t* Bt; int M, N, K; size_t bstride; };

struct StaticOrder {
    int nM, nN, nwg, G, c;
    __host__ __device__ void init(int M, int N, int G_, int c_) { nM = M / BM; nN = N / BM; nwg = nM * nN; G = G_; c = c_; }
    __host__ __device__ bool next(int i, Unit& u) const {
        const long L = (long)i * G + c; if (L >= nwg) return false;
        int wgid = (int)L; { const int q = nwg / NXCD, r = nwg % NXCD, xcd = wgid % NXCD, off = wgid / NXCD; wgid = (xcd < r ? xcd * (q + 1) : r * (q + 1) + (xcd - r) * q) + off; }
        const int nig = WGM * nN, gid = wgid / nig, fm = gid * WGM, gsz = (nM - fm) < WGM ? (nM - fm) : WGM;
        u.pm = fm + ((wgid % nig) % gsz); u.pn = (wgid % nig) / gsz; return true;
    }
    __device__ __forceinline__ void a_ready(const Unit&) const {}
    __device__ __forceinline__ void done(const Unit&) const {}
};

typedef __bf16 hwbf2 __attribute__((ext_vector_type(2)));
typedef float f32x2p __attribute__((ext_vector_type(2)));
__device__ __forceinline__ unsigned pk2f(float lo, float hi) { f32x2p v; v.x = lo; v.y = hi; return __builtin_bit_cast(unsigned, __builtin_convertvector(v, hwbf2)); }
__device__ __forceinline__ float bflo(unsigned w) { return __builtin_bit_cast(float, w << 16); }
__device__ __forceinline__ float bfhi(unsigned w) { return __builtin_bit_cast(float, w & 0xffff0000u); }
struct EpiStore {
    static constexpr bool PERM = true, AFTER_DRAIN = false;
    bf16_t* O; int ldc;
    __device__ __forceinline__ void operator()(const f32x4 (&acc)[2][2][4][2], const Unit& u, int wr, int wc, int fr, int fq) const {
        const int row0 = u.pm * BM + wr * 64 + fr, col0 = u.pn * BM + wc * 32 + 8 * fq;
#pragma unroll
        for (int ai = 0; ai < 2; ++ai)
#pragma unroll
            for (int m = 0; m < 4; ++m) { bf16_t* rowp = O + (size_t)(row0 + ai * HALF + m * 16) * ldc + col0;
#pragma unroll
                for (int bj = 0; bj < 2; ++bj) { const f32x4 v0 = acc[ai][bj][m][0], v1 = acc[ai][bj][m][1];
                    u32x4 w; w.x = pk2f(v0[0], v0[1]); w.y = pk2f(v0[2], v0[3]); w.z = pk2f(v1[0], v1[1]); w.w = pk2f(v1[2], v1[3]);
                    *(u32x4*)(rowp + bj * HALF) = w; } }
    }
};
struct EpiRes {
    static constexpr bool PERM = false, AFTER_DRAIN = false;
    const float* X; float* O; const float* gate;
    __device__ __forceinline__ void operator()(const f32x4 (&acc)[2][2][4][2], const Unit& u, int wr, int wc, int fr, int fq) const {
        const int row0 = u.pm * BM + wr * 64 + fr, col0 = u.pn * BM + wc * 32 + 4 * fq, b = (u.pm * BM) >> 13;
        f32x4 gv[2][2];
#pragma unroll
        for (int bj = 0; bj < 2; ++bj)
#pragma unroll
            for (int n = 0; n < 2; ++n) gv[bj][n] = *(const f32x4*)(gate + b * 3072 + col0 + bj * HALF + n * 16);
#pragma unroll
        for (int ai = 0; ai < 2; ++ai)
#pragma unroll
            for (int m = 0; m < 4; ++m) { const size_t ro = (size_t)(row0 + ai * HALF + m * 16) * 1024 + col0;
#pragma unroll
                for (int bj = 0; bj < 2; ++bj)
#pragma unroll
                    for (int n = 0; n < 2; ++n) { const size_t idx = ro + bj * HALF + n * 16; const f32x4 xv = *(const f32x4*)(X + idx); *(f32x4*)(O + idx) = xv + gv[bj][n] * acc[ai][bj][m][n]; } }
    }
};
struct EpiRes1 {
    static constexpr bool PERM = true, AFTER_DRAIN = false;
    const float* X; const float* gate; bf16_t* X1B; float* SS;
    __device__ __forceinline__ void operator()(const f32x4 (&acc)[2][2][4][2], const Unit& u, int wr, int wc, int fr, int fq) const {
        const int row0 = u.pm * BM + wr * 64 + fr, col0 = u.pn * BM + wc * 32 + 8 * fq, b = (u.pm * BM) >> 13;
        f32x4 gv[2][2];
#pragma unroll
        for (int bj = 0; bj < 2; ++bj)
#pragma unroll
            for (int n = 0; n < 2; ++n) gv[bj][n] = *(const f32x4*)(gate + b * 3072 + col0 + bj * HALF + n * 4);
#pragma unroll
        for (int ai = 0; ai < 2; ++ai)
#pragma unroll
        for (int mh = 0; mh < 2; ++mh) {
            f32x4 xv[2][2][2];
#pragma unroll
            for (int mm = 0; mm < 2; ++mm)
#pragma unroll
                for (int bj = 0; bj < 2; ++bj) { const size_t idx = (size_t)(row0 + ai * HALF + (2 * mh + mm) * 16) * 1024 + col0 + bj * HALF; xv[mm][bj][0] = *(const f32x4*)(X + idx); xv[mm][bj][1] = *(const f32x4*)(X + idx + 4); }
#pragma unroll
            for (int mm = 0; mm < 2; ++mm) { const int m = 2 * mh + mm; const int row = row0 + ai * HALF + m * 16; const size_t ro = (size_t)row * 1024 + col0; float s = 0.f;
#pragma unroll
                for (int bj = 0; bj < 2; ++bj) { const size_t idx = ro + bj * HALF;
                    const f32x4 y0 = xv[mm][bj][0] + gv[bj][0] * acc[ai][bj][m][0], y1 = xv[mm][bj][1] + gv[bj][1] * acc[ai][bj][m][1];
                    s += ((y0[0] * y0[0] + y0[1] * y0[1]) + (y0[2] * y0[2] + y0[3] * y0[3])) + ((y1[0] * y1[0] + y1[1] * y1[1]) + (y1[2] * y1[2] + y1[3] * y1[3]));
                    u32x4 w; w.x = pk2f(y0[0], y0[1]); w.y = pk2f(y0[2], y0[3]); w.z = pk2f(y1[0], y1[1]); w.w = pk2f(y1[2], y1[3]); *(u32x4*)(X1B + idx) = w; }
                s += __shfl_xor(s, 16); s += __shfl_xor(s, 32);
                if (fq == 0) __hip_atomic_fetch_add(SS + row, s, __ATOMIC_RELAXED, __HIP_MEMORY_SCOPE_AGENT); }
        }
    }
};
struct EpiRes2 {
    static constexpr bool PERM = true, AFTER_DRAIN = false;
    const bf16_t* X1B; float* O; const float* gate;
    __device__ __forceinline__ void operator()(const f32x4 (&acc)[2][2][4][2], const Unit& u, int wr, int wc, int fr, int fq) const {
        const int row0 = u.pm * BM + wr * 64 + fr, col0 = u.pn * BM + wc * 32 + 8 * fq, b = (u.pm * BM) >> 13;
        f32x4 gv[2][2];
#pragma unroll
        for (int bj = 0; bj < 2; ++bj)
#pragma unroll
            for (int n = 0; n < 2; ++n) gv[bj][n] = *(const f32x4*)(gate + b * 3072 + col0 + bj * HALF + n * 4);
#pragma unroll
        for (int ai = 0; ai < 2; ++ai) {
            u32x4 xw[4][2];
#pragma unroll
            for (int m = 0; m < 4; ++m)
#pragma unroll
                for (int bj = 0; bj < 2; ++bj) xw[m][bj] = *(const u32x4*)(X1B + (size_t)(row0 + ai * HALF + m * 16) * 1024 + col0 + bj * HALF);
#pragma unroll
            for (int m = 0; m < 4; ++m) { const size_t ro = (size_t)(row0 + ai * HALF + m * 16) * 1024 + col0;
#pragma unroll
                for (int bj = 0; bj < 2; ++bj) { const size_t idx = ro + bj * HALF; const u32x4 q = xw[m][bj];
                    f32x4 x0, x1; x0[0] = bflo(q.x); x0[1] = bfhi(q.x); x0[2] = bflo(q.y); x0[3] = bfhi(q.y); x1[0] = bflo(q.z); x1[1] = bfhi(q.z); x1[2] = bflo(q.w); x1[3] = bfhi(q.w);
                    *(f32x4*)(O + idx) = x0 + gv[bj][0] * acc[ai][bj][m][0]; *(f32x4*)(O + idx + 4) = x1 + gv[bj][1] * acc[ai][bj][m][1]; } }
        }
    }
};
struct EpiStoreN {
    static constexpr bool PERM = true, AFTER_DRAIN = false;
    bf16_t* O; int ldc; const float* SS; const float* shw;
    __device__ __forceinline__ void operator()(const f32x4 (&acc)[2][2][4][2], const Unit& u, int wr, int wc, int fr, int fq) const {
        const int row0 = u.pm * BM + wr * 64 + fr, col0 = u.pn * BM + wc * 32 + 8 * fq, b = (u.pm * BM) >> 13;
        f32x4 sw[2][2];
#pragma unroll
        for (int bj = 0; bj < 2; ++bj) { sw[bj][0] = *(const f32x4*)(shw + b * 3072 + col0 + bj * HALF); sw[bj][1] = *(const f32x4*)(shw + b * 3072 + col0 + bj * HALF + 4); }
        float ssv[2][4];
#pragma unroll
        for (int ai = 0; ai < 2; ++ai)
#pragma unroll
            for (int m = 0; m < 4; ++m) ssv[ai][m] = SS[row0 + ai * HALF + m * 16];
#pragma unroll
        for (int ai = 0; ai < 2; ++ai)
#pragma unroll
            for (int m = 0; m < 4; ++m) { const int row = row0 + ai * HALF + m * 16; bf16_t* rowp = O + (size_t)row * ldc + col0;
                const float rstd = __builtin_amdgcn_rsqf(ssv[ai][m] * (1.f / 1024.f) + 1e-6f);
#pragma unroll
                for (int bj = 0; bj < 2; ++bj) { const f32x4 v0 = acc[ai][bj][m][0] * rstd + sw[bj][0], v1 = acc[ai][bj][m][1] * rstd + sw[bj][1];
                    u32x4 w; w.x = pk2f(v0[0], v0[1]); w.y = pk2f(v0[2], v0[3]); w.z = pk2f(v1[0], v1[1]); w.w = pk2f(v1[2], v1[3]);
                    *(u32x4*)(rowp + bj * HALF) = w; } }
    }
};
struct EpiGlu {
    static constexpr bool PERM = true, AFTER_DRAIN = false;
    const float* bias; const bf16_t* proj; bf16_t* mix;
    __device__ __forceinline__ void operator()(const f32x4 (&acc)[2][2][4][2], const Unit& u, int wr, int wc, int fr, int fq) const {
        const int row0 = u.pm * BM + wr * 64 + fr, colv = u.pn * 128 + wc * 32 + 8 * fq;
        const f32x4 bv0 = *(const f32x4*)(bias + colv), bv1 = *(const f32x4*)(bias + colv + 4), bg0 = *(const f32x4*)(bias + 512 + colv), bg1 = *(const f32x4*)(bias + 512 + colv + 4);
        u32x4 gsv[2][4];
#pragma unroll
        for (int ai = 0; ai < 2; ++ai)
#pragma unroll
            for (int m = 0; m < 4; ++m) gsv[ai][m] = *(const u32x4*)(proj + (size_t)(row0 + ai * HALF + m * 16) * 3072 + 2560 + colv);
#pragma unroll
        for (int ai = 0; ai < 2; ++ai)
#pragma unroll
            for (int m = 0; m < 4; ++m) { const size_t row = (size_t)(row0 + ai * HALF + m * 16);
                const u32x4 gs = gsv[ai][m];
                const f32x4 va = acc[ai][0][m][0] + bv0, vb = acc[ai][0][m][1] + bv1, ga = acc[ai][1][m][0] + bg0, gb = acc[ai][1][m][1] + bg1;
                float y[8];
#pragma unroll
                for (int e = 0; e < 4; ++e) { const float g0 = (e & 1) ? bfhi(gs[e >> 1]) : bflo(gs[e >> 1]); const float g1 = (e & 1) ? bfhi(gs[2 + (e >> 1)]) : bflo(gs[2 + (e >> 1)]);
                    y[e] = va[e] * __builtin_amdgcn_rcpf(1.f + __expf(-ga[e])) * (g0 * __builtin_amdgcn_rcpf(1.f + __expf(-g0))); y[4 + e] = vb[e] * __builtin_amdgcn_rcpf(1.f + __expf(-gb[e])) * (g1 * __builtin_amdgcn_rcpf(1.f + __expf(-g1))); }
                u32x4 w; w.x = pk2f(y[0], y[1]); w.y = pk2f(y[2], y[3]); w.z = pk2f(y[4], y[5]); w.w = pk2f(y[6], y[7]);
                *(u32x4*)(mix + row * 1024 + 512 + colv) = w; }
    }
};
template <class Epi, class Sched, bool ALIGN_EPI = false, bool SP2 = false>
__device__ __forceinline__ void gemm_phase(PG8_LAS unsigned char* lds, const Gemm g, const Sched& S, const Epi& E) {
    int tid_ = threadIdx.x; asm volatile("" : "+v"(tid_));
    const int tid = tid_, wid = __builtin_amdgcn_readfirstlane(tid >> 6), lane = tid & 63, wr = wid >> 2, wc = wid & 3, fr = lane & 15, fq = lane >> 4;
    const int K = g.K, nt = K / BK;
    unsigned voffA[2], voffB[2];
#pragma unroll
    for (int i = 0; i < 2; ++i) { int R, C; stage_rc(tid * 16 + i * 8192, R, C); const int Rb = Epi::PERM ? ((R & ~31) + perm32(R & 31)) : R;
        voffA[i] = (unsigned)(R * K + C) * 2u; voffB[i] = (unsigned)(Rb * K + C) * 2u; }
    const size_t kstep = (size_t)(BK * 2);
    const size_t hstep = (size_t)HALF * K * 2;
    const size_t tstep = 2 * hstep;
    const unsigned ldsw = (unsigned)wid * 1024u;
    const int aoff = lds_byte(wr * 64 + fr, fq * 8), boff = lds_byte(wc * 32 + fr, fq * 8);
#define PG8_SA(b, h) (((b) * 2 + (h)) * HTB)
#define PG8_SB(b, h) ((4 + (b) * 2 + (h)) * HTB)
#define PG8_STAGE(bufoff, gbase, voff) do { _Pragma("unroll") for (int _i = 0; _i < 2; ++_i) \
        __builtin_amdgcn_global_load_lds((const unsigned*)((const char*)(gbase) + (voff)[_i]), (PG8_LAS unsigned*)(lds + (bufoff) + ldsw + _i * 8192), 16, 0, 0); } while (0)
#define PG8_LDA(dst, b, h) do { _Pragma("unroll") for (int m = 0; m < 4; ++m) _Pragma("unroll") for (int k = 0; k < 2; ++k) dst[m][k] = *(const PG8_LAS bf16x8*)(lds + PG8_SA(b, h) + aoff + m * 2048 + k * 1024); } while (0)
#define PG8_LDB(dst, b, h) do { _Pragma("unroll") for (int n = 0; n < 2; ++n) _Pragma("unroll") for (int k = 0; k < 2; ++k) dst[n][k] = *(const PG8_LAS bf16x8*)(lds + PG8_SB(b, h) + boff + n * 2048 + k * 1024); } while (0)
#define PG8_MMA(ai, bj, At, Bt) do { __builtin_amdgcn_s_setprio(1); _Pragma("unroll") for (int m = 0; m < 4; ++m) _Pragma("unroll") for (int n = 0; n < 2; ++n) _Pragma("unroll") for (int k = 0; k < 2; ++k) \
        acc[ai][bj][m][n] = __builtin_amdgcn_mfma_f32_16x16x32_bf16(Bt[n][k], At[m][k], acc[ai][bj][m][n], 0, 0, 0); __builtin_amdgcn_s_setprio(0); } while (0)
#define PG8_WAIT_V(n) asm volatile("s_waitcnt vmcnt(" #n ")" ::: "memory")
#define PG8_WAIT_L(n) asm volatile("s_waitcnt lgkmcnt(" #n ")" ::: "memory")
#define PG8_BAR __builtin_amdgcn_s_barrier()
#define PG8_SCHED __builtin_amdgcn_sched_barrier(0)
    Unit cur, nxt; int ui = 0;
    if (!S.next(0, cur)) return;
    f32x4 acc[2][2][4][2];
#pragma unroll
    for (int a = 0; a < 2; ++a)
#pragma unroll
        for (int b = 0; b < 2; ++b)
#pragma unroll
            for (int m = 0; m < 4; ++m)
#pragma unroll
                for (int n = 0; n < 2; ++n) acc[a][b][m][n] = (f32x4){0.f, 0.f, 0.f, 0.f};
    bf16x8 At[4][2], B0[2][2], B1[2][2];
    const char* cA = (const char*)g.A + (size_t)cur.pm * tstep; const char* cB = (const char*)g.Bt + (size_t)cur.pn * tstep + (size_t)(cur.pm >> 5) * g.bstride;
    S.a_ready(cur);
    if constexpr (SP2) {
        PG8_STAGE(PG8_SB(0, 0), cB, voffB); PG8_STAGE(PG8_SB(0, 1), cB + hstep, voffB); PG8_STAGE(PG8_SA(0, 0), cA, voffA); PG8_STAGE(PG8_SA(0, 1), cA + hstep, voffA);
        if (wr == 1) PG8_BAR;
        PG8_WAIT_V(2); PG8_BAR;
        PG8_STAGE(PG8_SB(1, 0), cB + kstep, voffB); PG8_STAGE(PG8_SA(1, 0), cA + kstep, voffA); PG8_STAGE(PG8_SB(1, 1), cB + hstep + kstep, voffB);
        PG8_WAIT_V(6); PG8_BAR;
    } else {
        PG8_STAGE(PG8_SB(0, 0), cB, voffB); PG8_STAGE(PG8_SA(0, 0), cA, voffA); PG8_STAGE(PG8_SB(0, 1), cB + hstep, voffB); PG8_STAGE(PG8_SA(0, 1), cA + hstep, voffA);
        if (wr == 1) PG8_BAR;
        PG8_WAIT_V(4); PG8_BAR;
        PG8_STAGE(PG8_SB(1, 0), cB + kstep, voffB); PG8_STAGE(PG8_SA(1, 0), cA + kstep, voffA); PG8_STAGE(PG8_SB(1, 1), cB + hstep + kstep, voffB);
        PG8_WAIT_V(6); PG8_BAR;
    }
    for (;;) {
        const bool has_next = S.next(ui + 1, nxt);
        const char* nA = has_next ? (const char*)g.A + (size_t)nxt.pm * tstep : cA; const char* nB = has_next ? (const char*)g.Bt + (size_t)nxt.pn * tstep + (size_t)(nxt.pm >> 5) * g.bstride : cB;
        for (int t = 0; t < nt; t += 2) {
            const bool last = (t == nt - 2);
            const char* a1 = cA + (size_t)(t + 1) * kstep;
            const char* a2 = last ? nA : cA + (size_t)(t + 2) * kstep; const char* b2 = last ? nB : cB + (size_t)(t + 2) * kstep;
            const char* a3 = a2 + kstep; const char* b3 = b2 + kstep;
            if (last && has_next) S.a_ready(nxt);
            if constexpr (SP2) {
            PG8_LDB(B0, 0, 0); PG8_LDB(B1, 0, 1); PG8_SCHED; PG8_LDA(At, 0, 0); PG8_STAGE(PG8_SA(1, 1), a1 + hstep, voffA);
            PG8_WAIT_V(8); PG8_WAIT_L(0); PG8_BAR; PG8_MMA(0, 0, At, B0); PG8_MMA(0, 1, At, B1); PG8_BAR; PG8_SCHED;
            PG8_LDA(At, 0, 1); PG8_STAGE(PG8_SB(0, 0), b2, voffB); PG8_STAGE(PG8_SB(0, 1), b2 + hstep, voffB); PG8_STAGE(PG8_SA(0, 0), a2, voffA);
            PG8_WAIT_V(8); PG8_WAIT_L(0); PG8_BAR; PG8_MMA(1, 0, At, B0); PG8_MMA(1, 1, At, B1); PG8_BAR; PG8_SCHED;
            PG8_LDB(B0, 1, 0); PG8_LDB(B1, 1, 1); PG8_SCHED; PG8_LDA(At, 1, 0); PG8_STAGE(PG8_SA(0, 1), a2 + hstep, voffA);
            PG8_WAIT_V(8); PG8_WAIT_L(0); PG8_BAR; PG8_MMA(0, 0, At, B0); PG8_MMA(0, 1, At, B1); PG8_BAR; PG8_SCHED;
            PG8_LDA(At, 1, 1); PG8_STAGE(PG8_SB(1, 0), b3, voffB); PG8_STAGE(PG8_SB(1, 1), b3 + hstep, voffB); PG8_STAGE(PG8_SA(1, 0), a3, voffA);
            PG8_WAIT_V(8); PG8_WAIT_L(0); PG8_BAR; PG8_MMA(1, 0, At, B0); PG8_MMA(1, 1, At, B1); PG8_BAR; PG8_SCHED;
            } else {
            PG8_LDB(B0, 0, 0); PG8_SCHED; PG8_LDA(At, 0, 0); PG8_STAGE(PG8_SA(1, 1), a1 + hstep, voffA);
            PG8_WAIT_L(8); PG8_BAR; PG8_WAIT_L(0); PG8_MMA(0, 0, At, B0); PG8_BAR; PG8_SCHED;
            PG8_LDB(B1, 0, 1); PG8_STAGE(PG8_SB(0, 0), b2, voffB);
            PG8_BAR; PG8_WAIT_L(0); PG8_MMA(0, 1, At, B1); PG8_BAR;
            PG8_LDA(At, 0, 1); PG8_STAGE(PG8_SA(0, 0), a2, voffA);
            PG8_BAR; PG8_WAIT_L(0); PG8_MMA(1, 0, At, B0); PG8_BAR; PG8_SCHED;
            PG8_STAGE(PG8_SB(0, 1), b2 + hstep, voffB);
            PG8_WAIT_V(6); PG8_BAR; PG8_MMA(1, 1, At, B1); PG8_BAR;
            PG8_LDB(B0, 1, 0); PG8_SCHED; PG8_LDA(At, 1, 0); PG8_STAGE(PG8_SA(0, 1), a2 + hstep, voffA);
            PG8_WAIT_L(8); PG8_BAR; PG8_WAIT_L(0); PG8_MMA(0, 0, At, B0); PG8_BAR; PG8_SCHED;
            PG8_LDB(B1, 1, 1); PG8_STAGE(PG8_SB(1, 0), b3, voffB);
            PG8_BAR; PG8_WAIT_L(0); PG8_MMA(0, 1, At, B1); PG8_BAR;
            PG8_LDA(At, 1, 1); PG8_STAGE(PG8_SA(1, 0), a3, voffA);
            PG8_BAR; PG8_WAIT_L(0); PG8_MMA(1, 0, At, B0); PG8_BAR; PG8_SCHED;
            PG8_STAGE(PG8_SB(1, 1), b3 + hstep, voffB);
            PG8_WAIT_V(6); PG8_BAR; PG8_MMA(1, 1, At, B1); PG8_BAR;
            }
        }
        if constexpr (ALIGN_EPI) { if (wr == 0) PG8_BAR; }
        if constexpr (!Epi::AFTER_DRAIN) { E(acc, cur, wr, wc, fr, fq); S.done(cur); }
        if (!has_next) break;
#pragma unroll
        for (int a = 0; a < 2; ++a)
#pragma unroll
            for (int b = 0; b < 2; ++b)
#pragma unroll
                for (int m = 0; m < 4; ++m)
#pragma unroll
                    for (int n = 0; n < 2; ++n) acc[a][b][m][n] = (f32x4){0.f, 0.f, 0.f, 0.f};
        cur = nxt; cA = nA; cB = nB; ++ui;
        if constexpr (ALIGN_EPI) { if (wr == 1) PG8_BAR; }
    }
    PG8_WAIT_V(0);
    if constexpr (!ALIGN_EPI) { if (wr == 0) PG8_BAR; }
    PG8_BAR;
    if constexpr (Epi::AFTER_DRAIN) { E.fused(acc, cur, wr, wc, fr, fq, lds, wid, lane); S.done(cur); }
#undef PG8_SA
#undef PG8_SB
#undef PG8_STAGE
#undef PG8_LDA
#undef PG8_LDB
#undef PG8_MMA
#undef PG8_WAIT_V
#undef PG8_WAIT_L
#undef PG8_BAR
#undef PG8_SCHED
}
}
#define DI __device__ __forceinline__
#define LAS __attribute__((address_space(3)))
typedef unsigned short bf16;
typedef short bf16x8 __attribute__((ext_vector_type(8)));
typedef float f32x4 __attribute__((ext_vector_type(4)));
typedef float f32x2 __attribute__((ext_vector_type(2)));
typedef float f32x16 __attribute__((ext_vector_type(16)));
typedef unsigned u32x4 __attribute__((ext_vector_type(4)));
typedef unsigned u32x2 __attribute__((ext_vector_type(2)));
#define MFMA32(a, b, c) __builtin_amdgcn_mfma_f32_32x32x16_bf16((a), (b), (c), 0, 0, 0)

constexpr int NB = 4, T = 8192, D = 1024, M = NB * T, NP = 3072;
constexpr int NWAVES = 8, NTHR = 512;
constexpr int LDS_BYTES = 155648;
constexpr size_t MiB = 1u << 20;
constexpr size_t WS_MOD = 1 * MiB;
constexpr size_t WS_SS = 128 * 1024;
constexpr size_t WS_SHW = 1 * MiB + 256 * 1024;
constexpr size_t WS_GW = 1 * MiB + 512 * 1024;
constexpr size_t WS_ABL = 2 * MiB;
constexpr size_t WS_BB = 2 * MiB + 65536;
constexpr size_t WS_PW = 3 * MiB;
constexpr size_t WS_F = 5 * MiB;
constexpr size_t WS_VBIG = 8 * MiB;
constexpr size_t WS_WBIG = 16 * MiB;
constexpr size_t WS_WIN0 = 24 * MiB, WS_WOUT0 = 30 * MiB, WS_WIN1 = 32 * MiB, WS_WGLU = 38 * MiB, WS_WOUT1 = 39 * MiB;
constexpr size_t WS_KMEAN = 41 * MiB;
constexpr size_t WS_LRUSUM = 42 * MiB;
constexpr size_t WS_S5S = 44 * MiB;
constexpr size_t WS_VT = 52 * MiB;
constexpr size_t WS_H = 84 * MiB;
constexpr size_t WS_MIX = 148 * MiB;
constexpr size_t WS_PROJ = 212 * MiB;
constexpr size_t WS_KF = 404 * MiB;
constexpr size_t WS_X1B = 436 * MiB;
constexpr size_t WS_W1S = 116 * MiB;
constexpr size_t WS_END = 500 * MiB;

struct Args { const float* in[33]; float* out; unsigned char* ws; };

DI unsigned f2bf(float f) { unsigned u = __builtin_bit_cast(unsigned, f); return (u + 0x7fffu + ((u >> 16) & 1u)) >> 16; }
DI unsigned pk2(float lo, float hi) { return pg8::pk2f(lo, hi); }
DI float bf2f(unsigned short b) { return __builtin_bit_cast(float, (unsigned)b << 16); }
DI float bflo(unsigned w) { return __builtin_bit_cast(float, w << 16); }
DI float bfhi(unsigned w) { return __builtin_bit_cast(float, w & 0xffff0000u); }
DI int crow(int reg, int h) { return (reg & 3) + 8 * (reg >> 2) + 4 * h; }
DI float sigm(float x) { return __builtin_amdgcn_rcpf(1.f + __expf(-x)); }
DI float silu(float x) { return x * __builtin_amdgcn_rcpf(1.f + __expf(-x)); }
DI bf16x8 mk8(u32x4 v) { return __builtin_bit_cast(bf16x8, v); }
DI bf16x8 pack8(float a0, float a1, float a2, float a3, float a4, float a5, float a6, float a7) { u32x4 v; v.x = pk2(a0, a1); v.y = pk2(a2, a3); v.z = pk2(a4, a5); v.w = pk2(a6, a7); return __builtin_bit_cast(bf16x8, v); }
DI f32x16 zero16() { f32x16 z;
#pragma unroll
  for (int i = 0; i < 16; ++i) z[i] = 0.f; return z; }

#define XB_TMO      128
#define XB_XCNT(j)  (256  + 64 * (j))
#define XB_XSUB(j)  (1280 + 64 * (j))
#define XB_XGEN(j)  (2304 + 64 * (j))
#define XB_TOP      3328
#define XB_TOPGEN   3392
#define XCD_BAR_WORDS 3456
#define XB_SPIN_CAP (1u << 18)

__device__ __forceinline__ unsigned xb_ld(unsigned* p)              { return __hip_atomic_load(p, __ATOMIC_RELAXED, __HIP_MEMORY_SCOPE_AGENT); }
__device__ __forceinline__ unsigned xb_add(unsigned* p, unsigned v) { return __hip_atomic_fetch_add(p, v, __ATOMIC_RELAXED, __HIP_MEMORY_SCOPE_AGENT); }
__device__ __forceinline__ unsigned xb_xcc_id() { return (unsigned)__builtin_amdgcn_s_getreg((3 << 11) | 20) & 0xFu; }
#define XB_SPIN(cond, bar) do { unsigned _sp = 0; while (cond) { __builtin_amdgcn_s_sleep(1); \
    if ((++_sp & 255u) == 0u) { if (xb_ld(&(bar)[XB_TMO])) break; if (_sp > XB_SPIN_CAP) { atomicAdd(&(bar)[XB_TMO], 1u); break; } } } } while (0)

struct XcdBarrier {
    unsigned* bar; unsigned x;
    volatile LAS unsigned* st;
};

__device__ __forceinline__ XcdBarrier xcd_barrier_post(unsigned* bar, volatile LAS unsigned* st) {
    XcdBarrier b; b.bar = bar; b.x = xb_xcc_id(); b.st = st;
    if (threadIdx.x == 0) (void)xb_add(&bar[XB_XCNT(b.x)], 1u);
    return b;
}
__device__ __forceinline__ void xcd_barrier_complete(unsigned* bar, unsigned x, unsigned& nloc, unsigned& nx) {
    const unsigned G = gridDim.x * gridDim.y * gridDim.z;
    unsigned sum, cnt, mine, sp = 0u;
    for (;;) {
        sum = 0u; cnt = 0u; mine = 0u;
#pragma unroll
        for (unsigned j = 0; j < 16; ++j) { const unsigned c = xb_ld(&bar[XB_XCNT(j)]); sum += c; cnt += (c > 0u) ? 1u : 0u; mine = (j == x) ? c : mine; }
        if (sum == G) break;
        __builtin_amdgcn_s_sleep(1);
        if ((++sp & 255u) == 0u) { if (xb_ld(&bar[XB_TMO])) break; if (sp > XB_SPIN_CAP) { atomicAdd(&bar[XB_TMO], 1u); break; } }
    }
    nloc = mine > 0u ? mine : 1u; nx = cnt > 0u ? cnt : 1u;
}

__device__ __forceinline__ void xcd_barrier(const XcdBarrier& b) {
    asm volatile("s_waitcnt vmcnt(0)" ::: "memory");
    __syncthreads();
    if (threadIdx.x == 0) {
        unsigned* bar = b.bar;
        __builtin_amdgcn_s_waitcnt(0);
        unsigned nloc = b.st[0], nx = b.st[1];
        if (nloc == 0u) { xcd_barrier_complete(bar, b.x, nloc, nx); b.st[0] = nloc; b.st[1] = nx; }
        const unsigned old = xb_add(&bar[XB_XSUB(b.x)], 1u);
        const unsigned gen = old / nloc;
        if (old + 1u == (gen + 1u) * nloc) {
            __builtin_amdgcn_fence(__ATOMIC_RELEASE, "agent");
            asm volatile("s_waitcnt vmcnt(0)" ::: "memory");
            const unsigned og = xb_add(&bar[XB_TOP], 1u);
            const unsigned tg = og / nx;
            if (og + 1u == (tg + 1u) * nx) xb_add(&bar[XB_TOPGEN], 1u);
            else XB_SPIN(xb_ld(&bar[XB_TOPGEN]) == tg, bar);
            __builtin_amdgcn_fence(__ATOMIC_ACQUIRE, "agent");
            xb_add(&bar[XB_XGEN(b.x)], 1u);
            asm volatile("s_waitcnt vmcnt(0)" ::: "memory");
        } else {
            XB_SPIN(xb_ld(&bar[XB_XGEN(b.x)]) == gen, bar);
            __builtin_amdgcn_fence(__ATOMIC_ACQUIRE, "agent");
            asm volatile("s_waitcnt vmcnt(0)" ::: "memory");
        }
    }
    __syncthreads();
}

DI void transpose_item(const float* W, int K, int N, bf16* WT, int dst_row0, LAS float* scr, int kb, int nb, int lane) {
    const int k0 = 64 * kb, n0 = 32 * nb;
#pragma unroll 8
    for (int i = 0; i < 32; ++i) { const int kk = 2 * i + (lane >> 5); scr[kk * 33 + (lane & 31)] = W[(size_t)(k0 + kk) * N + n0 + (lane & 31)]; }
    asm volatile("s_waitcnt lgkmcnt(0)" ::: "memory");
    const int c = lane & 7;
#pragma unroll
    for (int j = 0; j < 4; ++j) { const int n = (lane >> 3) + 8 * j; const LAS float* s = scr + (8 * c) * 33 + n;
        u32x4 o; o.x = pk2(s[0 * 33], s[1 * 33]); o.y = pk2(s[2 * 33], s[3 * 33]); o.z = pk2(s[4 * 33], s[5 * 33]); o.w = pk2(s[6 * 33], s[7 * 33]);
        *(u32x4*)(WT + (size_t)(dst_row0 + n) * K + k0 + 8 * c) = o; }
    asm volatile("s_waitcnt lgkmcnt(0)" ::: "memory");
}

DI void phase0(const Args& a, LAS unsigned char* lds, int tid, int lane, int wave) {
    unsigned char* ws = a.ws;
    const int bx = blockIdx.x;
    if (bx < 192) {
        const int layer = bx / 96, cc = bx % 96, l31 = lane & 31, hh = lane >> 5, col = 32 * cc + l31;
        const float* W = layer ? a.in[17] : a.in[3]; const float* cv = a.in[1];
        LAS float* SC = (LAS float*)lds;
        LAS float* red = (LAS float*)(lds + 16384);
        for (int i = tid; i < 4096; i += NTHR) SC[i] = silu(cv[i]);
        __syncthreads();
        float a0 = 0.f, a1 = 0.f, a2 = 0.f, a3 = 0.f;
        const float* wp = W + (size_t)(128 * wave + hh) * 3072 + col;
#pragma unroll 1
        for (int i0 = 0; i0 < 64; i0 += 16) { float wv[16];
#pragma unroll
            for (int i = 0; i < 16; ++i) wv[i] = wp[(size_t)(2 * (i0 + i)) * 3072];
#pragma unroll
            for (int i = 0; i < 16; ++i) { const int k = 128 * wave + 2 * (i0 + i) + hh; a0 += SC[k] * wv[i]; a1 += SC[1024 + k] * wv[i]; a2 += SC[2048 + k] * wv[i]; a3 += SC[3072 + k] * wv[i]; } }
        a0 += __shfl_xor(a0, 32); a1 += __shfl_xor(a1, 32); a2 += __shfl_xor(a2, 32); a3 += __shfl_xor(a3, 32);
        if (hh == 0) { red[(wave * 4 + 0) * 32 + l31] = a0; red[(wave * 4 + 1) * 32 + l31] = a1; red[(wave * 4 + 2) * 32 + l31] = a2; red[(wave * 4 + 3) * 32 + l31] = a3; }
        __syncthreads();
        if (tid < 128) { const int b = tid >> 5, l = tid & 31; float s = 0.f;
#pragma unroll
            for (int w = 0; w < 8; ++w) s += red[(w * 4 + b) * 32 + l];
            const float* bias = layer ? a.in[18] : a.in[4];
            ((float*)(ws + WS_MOD))[(layer * 4 + b) * 3072 + 32 * cc + l] = s + bias[32 * cc + l]; }
        __syncthreads();
    } else if (bx < 196) {
        const int gp = (bx - 192) * 512 + tid, g = gp >> 6;
        const float step = __expf(a.in[24][g]);
        const float lr = a.in[22][gp], li = a.in[23][gp];
        const float decay = __expf(lr * step);
        float rev = li * step * 0.15915494309189535f; rev -= floorf(rev);
        const float abr = decay * __builtin_amdgcn_cosf(rev), abi = decay * __builtin_amdgcn_sinf(rev);
        const float den = lr * lr + li * li;
        const float fr = ((abr - 1.f) * lr + abi * li) / den, fi = (abi * lr - (abr - 1.f) * li) / den;
        float* BB = (float*)(ws + WS_BB) + (size_t)gp * 32;
#pragma unroll
        for (int h = 0; h < 16; ++h) { const float br = a.in[25][gp * 16 + h], bi = a.in[26][gp * 16 + h]; BB[2 * h] = fr * br - fi * bi; BB[2 * h + 1] = fr * bi + fi * br; }
        float* PW = (float*)(ws + WS_PW) + ((size_t)g * 65 * 64 + (gp & 63)) * 2;
        float pr = 1.f, pi = 0.f;
        for (int t = 0; t < 64; ++t) { PW[(size_t)t * 128] = pr; PW[(size_t)t * 128 + 1] = pi; const float nr = pr * abr - pi * abi, ni = pr * abi + pi * abr; pr = nr; pi = ni; }
        PW[(size_t)64 * 128] = pr; PW[(size_t)64 * 128 + 1] = pi;
        float* ABL = (float*)(ws + WS_ABL) + gp * 2; ABL[0] = pr; ABL[1] = pi;
    }
    if (bx == 200 && tid == 0) { float gq = 0.f, gk = 0.f;
        for (int i = 0; i < 64; ++i) { gq = fmaxf(gq, fabsf(a.in[13][i])); gk = fmaxf(gk, fabsf(a.in[14][i])); }
        ((float*)(ws + WS_MOD))[2 * 4 * 3072] = 8.f * gq * gk; }
    if (bx >= 201 && bx < 217) {
        const int v = (bx - 201) * 512 + tid, ln = v & 63, s = (v >> 6) & 3, ct = (v >> 8) & 1, g = (v >> 9) & 7, gate = v >> 12, l31 = ln & 31, hh = ln >> 5;
        const float* wsrc = (gate ? a.in[10] : a.in[8]) + (size_t)g * 4096 + (16 * s + 8 * hh) * 64 + 32 * ct + l31;
        u32x4 o; o.x = pk2(wsrc[0], wsrc[64]); o.y = pk2(wsrc[128], wsrc[192]); o.z = pk2(wsrc[256], wsrc[320]); o.w = pk2(wsrc[384], wsrc[448]);
        *(u32x4*)(ws + WS_GW + (size_t)v * 16) = o; }
    LAS float* scr = (LAS float*)(lds + 16384 + wave * 8704);
    const int gw = bx * NWAVES + wave, NGW = gridDim.x * NWAVES;
    constexpr int I0 = 16 * 96, I1 = 16 * 32, I2 = 16 * 96, I3 = 8 * 32, I4 = 16 * 32;
    for (int it = gw; it < I0 + I1 + I2 + I3 + I4; it += NGW) {
        int r = it;
        if (r < I0) { transpose_item(a.in[5], 1024, 3072, (bf16*)(ws + WS_WIN0), 32 * (r % 96), scr, r / 96, r % 96, lane); continue; } r -= I0;
        if (r < I1) { transpose_item(a.in[15], 1024, 1024, (bf16*)(ws + WS_WOUT0), 32 * (r % 32), scr, r / 32, r % 32, lane); continue; } r -= I1;
        if (r < I2) { transpose_item(a.in[19], 1024, 3072, (bf16*)(ws + WS_WIN1), 32 * (r % 96), scr, r / 96, r % 96, lane); continue; } r -= I2;
        if (r < I3) { const int nb = r % 32, n0 = 32 * nb; const int nn = n0 & 511; const int dst = 256 * (nn >> 7) + (n0 >= 512 ? 128 : 0) + (nn & 127);
            transpose_item(a.in[30], 512, 1024, (bf16*)(ws + WS_WGLU), dst, scr, r / 32, nb, lane); continue; } r -= I3;
        transpose_item(a.in[32], 1024, 1024, (bf16*)(ws + WS_WOUT1), 32 * (r % 32), scr, r / 32, r % 32, lane);
    }
}

DI float wave_sum(float v) {
#pragma unroll
    for (int o = 1; o < 64; o <<= 1) v += __shfl_xor(v, o);
    return v;
}
DI void norm_rows(const float* xin, const float* gain, const float* modl, bf16* H, int gw, int NGW, int lane) {
    f32x4 gs[4], sh[4]; int curb = -1;
    for (int m = gw; m < M; m += NGW) {
        const f32x4* xr = (const f32x4*)(xin + (size_t)m * D) + lane;
        f32x4 v[4]; float s = 0.f;
#pragma unroll
        for (int j = 0; j < 4; ++j) v[j] = xr[64 * j];
        const int b = m >> 13;
        if (b != curb) { curb = b; const float* mb = modl + b * 3072;
#pragma unroll
            for (int j = 0; j < 4; ++j) { const int c = 4 * lane + 256 * j; gs[j] = *(const f32x4*)(gain + c) * (*(const f32x4*)(mb + 1024 + c) + 1.f); sh[j] = *(const f32x4*)(mb + c); } }
#pragma unroll
        for (int j = 0; j < 4; ++j) s += (v[j].x * v[j].x + v[j].y * v[j].y) + (v[j].z * v[j].z + v[j].w * v[j].w);
        const float rstd = rsqrtf(wave_sum(s) * (1.f / D) + 1e-6f);
        unsigned long long* o8 = (unsigned long long*)(H + (size_t)m * D) + lane;
#pragma unroll
        for (int j = 0; j < 4; ++j) { const f32x4 y = v[j] * rstd * gs[j] + sh[j];
            o8[64 * j] = (unsigned long long)pk2(y.x, y.y) | ((unsigned long long)pk2(y.z, y.w) << 32); }
    }
}

DI void s5_tables(const Args& a, LAS unsigned char* lds, int gt, int NT) {
    unsigned char* ws = a.ws;
    const float* PW = (const float*)(ws + WS_PW); const float* BB = (const float*)(ws + WS_BB);
    const float* cre = a.in[27]; const float* cim = a.in[28]; const float* dd = a.in[29];
    const bool staged = (NT == 32 * 64 * 16 * 4);
    LAS float* LB = (LAS float*)lds; LAS float* LP = LB + 2048; LAS float* LC = LP + 1024; LAS float* LI = LC + 1024;
    if (staged) { const int g = blockIdx.x >> 3, tau0 = (8 * blockIdx.x) & 63; const int t = threadIdx.x;
#pragma unroll
        for (int i = 0; i < 4; ++i) LB[t + 512 * i] = BB[(size_t)g * 2048 + t + 512 * i];
#pragma unroll
        for (int i = 0; i < 2; ++i) { LP[t + 512 * i] = PW[((size_t)(g * 65 + tau0) * 64) * 2 + t + 512 * i]; LC[t + 512 * i] = cre[g * 1024 + t + 512 * i]; LI[t + 512 * i] = cim[g * 1024 + t + 512 * i]; }
        __syncthreads(); }
    for (int v4 = gt; v4 < 32 * 64 * 16 * 4; v4 += NT) {
        const int v = v4 >> 2, pq = v4 & 3, g = v >> 10, tau = (v >> 4) & 63, h = v & 15;
        float acc[16];
#pragma unroll
        for (int e = 0; e < 16; ++e) acc[e] = 0.f;
        if (staged) {
#pragma unroll 4
            for (int pi = 0; pi < 16; ++pi) { const int p = 16 * pq + pi;
                const float cr = LC[h * 64 + p], ci = LI[h * 64 + p];
                const f32x2 pw = *(const LAS f32x2*)(LP + ((tau & 7) * 64 + p) * 2);
                const float wr = cr * pw.x - ci * pw.y, wi = cr * pw.y + ci * pw.x;
                const LAS f32x4* bb = (const LAS f32x4*)(LB + p * 32);
#pragma unroll
                for (int e2 = 0; e2 < 8; ++e2) { const f32x4 b4 = bb[e2]; acc[2 * e2] += wr * b4.x - wi * b4.y; acc[2 * e2 + 1] += wr * b4.z - wi * b4.w; }
            }
        } else {
#pragma unroll 4
        for (int pi = 0; pi < 16; ++pi) { const int p = 16 * pq + pi;
            const float cr = cre[(g * 16 + h) * 64 + p], ci = cim[(g * 16 + h) * 64 + p];
            const f32x2 pw = *(const f32x2*)(PW + ((size_t)(g * 65 + tau) * 64 + p) * 2);
            const float wr = cr * pw.x - ci * pw.y, wi = cr * pw.y + ci * pw.x;
            const f32x4* bb = (const f32x4*)(BB + (size_t)(g * 64 + p) * 32);
#pragma unroll
            for (int e2 = 0; e2 < 8; ++e2) { const f32x4 b4 = bb[e2]; acc[2 * e2] += wr * b4.x - wi * b4.y; acc[2 * e2 + 1] += wr * b4.z - wi * b4.w; }
        }
        }
#pragma unroll
        for (int e = 0; e < 16; ++e) { acc[e] += __shfl_xor(acc[e], 1); acc[e] += __shfl_xor(acc[e], 2); }
        if (pq != 0) continue;
        if (tau == 0) { const float dv = dd[g * 16 + h];
#pragma unroll
            for (int e = 0; e < 16; ++e) if (e == h) acc[e] += dv; }
        u32x4 lo, hi; lo.x = pk2(acc[0], acc[1]); lo.y = pk2(acc[2], acc[3]); lo.z = pk2(acc[4], acc[5]); lo.w = pk2(acc[6], acc[7]);
        hi.x = pk2(acc[8], acc[9]); hi.y = pk2(acc[10], acc[11]); hi.z = pk2(acc[12], acc[13]); hi.w = pk2(acc[14], acc[15]);
        unsigned char* fb = ws + WS_F + (size_t)g * 65536;
        if (tau + 1 < 64) { *(u32x4*)(fb + (size_t)((tau + 1) * 64 + h) * 16) = lo; *(u32x4*)(fb + (size_t)((tau + 1) * 64 + 32 + h) * 16) = hi; }
        *(u32x4*)(fb + (size_t)(tau * 64 + 16 + h) * 16) = lo; *(u32x4*)(fb + (size_t)(tau * 64 + 48 + h) * 16) = hi;
        if (tau == 0) { u32x4 z; z.x = 0u; z.y = 0u; z.z = 0u; z.w = 0u; *(u32x4*)(fb + (size_t)h * 16) = z; *(u32x4*)(fb + (size_t)(32 + h) * 16) = z; }
    }
    for (int vb_ = gt; vb_ < 32 * 4 * 64 * 64; vb_ += 4 * NT)
#pragma unroll
    for (int u_ = 0; u_ < 4; ++u_) { const int v = vb_ + u_ * NT; if (v >= 32 * 4 * 64 * 64) continue;
        const int g = v >> 14, rt = (v >> 12) & 3, s = (v >> 6) & 63, lane = v & 63, q = 32 * rt + (lane & 31), part = q >> 6, p = q & 63, hh = lane >> 5;
        const f32x2 pw = *(const f32x2*)(PW + ((size_t)(g * 65 + (63 - s)) * 64 + p) * 2);
        const float* bb = BB + ((size_t)(g * 64 + p) * 16 + 8 * hh) * 2;
        float o[8];
#pragma unroll
        for (int e = 0; e < 8; ++e) o[e] = part ? (pw.x * bb[2 * e + 1] + pw.y * bb[2 * e]) : (pw.x * bb[2 * e] - pw.y * bb[2 * e + 1]);
        u32x4 w; w.x = pk2(o[0], o[1]); w.y = pk2(o[2], o[3]); w.z = pk2(o[4], o[5]); w.w = pk2(o[6], o[7]);
        *(u32x4*)(ws + WS_VBIG + (size_t)v * 16) = w;
    }
    for (int vb_ = gt; vb_ < 32 * 32 * 8 * 64; vb_ += 4 * NT)
#pragma unroll
    for (int u_ = 0; u_ < 4; ++u_) { const int v = vb_ + u_ * NT; if (v >= 32 * 32 * 8 * 64) continue;
        const int g = v >> 14, R = (v >> 9) & 31, ks = (v >> 6) & 7, lane = v & 63, r = lane & 31, jj = r >> 4, h = r & 15, hh = lane >> 5, tok = 2 * R + jj, part = ks >> 2;
        float o[8];
#pragma unroll
        for (int e = 0; e < 8; ++e) { const int p = 16 * (ks & 3) + 8 * hh + e;
            const float cr = cre[(g * 16 + h) * 64 + p], ci = cim[(g * 16 + h) * 64 + p];
            const f32x2 pw = *(const f32x2*)(PW + ((size_t)(g * 65 + tok + 1) * 64 + p) * 2);
            o[e] = part ? -(cr * pw.y + ci * pw.x) : (cr * pw.x - ci * pw.y); }
        u32x4 w; w.x = pk2(o[0], o[1]); w.y = pk2(o[2], o[3]); w.z = pk2(o[4], o[5]); w.w = pk2(o[6], o[7]);
        *(u32x4*)(ws + WS_WBIG + (size_t)v * 16) = w;
    }
}
template <int PASS>
DI void lru_item(const Args& a, LAS unsigned char* lds, int item, int tid, int lane, int wave) {
    unsigned char* ws = a.ws;
    const bf16* PROJ = (const bf16*)(ws + WS_PROJ); bf16* MIX = (bf16*)(ws + WS_MIX); float* SUM = (float*)(ws + WS_LRUSUM);
    const int b = item >> 7, ch = item & 127; const size_t m0 = (size_t)b * T + 64 * ch;
    constexpr int XP = 520;
    LAS bf16* XC = (LAS bf16*)lds; LAS bf16* HB = (LAS bf16*)(lds + 66560);
    {
        LAS bf16* XR = HB;
        u32x4 xv[9];
#pragma unroll
        for (int i = 0; i < 9; ++i) { const int idx = tid + 512 * i, r = idx >> 6, c8 = idx & 63;
            xv[i].x = 0u; xv[i].y = 0u; xv[i].z = 0u; xv[i].w = 0u;
            if (idx < 67 * 64 && (ch > 0 || r >= 3)) xv[i] = *(const u32x4*)(PROJ + (m0 + r - 3) * NP + 8 * c8); }
#pragma unroll
        for (int i = 0; i < 9; ++i) { const int idx = tid + 512 * i, r = idx >> 6, c8 = idx & 63;
            if (idx < 67 * 64) *(LAS u32x4*)(XR + r * XP + 8 * c8) = xv[i]; }
        __syncthreads();
        const int c = tid; const float* cw = a.in[6];
        const float w0 = cw[c], w1 = cw[512 + c], w2 = cw[1024 + c], w3 = cw[1536 + c], cb = a.in[7][c];
        float xm3 = bf2f(XR[c]), xm2 = bf2f(XR[XP + c]), xm1 = bf2f(XR[2 * XP + c]);
#pragma unroll 4
        for (int j = 0; j < 64; ++j) { const float x0 = bf2f(XR[(j + 3) * XP + c]); const float xc = w0 * xm3 + w1 * xm2 + w2 * xm1 + w3 * x0 + cb; XC[j * XP + c] = (bf16)f2bf(xc); xm3 = xm2; xm2 = xm1; xm1 = x0; }
    }
    LAS float* CAR = (LAS float*)(lds + 136448);
    if (PASS == 2) { float h = 0.f; const float* sp2 = SUM + ((size_t)(b * 128) * 512 + tid) * 2;
#pragma unroll 16
        for (int cc = 0; cc < ch; ++cc) { const f32x2 s2 = *(const f32x2*)(sp2 + (size_t)cc * 1024); h = s2.x * h + s2.y; }
        CAR[tid] = h; }
    __syncthreads();
    const int g = wave, hh = lane >> 5, l31 = lane & 31;
    const bf16* GW = (const bf16*)(ws + WS_GW);
#pragma unroll 1
    for (int ct = 0; ct < 2; ++ct) {
        const int j = 32 * ct + l31, c = 64 * g + j;
        bf16x8 Br[4], Bi[4];
#pragma unroll
        for (int s = 0; s < 4; ++s) { Br[s] = mk8(*(const u32x4*)(GW + ((size_t)(((0 * 8 + g) * 2 + ct) * 4 + s) * 64 + lane) * 8)); Bi[s] = mk8(*(const u32x4*)(GW + ((size_t)(((1 * 8 + g) * 2 + ct) * 4 + s) * 64 + lane) * 8)); }
        f32x16 Rr[2], Ii[2];
#pragma unroll
        for (int rt = 0; rt < 2; ++rt) { Rr[rt] = zero16(); Ii[rt] = zero16();
#pragma unroll
            for (int s = 0; s < 4; ++s) { const bf16x8 A = *(const LAS bf16x8*)(XC + (32 * rt + l31) * XP + 64 * g + 16 * s + 8 * hh); Rr[rt] = MFMA32(A, Br[s], Rr[rt]); Ii[rt] = MFMA32(A, Bi[s], Ii[rt]); } }
        const float rb = a.in[9][c], ib = a.in[11][c];
        const float sp = log1pf(__expf(-a.in[12][c]));
#pragma unroll
        for (int rt = 0; rt < 2; ++rt)
#pragma unroll
            for (int i = 0; i < 16; ++i) { const int tok = 32 * rt + crow(i, hh);
                const float r = sigm(Rr[rt][i] + rb), ig = sigm(Ii[rt][i] + ib);
                const float la = -8.f * r * sp; const float av = __expf(la); const float x2 = 2.f * la;
                const float ser = -x2 * (1.f + 0.5f * x2 * (1.f + (1.f / 3.f) * x2 * (1.f + 0.25f * x2 * (1.f + 0.2f * x2 * (1.f + (1.f / 6.f) * x2)))));
                const float om = (x2 > -0.25f) ? ser : (1.f - av * av); const float mult = __builtin_amdgcn_sqrtf(om);
                const float xv = bf2f(XC[tok * XP + c]);
                Rr[rt][i] = av; Ii[rt][i] = mult * ig * xv; if ((i & 3) == 3) __builtin_amdgcn_sched_barrier(0); }
        float Ag[8], Bg[8], Ao[8], Bo[8];
#pragma unroll
        for (int rt = 0; rt < 2; ++rt)
#pragma unroll
            for (int k = 0; k < 4; ++k) { float A = 1.f, Bv = 0.f;
#pragma unroll
                for (int e = 0; e < 4; ++e) { const float av = Rr[rt][4 * k + e]; Bv = av * Bv + Ii[rt][4 * k + e]; A *= av; }
                Ag[rt * 4 + k] = A; Bg[rt * 4 + k] = Bv; }
#pragma unroll
        for (int q = 0; q < 8; ++q) { Ao[q] = __shfl_xor(Ag[q], 32); Bo[q] = __shfl_xor(Bg[q], 32); }
        float h = (PASS == 2) ? CAR[c] : 0.f;
        float hs[8]; float Atot = 1.f;
#pragma unroll
        for (int q = 0; q < 8; ++q) {
            const float A1 = hh ? Ao[q] : Ag[q], B1 = hh ? Bo[q] : Bg[q], A2 = hh ? Ag[q] : Ao[q], B2 = hh ? Bg[q] : Bo[q];
            const float h1 = A1 * h + B1; hs[q] = hh ? h1 : h; h = A2 * h1 + B2; Atot *= A1 * A2; }
        if (PASS == 1) { if (hh == 0) { f32x2 o; o.x = Atot; o.y = h; *(f32x2*)(SUM + ((size_t)(b * 128 + ch) * 512 + c) * 2) = o; } }
        else {
#pragma unroll
            for (int rt = 0; rt < 2; ++rt)
#pragma unroll
                for (int k = 0; k < 4; ++k) { float hc = hs[rt * 4 + k];
#pragma unroll
                    for (int e = 0; e < 4; ++e) { const int i = 4 * k + e; hc = Rr[rt][i] * hc + Ii[rt][i]; HB[(32 * rt + 8 * k + 4 * hh + e) * XP + c] = (bf16)f2bf(hc); } }
        }
    }
    __syncthreads();
    if (PASS == 2) {
#pragma unroll
        for (int i = 0; i < 8; ++i) { const int idx = tid + 512 * i, tok = idx >> 6, c8 = idx & 63;
            const u32x4 hv = *(const LAS u32x4*)(HB + tok * XP + 8 * c8); const u32x4 gv = *(const u32x4*)(PROJ + (m0 + tok) * NP + 512 + 8 * c8);
            u32x4 o;
#pragma unroll
            for (int e = 0; e < 4; ++e) o[e] = pk2(bflo(hv[e]) * silu(bflo(gv[e])), bfhi(hv[e]) * silu(bfhi(gv[e])));
            *(u32x4*)(MIX + (m0 + tok) * 1024 + 8 * c8) = o; }
        __syncthreads();
    }
}

template <int LAYER>
DI void prep_item(const Args& a, LAS unsigned char* lds, int item, int tid) {
    unsigned char* ws = a.ws;
    bf16* PROJ = (bf16*)(ws + WS_PROJ); bf16* VF = (bf16*)(ws + WS_VT); bf16* KF = (bf16*)(ws + WS_KF);
    constexpr int qoff = LAYER ? 0 : 1024, koff = LAYER ? 512 : 1536, voff = LAYER ? 1024 : 2048;
    const float* qg = LAYER ? a.in[20] : a.in[13]; const float* kg = LAYER ? a.in[21] : a.in[14];
    const int h = item & 7, n = (item >> 3) & 31, b = item >> 8;
    LAS bf16* VL = (LAS bf16*)lds; LAS float* RED = (LAS float*)(lds + 40960);
    const int c8 = tid & 7, r0 = tid >> 3;
    float qgv[8], kgv[8], ksum[8];
#pragma unroll
    for (int e = 0; e < 8; ++e) { qgv[e] = qg[8 * c8 + e]; kgv[e] = kg[8 * c8 + e]; ksum[e] = 0.f; }
    u32x4 lq[4], lk[4], lv[4];
#pragma unroll
    for (int i = 0; i < 4; ++i) { const bf16* base = PROJ + ((size_t)b * T + 256 * n + r0 + 64 * i) * NP + 64 * h + 8 * c8; lq[i] = *(const u32x4*)(base + qoff); lk[i] = *(const u32x4*)(base + koff); lv[i] = *(const u32x4*)(base + voff); }
#pragma unroll
    for (int i = 0; i < 4; ++i) {
        const int row = r0 + 64 * i; bf16* base = PROJ + ((size_t)b * T + 256 * n + row) * NP + 64 * h + 8 * c8;
        {   u32x4 v = lq[i]; float f[8];
#pragma unroll
            for (int e = 0; e < 4; ++e) { f[2 * e] = bflo(v[e]); f[2 * e + 1] = bfhi(v[e]); }
            float ss = 0.f;
#pragma unroll
            for (int e = 0; e < 8; ++e) ss += f[e] * f[e];
            ss += __shfl_xor(ss, 1); ss += __shfl_xor(ss, 2); ss += __shfl_xor(ss, 4);
            const float rstd = rsqrtf(ss * (1.f / 64.f) + 1e-6f);
#pragma unroll
            for (int e = 0; e < 8; ++e) f[e] = f[e] * rstd * qgv[e];
            u32x4 o; o.x = pk2(f[0], f[1]); o.y = pk2(f[2], f[3]); o.z = pk2(f[4], f[5]); o.w = pk2(f[6], f[7]); *(u32x4*)(base + qoff) = o; }
        {   u32x4 v = lk[i]; float f[8];
#pragma unroll
            for (int e = 0; e < 4; ++e) { f[2 * e] = bflo(v[e]); f[2 * e + 1] = bfhi(v[e]); }
            float ss = 0.f;
#pragma unroll
            for (int e = 0; e < 8; ++e) ss += f[e] * f[e];
            ss += __shfl_xor(ss, 1); ss += __shfl_xor(ss, 2); ss += __shfl_xor(ss, 4);
            const float rstd = rsqrtf(ss * (1.f / 64.f) + 1e-6f);
#pragma unroll
            for (int e = 0; e < 8; ++e) { f[e] = f[e] * rstd * kgv[e]; ksum[e] += f[e]; }
            u32x4 o; o.x = pk2(f[0], f[1]); o.y = pk2(f[2], f[3]); o.z = pk2(f[4], f[5]); o.w = pk2(f[6], f[7]);
            *(u32x4*)(KF + ((((size_t)(b * 8 + h) * 256 + 8 * n + (row >> 5)) * 4 + (c8 >> 1)) * 64 + (c8 & 1) * 32 + (row & 31)) * 8) = o; }
        *(LAS u32x4*)(VL + row * 72 + 8 * c8) = lv[i];
    }
    if (LAYER == 0) {
#pragma unroll
        for (int e = 0; e < 8; ++e) RED[r0 * 64 + 8 * c8 + e] = ksum[e]; }
    __syncthreads();
    if (LAYER == 0 && tid < 64) { float s = 0.f;
        for (int r = 0; r < 64; ++r) s += RED[r * 64 + tid];
        ((float*)(ws + WS_KMEAN))[((size_t)(b * 8 + h) * 32 + n) * 64 + tid] = s * (1.f / 256.f); }
#pragma unroll
    for (int i = 0; i < 4; ++i) { const int idx = tid + 512 * i, ln = idx & 63, s = (idx >> 6) & 1, dt = (idx >> 7) & 1, kt = idx >> 8, l31 = ln & 31, hh = ln >> 5;
        const LAS bf16* vp = VL + (32 * kt + 16 * s + 4 * hh) * 72 + 32 * dt + l31;
        const unsigned short e0 = vp[0], e1 = vp[72], e2 = vp[144], e3 = vp[216], e4 = vp[8 * 72], e5 = vp[9 * 72], e6 = vp[10 * 72], e7 = vp[11 * 72];
        u32x4 o; o.x = e0 | ((unsigned)e1 << 16); o.y = e2 | ((unsigned)e3 << 16); o.z = e4 | ((unsigned)e5 << 16); o.w = e6 | ((unsigned)e7 << 16);
        *(u32x4*)(VF + (((((size_t)(b * 8 + h) * 256 + 8 * n + kt) * 2 + dt) * 2 + s) * 64 + ln) * 8) = o; }
    __syncthreads();
}

DI void moba_item(const Args& a, LAS unsigned char* lds, int item, int tid, int lane, int wave) {
    unsigned char* ws = a.ws;
    const bf16* PROJ = (const bf16*)(ws + WS_PROJ); const bf16* VT = (const bf16*)(ws + WS_VT); bf16* MIX = (bf16*)(ws + WS_MIX);
    const int bh = item & 31, m = item >> 5, b = bh >> 3, h = bh & 7;
    constexpr int QP = 72, SP = 68;
    LAS bf16* QS = (LAS bf16*)lds;
    LAS bf16* SLAB = (LAS bf16*)(lds + 36864);
    LAS float* KM = (LAS float*)(lds + 36864);
    LAS float* SL = (LAS float*)(lds + 141312);
    LAS unsigned short* LISTQ = (LAS unsigned short*)(lds + 144384);
    LAS unsigned short* SELROW = (LAS unsigned short*)(lds + 145920);
    LAS int* CNT = (LAS int*)(lds + 147968);
    LAS int* OFF = (LAS int*)(lds + 148096);
    LAS unsigned short* TILES = (LAS unsigned short*)(lds + 148224);
    LAS int* NTL = (LAS int*)(lds + 148352);
    const size_t mq0 = (size_t)b * T + 256 * m;
    {   const int row = tid >> 1, half = tid & 1; const bf16* src = PROJ + (mq0 + row) * NP + 1024 + 64 * h + 32 * half;
#pragma unroll
        for (int i = 0; i < 4; ++i) { const u32x4 v = *(const u32x4*)(src + 8 * i); u32x4 o;
#pragma unroll
            for (int e = 0; e < 4; ++e) o[e] = pk2(bflo(v[e]) * (0.125f * 1.4426950408889634f), bfhi(v[e]) * (0.125f * 1.4426950408889634f));
            *(LAS u32x4*)(QS + row * QP + 32 * half + 8 * i) = o; } }
    {   const float* km = (const float*)(ws + WS_KMEAN) + (size_t)(b * 8 + h) * 2048;
        for (int i = tid; i < m * 64; i += NTHR) KM[i] = km[i]; }
    if (tid < 32) CNT[tid] = 0;
    __syncthreads();
    int i0 = 255, i1 = 255, i2 = 255, ps0 = 0, ps1 = 0, ps2 = 0;
    if (tid < 256 && m > 0) {
        float q[64];
#pragma unroll
        for (int i = 0; i < 8; ++i) { const u32x4 v = *(const LAS u32x4*)(QS + tid * QP + 8 * i);
#pragma unroll
            for (int e = 0; e < 4; ++e) { q[8 * i + 2 * e] = bflo(v[e]); q[8 * i + 2 * e + 1] = bfhi(v[e]); } }
        float v0 = -INFINITY, v1 = -INFINITY, v2 = -INFINITY;
        for (int n = 0; n < m; ++n) { float dot = 0.f;
#pragma unroll
            for (int d4 = 0; d4 < 16; ++d4) { const f32x4 kv = *(const LAS f32x4*)(KM + n * 64 + 4 * d4); dot += q[4 * d4] * kv.x + q[4 * d4 + 1] * kv.y + q[4 * d4 + 2] * kv.z + q[4 * d4 + 3] * kv.w; }
            if (dot > v0) { v2 = v1; i2 = i1; v1 = v0; i1 = i0; v0 = dot; i0 = n; }
            else if (dot > v1) { v2 = v1; i2 = i1; v1 = dot; i1 = n; }
            else if (dot > v2) { v2 = dot; i2 = n; } }
        if (i0 != 255) ps0 = __hip_atomic_fetch_add(CNT + i0, 1, __ATOMIC_RELAXED, __HIP_MEMORY_SCOPE_WORKGROUP);
        if (i1 != 255) ps1 = __hip_atomic_fetch_add(CNT + i1, 1, __ATOMIC_RELAXED, __HIP_MEMORY_SCOPE_WORKGROUP);
        if (i2 != 255) ps2 = __hip_atomic_fetch_add(CNT + i2, 1, __ATOMIC_RELAXED, __HIP_MEMORY_SCOPE_WORKGROUP);
    }
    __syncthreads();
    if (tid < 64) {
        const int c = (lane < m) ? CNT[lane] : 0, ntile = (c + 31) >> 5;
        int pc = c, ptile = ntile;
#pragma unroll
        for (int o = 1; o < 32; o <<= 1) { const int uc = __shfl_up(pc, o), ut = __shfl_up(ptile, o); if ((lane & 31) >= o) { pc += uc; ptile += ut; } }
        if (lane < 32) { OFF[lane] = pc - c; for (int qt = 0; qt < ntile; ++qt) TILES[ptile - ntile + qt] = (unsigned short)(lane | (qt << 8)); if (lane == 31) NTL[0] = ptile; }
    }
    __syncthreads();
    if (tid < 256) {
        unsigned short r0 = 0xffff, r1 = 0xffff, r2 = 0xffff;
        if (i0 != 255) { r0 = (unsigned short)(OFF[i0] + ps0); LISTQ[r0] = (unsigned short)tid; }
        if (i1 != 255) { r1 = (unsigned short)(OFF[i1] + ps1); LISTQ[r1] = (unsigned short)tid; }
        if (i2 != 255) { r2 = (unsigned short)(OFF[i2] + ps2); LISTQ[r2] = (unsigned short)tid; }
        SELROW[tid * 4] = r0; SELROW[tid * 4 + 1] = r1; SELROW[tid * 4 + 2] = r2;
    }
    __syncthreads();
    const float cb2 = ((const float*)(ws + WS_MOD))[2 * 4 * 3072] * 1.4426950408889634f;
    f32x16 sinit;
#pragma unroll
    for (int i = 0; i < 16; ++i) sinit[i] = -cb2;
    const int hh = lane >> 5, l31 = lane & 31, w = wave;
    const bf16* Kb = (const bf16*)(ws + WS_KF) + ((size_t)(b * 8 + h) * 256 * 4 * 64 + lane) * 8;
    const bf16* Vb = VT + ((size_t)(b * 8 + h) * 256 * 4 * 64 + lane) * 8;
    const int nt = NTL[0];
#define MOBA_LOADKV(AK, AV, key0) do { const size_t kt_ = (size_t)((key0) >> 5) * 2048; \
    _Pragma("unroll") for (int s = 0; s < 4; ++s) AK[s] = mk8(*(const u32x4*)(Kb + kt_ + s * 512)); \
    _Pragma("unroll") for (int dt = 0; dt < 2; ++dt) _Pragma("unroll") for (int s = 0; s < 2; ++s) AV[dt][s] = mk8(*(const u32x4*)(Vb + kt_ + (dt * 2 + s) * 512)); } while (0)
    for (int t = w; t < nt; t += 8) {
        const int tl = TILES[t], n = tl & 255, qt = tl >> 8, cnt = CNT[n], rowb = OFF[n] + 32 * qt;
        const bool valid = (32 * qt + l31) < cnt; const int qrow = valid ? (int)LISTQ[rowb + l31] : 0;
        bf16x8 bq[4];
#pragma unroll
        for (int s = 0; s < 4; ++s) bq[s] = *(const LAS bf16x8*)(QS + qrow * QP + 16 * s + 8 * hh);
        f32x16 o0 = zero16(), o1 = zero16(); f32x2 ls2; ls2.x = 0.f; ls2.y = 0.f;
        bf16x8 ak[4], av[2][2], akn[4], avn[2][2];
        MOBA_LOADKV(ak, av, 256 * n);
#define MOBA_STEP(AK, AV, AKN, AVN, knext) do { \
            MOBA_LOADKV(AKN, AVN, knext); \
            f32x16 sacc = sinit; \
            _Pragma("unroll") for (int s = 0; s < 4; ++s) sacc = MFMA32(AK[s], bq[s], sacc); \
            _Pragma("unroll") for (int i = 0; i < 16; i += 2) { f32x2 p2; p2.x = __builtin_amdgcn_exp2f(sacc[i]); p2.y = __builtin_amdgcn_exp2f(sacc[i + 1]); sacc[i] = p2.x; sacc[i + 1] = p2.y; ls2 += p2; } \
            const bf16x8 p0 = pack8(sacc[0], sacc[1], sacc[2], sacc[3], sacc[4], sacc[5], sacc[6], sacc[7]); \
            const bf16x8 p1 = pack8(sacc[8], sacc[9], sacc[10], sacc[11], sacc[12], sacc[13], sacc[14], sacc[15]); \
            o0 = MFMA32(AV[0][0], p0, o0); o0 = MFMA32(AV[0][1], p1, o0); o1 = MFMA32(AV[1][0], p0, o1); o1 = MFMA32(AV[1][1], p1, o1); } while (0)
#pragma unroll 1
        for (int ks = 0; ks < 8; ks += 2) {
            MOBA_STEP(ak, av, akn, avn, 256 * n + 32 * (ks + 1));
            MOBA_STEP(akn, avn, ak, av, 256 * n + 32 * (ks < 6 ? ks + 2 : ks + 1));
        }
        float lsum = ls2.x + ls2.y;
        lsum += __shfl_xor(lsum, 32);
        if (valid) {
            LAS bf16* sr = SLAB + (rowb + l31) * SP + 4 * hh;
#pragma unroll
            for (int k = 0; k < 4; ++k) { u32x2 wv; wv.x = pk2(o0[4 * k], o0[4 * k + 1]); wv.y = pk2(o0[4 * k + 2], o0[4 * k + 3]); *(LAS u32x2*)(sr + 8 * k) = wv;
                u32x2 wu; wu.x = pk2(o1[4 * k], o1[4 * k + 1]); wu.y = pk2(o1[4 * k + 2], o1[4 * k + 3]); *(LAS u32x2*)(sr + 32 + 8 * k) = wu; }
            if (hh == 0) SL[rowb + l31] = lsum;
        }
    }
    f32x16 o0 = zero16(), o1 = zero16(); float lsum = 0.f;
    {
        const int qrow = 32 * w + l31;
        bf16x8 bq[4];
#pragma unroll
        for (int s = 0; s < 4; ++s) bq[s] = *(const LAS bf16x8*)(QS + qrow * QP + 16 * s + 8 * hh);
        bf16x8 ak[4], av[2][2], akn[4], avn[2][2];
        MOBA_LOADKV(ak, av, 256 * m);
#pragma unroll 1
        for (int ks = 0; ks <= w; ++ks) {
            const int kn = 256 * m + 32 * (ks < w ? ks + 1 : ks);
            MOBA_LOADKV(akn, avn, kn);
            f32x16 sacc = sinit;
#pragma unroll
            for (int s = 0; s < 4; ++s) sacc = MFMA32(ak[s], bq[s], sacc);
#pragma unroll
            for (int i = 0; i < 16; ++i) { float p = __builtin_amdgcn_exp2f(sacc[i]); if (ks == w && crow(i, hh) > l31) p = 0.f; sacc[i] = p; lsum += p; }
            const bf16x8 p0 = pack8(sacc[0], sacc[1], sacc[2], sacc[3], sacc[4], sacc[5], sacc[6], sacc[7]);
            const bf16x8 p1 = pack8(sacc[8], sacc[9], sacc[10], sacc[11], sacc[12], sacc[13], sacc[14], sacc[15]);
            o0 = MFMA32(av[0][0], p0, o0); o0 = MFMA32(av[0][1], p1, o0); o1 = MFMA32(av[1][0], p0, o1); o1 = MFMA32(av[1][1], p1, o1);
#pragma unroll
            for (int s = 0; s < 4; ++s) ak[s] = akn[s];
#pragma unroll
            for (int dt = 0; dt < 2; ++dt) { av[dt][0] = avn[dt][0]; av[dt][1] = avn[dt][1]; }
        }
        lsum += __shfl_xor(lsum, 32);
    }
    __syncthreads();
    {
        const int qrow = 32 * w + l31;
#pragma unroll
        for (int j = 0; j < 3; ++j) { const int r = SELROW[qrow * 4 + j];
            if (r != 0xffff) { lsum += SL[r]; const LAS bf16* sr = SLAB + r * SP + 4 * hh;
#pragma unroll
                for (int k = 0; k < 4; ++k) { const u32x2 u0 = *(const LAS u32x2*)(sr + 8 * k), u1 = *(const LAS u32x2*)(sr + 32 + 8 * k);
                    o0[4 * k] += bflo(u0.x); o0[4 * k + 1] += bfhi(u0.x); o0[4 * k + 2] += bflo(u0.y); o0[4 * k + 3] += bfhi(u0.y);
                    o1[4 * k] += bflo(u1.x); o1[4 * k + 1] += bfhi(u1.x); o1[4 * k + 2] += bflo(u1.y); o1[4 * k + 3] += bfhi(u1.y); } } }
        const float inv = 1.f / lsum;
        LAS bf16* sl = QS + (32 * w) * QP;
#pragma unroll
        for (int dt = 0; dt < 2; ++dt)
#pragma unroll
            for (int k = 0; k < 4; ++k) { const f32x16& o = dt ? o1 : o0; u32x2 wv; wv.x = pk2(o[4 * k] * inv, o[4 * k + 1] * inv); wv.y = pk2(o[4 * k + 2] * inv, o[4 * k + 3] * inv);
                *(LAS u32x2*)(sl + l31 * QP + 32 * dt + 8 * k + 4 * hh) = wv; }
#pragma unroll
        for (int i = 0; i < 4; ++i) { const int c = lane + 64 * i, row = c >> 3, part = c & 7;
            const u32x4 ov = *(const LAS u32x4*)(sl + row * QP + 8 * part); const u32x4 gv = *(const u32x4*)(PROJ + (mq0 + 32 * w + row) * NP + 2560 + 64 * h + 8 * part);
            u32x4 wv;
#pragma unroll
            for (int e = 0; e < 4; ++e) wv[e] = pk2(bflo(ov[e]) * silu(bflo(gv[e])), bfhi(ov[e]) * silu(bfhi(gv[e])));
            *(u32x4*)(MIX + (mq0 + 32 * w + row) * 1024 + 512 + 64 * h + 8 * part) = wv; }
    }
    __syncthreads();
#undef MOBA_LOADKV
#undef MOBA_STEP
}

DI void sb_item(const Args& a, LAS unsigned char* slab, int item, int lane) {
    unsigned char* ws = a.ws;
    const bf16* PROJ = (const bf16*)(ws + WS_PROJ); const bf16* VT = (const bf16*)(ws + WS_VT); const bf16* KF = (const bf16*)(ws + WS_KF); bf16* MIX = (bf16*)(ws + WS_MIX);
    const int qt = 255 - (item >> 5), bh = item & 31, b = bh >> 3, h = bh & 7;
    const int hh = lane >> 5, l31 = lane & 31;
    const size_t mq = (size_t)b * T + 32 * qt + l31;
    bf16x8 bq[4];
#pragma unroll
    for (int s = 0; s < 4; ++s) bq[s] = mk8(*(const u32x4*)(PROJ + mq * NP + 64 * h + 16 * s + 8 * hh));
    f32x16 o0 = zero16(), o1 = zero16();
    float carry = 0.f;
    const size_t kfb = (size_t)(b * 8 + h) * 256 * 2048 + lane * 8;
#define SB_LOADKV(AK, AV, kt_) do { const size_t kb_ = kfb + (size_t)(kt_) * 2048; \
    _Pragma("unroll") for (int s = 0; s < 4; ++s) AK[s] = mk8(*(const u32x4*)(KF + kb_ + s * 512)); \
    _Pragma("unroll") for (int dt = 0; dt < 2; ++dt) _Pragma("unroll") for (int s = 0; s < 2; ++s) AV[dt][s] = mk8(*(const u32x4*)(VT + kb_ + (dt * 2 + s) * 512)); } while (0)
    bf16x8 ak[4], av[2][2], akn[4], avn[2][2];
    SB_LOADKV(ak, av, qt);
#pragma unroll 1
    for (int kt = qt; kt >= 0; --kt) {
        SB_LOADKV(akn, avn, (kt > 0 ? kt - 1 : 0));
        f32x16 z = zero16();
#pragma unroll
        for (int s = 0; s < 4; ++s) z = MFMA32(ak[s], bq[s], z);
        float kp[16], bt[16];
        if (kt == qt) {
#pragma unroll
            for (int i = 0; i < 16; ++i) { const float zz = z[i] * 0.125f; const bool strict = crow(i, hh) < l31;
                const float e = __expf(-fabsf(zz)), r = __builtin_amdgcn_rcpf(1.f + e), er = e * r;
                kp[i] = strict ? (zz >= 0.f ? er : r) : 1.f; bt[i] = strict ? (zz >= 0.f ? r : er) : 0.f; }
        } else {
#pragma unroll
            for (int i = 0; i < 16; ++i) { const float zz = z[i] * 0.125f;
                const float e = __expf(-fabsf(zz)), r = __builtin_amdgcn_rcpf(1.f + e), er = e * r;
                kp[i] = (zz >= 0.f ? er : r); bt[i] = (zz >= 0.f ? r : er); }
        }
        float gs[4], go[4];
#pragma unroll
        for (int k = 0; k < 4; ++k) { gs[k] = (kp[4 * k] * kp[4 * k + 1]) * (kp[4 * k + 2] * kp[4 * k + 3]); go[k] = __shfl_xor(gs[k], 32); }
        float after[4]; float run = 1.f;
#pragma unroll
        for (int k = 3; k >= 0; --k) { after[k] = hh ? run : run * go[k]; run *= gs[k] * go[k]; }
        const float base = __expf(carry);
        float wv[16];
#pragma unroll
        for (int k = 0; k < 4; ++k) { float suf = base * after[k];
#pragma unroll
            for (int e = 3; e >= 0; --e) { wv[4 * k + e] = bt[4 * k + e] * suf; suf *= kp[4 * k + e]; } }
        carry += __logf(run);
        const bf16x8 p0 = pack8(wv[0], wv[1], wv[2], wv[3], wv[4], wv[5], wv[6], wv[7]);
        const bf16x8 p1 = pack8(wv[8], wv[9], wv[10], wv[11], wv[12], wv[13], wv[14], wv[15]);
        o0 = MFMA32(av[0][0], p0, o0); o0 = MFMA32(av[0][1], p1, o0);
        o1 = MFMA32(av[1][0], p0, o1); o1 = MFMA32(av[1][1], p1, o1);
        if (__all(carry < -104.f)) break;
#pragma unroll
        for (int s = 0; s < 4; ++s) ak[s] = akn[s];
#pragma unroll
        for (int dt = 0; dt < 2; ++dt) { av[dt][0] = avn[dt][0]; av[dt][1] = avn[dt][1]; }
    }
#undef SB_LOADKV
    {
        LAS bf16* sl = (LAS bf16*)slab;
#pragma unroll
        for (int dt = 0; dt < 2; ++dt)
#pragma unroll
            for (int k = 0; k < 4; ++k) { const f32x16& o = dt ? o1 : o0; u32x2 w; w.x = pk2(o[4 * k], o[4 * k + 1]); w.y = pk2(o[4 * k + 2], o[4 * k + 3]);
                *(LAS u32x2*)(sl + l31 * 72 + 32 * dt + 8 * k + 4 * hh) = w; }
        const size_t mb = (size_t)b * T + 32 * qt;
#pragma unroll
        for (int i = 0; i < 4; ++i) { const int c = lane + 64 * i, row = c >> 3, part = c & 7;
            const u32x4 ov = *(const LAS u32x4*)(sl + row * 72 + 8 * part); const u32x4 gv = *(const u32x4*)(PROJ + (mb + row) * NP + 1536 + 64 * h + 8 * part);
            u32x4 w;
#pragma unroll
            for (int e = 0; e < 4; ++e) w[e] = pk2(bflo(ov[e]) * silu(bflo(gv[e])), bfhi(ov[e]) * silu(bfhi(gv[e])));
            *(u32x4*)(MIX + (mb + row) * 1024 + 64 * h + 8 * part) = w; }
    }
}

DI void s5_pass1(const Args& a, LAS unsigned char* lds, int item, int tid, int lane, int wave) {
    unsigned char* ws = a.ws;
    const bf16* PROJ = (const bf16*)(ws + WS_PROJ); float* S5S = (float*)(ws + WS_S5S);
    const int g = item & 31, b = (item >> 5) & 3, ct = item >> 7;
    const int rt = wave & 3, kh = wave >> 2, hh = lane >> 5, l31 = lane & 31;
    constexpr int UP = 2064;
    LAS unsigned char* UL = lds + 16384;
#pragma unroll
    for (int i = 0; i < 8; ++i) { const int idx = tid + 512 * i, tok = idx >> 1, hf = idx & 1;
        const u32x4 v = *(const u32x4*)(PROJ + ((size_t)b * T + 2048 * ct + tok) * NP + 2048 + 16 * g + 8 * hf);
        *(LAS u32x4*)(UL + (tok >> 6) * UP + (tok & 63) * 32 + 16 * hf) = v; }
    __syncthreads();
    const unsigned char* vb = ws + WS_VBIG + ((size_t)((g * 4 + rt) * 64) * 64 + lane) * 16;
    f32x16 acc = zero16();
#pragma unroll 4
    for (int s = 32 * kh; s < 32 * kh + 32; ++s) { const bf16x8 A = mk8(*(const u32x4*)(vb + (size_t)s * 1024)); const bf16x8 Bf = *(const LAS bf16x8*)(UL + l31 * UP + s * 32 + 16 * hh); acc = MFMA32(A, Bf, acc); }
    LAS float* red = (LAS float*)lds;
    if (kh == 1) {
#pragma unroll
        for (int i = 0; i < 16; ++i) red[(rt * 16 + i) * 64 + lane] = acc[i]; }
    __syncthreads();
    if (kh == 0) {
        float* dst = S5S + ((size_t)((b * 32 + g) * 128 + 32 * ct + l31)) * 128 + 32 * rt;
#pragma unroll
        for (int k = 0; k < 4; ++k) { f32x4 o;
#pragma unroll
            for (int e = 0; e < 4; ++e) o[e] = acc[4 * k + e] + red[(rt * 16 + 4 * k + e) * 64 + lane];
            *(f32x4*)(dst + 8 * k + 4 * hh) = o; } }
    __syncthreads();
}
DI void s5_pass2(const Args& a, LAS unsigned char* lds, int item, int tid, int lane, int wave) {
    unsigned char* ws = a.ws;
    const bf16* PROJ = (const bf16*)(ws + WS_PROJ); const float* S5S = (const float*)(ws + WS_S5S); bf16* S5Y = (bf16*)(ws + WS_H);
    const int g = item & 31, b = (item >> 5) & 3, ct = item >> 7;
    constexpr int UP = 2064, XPP = 136;
    LAS unsigned char* FL = lds;
    LAS unsigned char* UL = lds + 65536;
    LAS bf16* XPl = (LAS bf16*)(lds + 65536 + 66048);
    {   const unsigned char* fsrc = ws + WS_F + (size_t)g * 65536;
#pragma unroll
        for (int i = 0; i < 8; ++i) { const int idx = tid + 512 * i; *(LAS u32x4*)(FL + idx * 16) = *(const u32x4*)(fsrc + (size_t)idx * 16); }
#pragma unroll
        for (int i = 0; i < 8; ++i) { const int idx = tid + 512 * i, tok = idx >> 1, half = idx & 1;
            const u32x4 v = *(const u32x4*)(PROJ + ((size_t)b * T + 2048 * ct + tok) * NP + 2048 + 16 * g + 8 * half);
            *(LAS u32x4*)(UL + (tok >> 6) * UP + (tok & 63) * 32 + 16 * half) = v; } }
    {
        const int p = lane; const float ar = ((const float*)(ws + WS_ABL))[(g * 64 + p) * 2], ai = ((const float*)(ws + WS_ABL))[(g * 64 + p) * 2 + 1];
        const float* Sp = S5S + (size_t)((b * 32 + g) * 128) * 128;
        LAS float* SEG = (LAS float*)(lds + 65536 + 66048 + 8704);
        const int seg = 4 * ct;
        {   float xr = 0.f, xi = 0.f, qr = 1.f, qi = 0.f;
            for (int c = wave * seg; c < (wave + 1) * seg; ++c) { const float sr = Sp[c * 128 + p], si = Sp[c * 128 + 64 + p];
                const float nr = ar * xr - ai * xi + sr, ni = ar * xi + ai * xr + si; xr = nr; xi = ni; const float tr = qr * ar - qi * ai, ti = qr * ai + qi * ar; qr = tr; qi = ti; }
            SEG[(wave * 4 + 0) * 64 + p] = xr; SEG[(wave * 4 + 1) * 64 + p] = xi; SEG[(wave * 4 + 2) * 64 + p] = qr; SEG[(wave * 4 + 3) * 64 + p] = qi; }
        __syncthreads();
        if (wave == 0) {
            float xr = 0.f, xi = 0.f;
#pragma unroll
            for (int w = 0; w < 8; ++w) { const float sr = SEG[(w * 4 + 0) * 64 + p], si = SEG[(w * 4 + 1) * 64 + p], qr = SEG[(w * 4 + 2) * 64 + p], qi = SEG[(w * 4 + 3) * 64 + p];
                const float nr = qr * xr - qi * xi + sr, ni = qr * xi + qi * xr + si; xr = nr; xi = ni; }
#pragma unroll 8
            for (int n = 0; n < 32; ++n) { XPl[n * XPP + p] = (bf16)f2bf(xr); XPl[n * XPP + 64 + p] = (bf16)f2bf(xi);
                const int c = 32 * ct + n; const float sr = Sp[c * 128 + p], si = Sp[c * 128 + 64 + p]; const float nr = ar * xr - ai * xi + sr, ni = ar * xi + ai * xr + si; xr = nr; xi = ni; }
        }
    }
    __syncthreads();
    const int hh = lane >> 5, l31 = lane & 31;
    f32x16 acc[4];
#pragma unroll
    for (int i = 0; i < 4; ++i) acc[i] = zero16();
#define S5_SEG(I0, SLO, SHI) do { _Pragma("unroll 2") for (int s = (SLO); s <= (SHI); ++s) { \
        const bf16x8 Bf = *(const LAS bf16x8*)(UL + l31 * UP + s * 32 + 16 * hh); bf16x8 Af[4]; \
        _Pragma("unroll") for (int i = (I0); i < 4; ++i) Af[i] = *(const LAS bf16x8*)(FL + (2 * (wave + 8 * i) - s + 1) * 1024 + lane * 16); \
        _Pragma("unroll") for (int i = (I0); i < 4; ++i) acc[i] = MFMA32(Af[i], Bf, acc[i]); } } while (0)
    S5_SEG(0, 0, 2 * wave + 1);
    S5_SEG(1, 2 * wave + 2, 2 * wave + 17);
    S5_SEG(2, 2 * wave + 18, 2 * wave + 33);
    S5_SEG(3, 2 * wave + 34, 2 * wave + 49);
#undef S5_SEG
#pragma unroll
    for (int ks = 0; ks < 8; ++ks) { const bf16x8 Bf = *(const LAS bf16x8*)(XPl + l31 * XPP + 16 * ks + 8 * hh);
#pragma unroll
        for (int i = 0; i < 4; ++i) { const int R = wave + 8 * i;
            const bf16x8 A = mk8(*(const u32x4*)(ws + WS_WBIG + ((size_t)((g * 32 + R) * 8 + ks) * 64 + lane) * 16)); acc[i] = MFMA32(A, Bf, acc[i]); } }
#pragma unroll
    for (int i = 0; i < 4; ++i) { const int R = wave + 8 * i;
#pragma unroll
        for (int k = 0; k < 4; ++k) { const int jj = k >> 1; const size_t tok = (size_t)b * T + 2048 * ct + 64 * l31 + 2 * R + jj;
            u32x2 w; w.x = pk2(acc[i][4 * k], acc[i][4 * k + 1]); w.y = pk2(acc[i][4 * k + 2], acc[i][4 * k + 3]);
            *(u32x2*)(S5Y + tok * 512 + 16 * g + 8 * (k & 1) + 4 * hh) = w; } }
    __syncthreads();
}

__global__ void __launch_bounds__(NTHR, 2) hybrid_fwd(Args a) {
    extern __shared__ __attribute__((aligned(16))) unsigned char lds_raw[];
    LAS unsigned char* lds = (LAS unsigned char*)lds_raw;
    cg::grid_group grid = cg::this_grid();
    const int tid = threadIdx.x, lane = tid & 63, wave = __builtin_amdgcn_readfirstlane(tid >> 6);
    const int bx = blockIdx.x, G = gridDim.x, gw = bx * NWAVES + wave, NGW = G * NWAVES;
    unsigned char* ws = a.ws;
    const float* MOD = (const float*)(ws + WS_MOD);
    bf16* H = (bf16*)(ws + WS_H); bf16* PROJ = (bf16*)(ws + WS_PROJ); bf16* MIX = (bf16*)(ws + WS_MIX);

    if (tid < 4) ((LAS unsigned*)(lds + LDS_BYTES - 16))[tid] = 0u;
    __syncthreads();
    XcdBarrier xbar = xcd_barrier_post((unsigned*)ws, (volatile LAS unsigned*)(lds + LDS_BYTES - 16));
    phase0(a, lds, tid, lane, wave);
    xcd_barrier(xbar);
    norm_rows(a.in[0], a.in[2], MOD, H, gw, NGW, lane);
    __syncthreads();
    s5_tables(a, lds, bx * NTHR + tid, G * NTHR);
    {
        const bf16* WT = (const bf16*)(ws + WS_WIN1); float* SHW = (float*)(ws + WS_SHW);
        for (int col = gw; col < NP; col += NGW) {
            const u32x4 w0 = *(const u32x4*)(WT + (size_t)col * D + 16 * lane), w1 = *(const u32x4*)(WT + (size_t)col * D + 16 * lane + 8);
            float wf[16];
#pragma unroll
            for (int e = 0; e < 4; ++e) { wf[2 * e] = bflo(w0[e]); wf[2 * e + 1] = bfhi(w0[e]); wf[8 + 2 * e] = bflo(w1[e]); wf[8 + 2 * e + 1] = bfhi(w1[e]); }
#pragma unroll
            for (int b = 0; b < 4; ++b) { const float* sh = MOD + (4 + b) * 3072 + 16 * lane; float s = 0.f;
#pragma unroll
                for (int e = 0; e < 16; ++e) s += sh[e] * wf[e];
                s = wave_sum(s); if (lane == 0) SHW[b * 3072 + col] = s; } } }
    xcd_barrier(xbar);
    {   pg8::Gemm g{H, (const bf16*)(ws + WS_WIN0), M, NP, D}; pg8::StaticOrder S; S.init(M, NP, G, bx); pg8::EpiStore E{PROJ, NP};
        pg8::gemm_phase<pg8::EpiStore, pg8::StaticOrder, true, true>(lds, g, S, E); }
    xcd_barrier(xbar);
    for (int it = bx; it < 1024; it += G) prep_item<0>(a, lds, it, tid);
    for (int it = bx; it < 512; it += G) lru_item<1>(a, lds, it, tid, lane, wave);
    {
        const bf16* WT = (const bf16*)(ws + WS_WIN1); bf16* W1S = (bf16*)(ws + WS_W1S); const float* gain = a.in[16];
        for (int c = bx * NTHR + tid; c < 4 * 3072 * 128; c += G * NTHR) { const int b = c / (3072 * 128), rem = c % (3072 * 128), k8 = (rem & 127) * 8;
            const u32x4 wv = *(const u32x4*)(WT + (size_t)rem * 8); const float* sc = MOD + (4 + b) * 3072 + 1024 + k8; u32x4 o;
#pragma unroll
            for (int e = 0; e < 4; ++e) o[e] = pk2(bflo(wv[e]) * gain[k8 + 2 * e] * (1.f + sc[2 * e]), bfhi(wv[e]) * gain[k8 + 2 * e + 1] * (1.f + sc[2 * e + 1]));
            *(u32x4*)(W1S + (size_t)c * 8) = o; } }
    xcd_barrier(xbar);
    if (G == 256) {
        const int xcd = bx & 7, j = bx >> 3;
#pragma unroll 1
        for (int r = 0; r < 4; ++r) { const int bh = 4 * xcd + r, m = (r & 1) ? 31 - j : j; moba_item(a, lds, m * 32 + bh, tid, lane, wave); }
    } else {
#pragma unroll 1
        for (int it = bx; it < 1024; it += G) moba_item(a, lds, 1023 - it, tid, lane, wave);
    }
    for (int it = bx; it < 512; it += G) lru_item<2>(a, lds, it, tid, lane, wave);
    xcd_barrier(xbar);
    {   pg8::Gemm g{MIX, (const bf16*)(ws + WS_WOUT0), M, D, D}; pg8::StaticOrder S; S.init(M, D, G, bx);
        pg8::EpiRes1 E{a.in[0], MOD + 2048, (bf16*)(ws + WS_X1B), (float*)(ws + WS_SS)};
        pg8::gemm_phase<pg8::EpiRes1, pg8::StaticOrder, true, true>(lds, g, S, E); }
    xcd_barrier(xbar);
    {   pg8::Gemm g{(const bf16*)(ws + WS_X1B), (const bf16*)(ws + WS_W1S), M, NP, D, (size_t)3072 * 1024 * 2}; pg8::StaticOrder S; S.init(M, NP, G, bx); pg8::EpiStoreN E{PROJ, NP, (const float*)(ws + WS_SS), (const float*)(ws + WS_SHW)};
        pg8::gemm_phase<pg8::EpiStoreN, pg8::StaticOrder, true, true>(lds, g, S, E); }
    xcd_barrier(xbar);
    for (int it = bx; it < 1024; it += G) prep_item<1>(a, lds, it, tid);
    for (int it = bx; it < 512; it += G) s5_pass1(a, lds, it, tid, lane, wave);
    xcd_barrier(xbar);
    for (int it = bx; it < 512; it += G) s5_pass2(a, lds, it, tid, lane, wave);
    for (int it = gw; it < 8192; it += NGW) sb_item(a, lds + wave * 4608, it, lane);
    xcd_barrier(xbar);
    {   pg8::Gemm g{H, (const bf16*)(ws + WS_WGLU), M, 1024, 512}; pg8::StaticOrder S; S.init(M, 1024, G, bx); pg8::EpiGlu E{a.in[31], PROJ, MIX};
        pg8::gemm_phase<pg8::EpiGlu, pg8::StaticOrder, true, true>(lds, g, S, E); }
    xcd_barrier(xbar);
    {   pg8::Gemm g{MIX, (const bf16*)(ws + WS_WOUT1), M, D, D}; pg8::StaticOrder S; S.init(M, D, G, bx); pg8::EpiRes2 E{(const bf16*)(ws + WS_X1B), a.out, MOD + 4 * 3072 + 2048};
        pg8::gemm_phase<pg8::EpiRes2, pg8::StaticOrder, true, true>(lds, g, S, E); }
    if (gridDim.y == 0x7fffu) grid.sync();
}

extern "C" void kernel_launch(void* const* d_in, const int* in_sizes, int n_in, void* d_out, int out_size, void* d_ws, size_t ws_size, hipStream_t stream) {
    static int grid = 0;
    if (grid == 0) {
        if (n_in != 33 || out_size != M * D || ws_size < WS_END) { fprintf(stderr, "kernel_launch: unexpected shapes (n_in %d out %d ws %zu)\n", n_in, out_size, ws_size); grid = -1; return; }
        int dev = 0, cus = 0, per_cu = 0;
        hipGetDevice(&dev); hipDeviceGetAttribute(&cus, hipDeviceAttributeMultiprocessorCount, dev);
        hipFuncSetAttribute((const void*)hybrid_fwd, hipFuncAttributeMaxDynamicSharedMemorySize, LDS_BYTES);
        hipOccupancyMaxActiveBlocksPerMultiprocessor(&per_cu, (const void*)hybrid_fwd, NTHR, LDS_BYTES);
        if (per_cu < 1) per_cu = 1;
        grid = cus * per_cu; if (grid > 256) grid = 256;
        (void)hipGetLastError();
    }
    if (grid < 0) return;
    if (hipMemsetAsync(d_ws, 0, 262144, stream) != hipSuccess) { fprintf(stderr, "kernel_launch: memset failed\n"); return; }
    Args a{};
    for (int i = 0; i < 33; ++i) a.in[i] = (const float*)d_in[i];
    a.out = (float*)d_out; a.ws = (unsigned char*)d_ws;
    void* args[] = {&a};
    hipError_t e = hipLaunchCooperativeKernel((const void*)hybrid_fwd, dim3(grid), dim3(NTHR), args, LDS_BYTES, stream);
    if (e != hipSuccess) fprintf(stderr, "cooperative launch failed: %s (grid %d)\n", hipGetErrorString(e), grid);
}
```

```cpp
#include <hip/hip_runtime.h>
#include <hip/hip_cooperative_groups.h>
#include <cstdio>
#include <cstdint>
namespace cg = cooperative_groups;
namespace pg8 {
#define PG8_LAS __attribute__((address_space(3)))
typedef unsigned short bf16_t;
typedef short bf16x8 __attribute__((ext_vector_type(8)));
typedef float f32x4 __attribute__((ext_vector_type(4)));
typedef unsigned u32x4 __attribute__((ext_vector_type(4)));
constexpr int BM = 256, BK = 64, HALF = 128, HTB = HALF * BK * 2  , STAGE_BYTES = 8 * HTB, NXCD = 8, WGM = 8;

__host__ __device__ __forceinline__ int lds_byte(int r, int c) { const int st = (r >> 4) * 2 + (c >> 5), rr = r & 15, cc = c & 31, ob = rr * 64 + cc * 2; return st * 1024 + (ob ^ (((ob >> 9) & 1) << 5)); }
__host__ __device__ __forceinline__ void stage_rc(int b, int& R, int& C) { const int st = b / 1024, sb = b % 1024, swz = sb ^ (((sb >> 9) & 1) << 5); R = (st >> 1) * 16 + swz / 64; C = (st & 1) * 32 + (swz % 64) / 2; }
__host__ __device__ __forceinline__ int perm32(int rho) { const int n = rho >> 4, i = rho & 15; return 8 * (i >> 2) + 4 * n + (i & 3); }

struct Unit { int pm, pn; };
struct Gemm { const bf16_t* A; const bf16_t* Bt; int M, N, K; size_t bstride; };

struct StaticOrder {
    int nM, nN, nwg, G, c;
    __host__ __device__ void init(int M, int N, int G_, int c_) { nM = M / BM; nN = N / BM; nwg = nM * nN; G = G_; c = c_; }
    __host__ __device__ bool next(int i, Unit& u) const {
        const long L = (long)i * G + c; if (L >= nwg) return false;
        int wgid = (int)L; { const int q = nwg / NXCD, r = nwg % NXCD, xcd = wgid % NXCD, off = wgid / NXCD; wgid = (xcd < r ? xcd * (q + 1) : r * (q + 1) + (xcd - r) * q) + off; }
        const int nig = WGM * nN, gid = wgid / nig, fm = gid * WGM, gsz = (nM - fm) < WGM ? (nM - fm) : WGM;
        u.pm = fm + ((wgid % nig) % gsz); u.pn = (wgid % nig) / gsz; return true;
    }
    __device__ __forceinline__ void a_ready(const Unit&) const {}
    __device__ __forceinline__ void done(const Unit&) const {}
};

typedef __bf16 hwbf2 __attribute__((ext_vector_type(2)));
typedef float f32x2p __attribute__((ext_vector_type(2)));
__device__ __forceinline__ unsigned pk2f(float lo, float hi) { f32x2p v; v.x = lo; v.y = hi; return __builtin_bit_cast(unsigned, __builtin_convertvector(v, hwbf2)); }
__device__ __forceinline__ float bflo(unsigned w) { return __builtin_bit_cast(float, w << 16); }
__device__ __forceinline__ float bfhi(unsigned w) { return __builtin_bit_cast(float, w & 0xffff0000u); }
struct EpiStore {
    static constexpr bool PERM = true, AFTER_DRAIN = false;
    bf16_t* O; int ldc;
    __device__ __forceinline__ void operator()(const f32x4 (&acc)[2][2][4][2], const Unit& u, int wr, int wc, int fr, int fq) const {
        const int row0 = u.pm * BM + wr * 64 + fr, col0 = u.pn * BM + wc * 32 + 8 * fq;
#pragma unroll
        for (int ai = 0; ai < 2; ++ai)
#pragma unroll
            for (int m = 0; m < 4; ++m) { bf16_t* rowp = O + (size_t)(row0 + ai * HALF + m * 16) * ldc + col0;
#pragma unroll
                for (int bj = 0; bj < 2; ++bj) { const f32x4 v0 = acc[ai][bj][m][0], v1 = acc[ai][bj][m][1];
                    u32x4 w; w.x = pk2f(v0[0], v0[1]); w.y = pk2f(v0[2], v0[3]); w.z = pk2f(v1[0], v1[1]); w.w = pk2f(v1[2], v1[3]);
                    *(u32x4*)(rowp + bj * HALF) = w; } }
    }
};
struct EpiRes {
    static constexpr bool PERM = false, AFTER_DRAIN = false;
    const float* X; float* O; const float* gate;
    __device__ __forceinline__ void operator()(const f32x4 (&acc)[2][2][4][2], const Unit& u, int wr, int wc, int fr, int fq) const {
        const int row0 = u.pm * BM + wr * 64 + fr, col0 = u.pn * BM + wc * 32 + 4 * fq, b = (u.pm * BM) >> 13;
        f32x4 gv[2][2];
#pragma unroll
        for (int bj = 0; bj < 2; ++bj)
#pragma unroll
            for (int n = 0; n < 2; ++n) gv[bj][n] = *(const f32x4*)(gate + b * 3072 + col0 + bj * HALF + n * 16);
#pragma unroll
        for (int ai = 0; ai < 2; ++ai)
#pragma unroll
            for (int m = 0; m < 4; ++m) { const size_t ro = (size_t)(row0 + ai * HALF + m * 16) * 1024 + col0;
#pragma unroll
                for (int bj = 0; bj < 2; ++bj)
#pragma unroll
                    for (int n = 0; n < 2; ++n) { const size_t idx = ro + bj * HALF + n * 16; const f32x4 xv = *(const f32x4*)(X + idx); *(f32x4*)(O + idx) = xv + gv[bj][n] * acc[ai][bj][m][n]; } }
    }
};
struct EpiRes1 {
    static constexpr bool PERM = true, AFTER_DRAIN = false;
    const float* X; const float* gate; bf16_t* X1B; float* SS;
    __device__ __forceinline__ void operator()(const f32x4 (&acc)[2][2][4][2], const Unit& u, int wr, int wc, int fr, int fq) const {
        const int row0 = u.pm * BM + wr * 64 + fr, col0 = u.pn * BM + wc * 32 + 8 * fq, b = (u.pm * BM) >> 13;
        f32x4 gv[2][2];
#pragma unroll
        for (int bj = 0; bj < 2; ++bj)
#pragma unroll
            for (int n = 0; n < 2; ++n) gv[bj][n] = *(const f32x4*)(gate + b * 3072 + col0 + bj * HALF + n * 4);
#pragma unroll
        for (int ai = 0; ai < 2; ++ai)
#pragma unroll
        for (int mh = 0; mh < 2; ++mh) {
            f32x4 xv[2][2][2];
#pragma unroll
            for (int mm = 0; mm < 2; ++mm)
#pragma unroll
                for (int bj = 0; bj < 2; ++bj) { const size_t idx = (size_t)(row0 + ai * HALF + (2 * mh + mm) * 16) * 1024 + col0 + bj * HALF; xv[mm][bj][0] = *(const f32x4*)(X + idx); xv[mm][bj][1] = *(const f32x4*)(X + idx + 4); }
#pragma unroll
            for (int mm = 0; mm < 2; ++mm) { const int m = 2 * mh + mm; const int row = row0 + ai * HALF + m * 16; const size_t ro = (size_t)row * 1024 + col0; float s = 0.f;
#pragma unroll
                for (int bj = 0; bj < 2; ++bj) { const size_t idx = ro + bj * HALF;
                    const f32x4 y0 = xv[mm][bj][0] + gv[bj][0] * acc[ai][bj][m][0], y1 = xv[mm][bj][1] + gv[bj][1] * acc[ai][bj][m][1];
                    s += ((y0[0] * y0[0] + y0[1] * y0[1]) + (y0[2] * y0[2] + y0[3] * y0[3])) + ((y1[0] * y1[0] + y1[1] * y1[1]) + (y1[2] * y1[2] + y1[3] * y1[3]));
                    u32x4 w; w.x = pk2f(y0[0], y0[1]); w.y = pk2f(y0[2], y0[3]); w.z = pk2f(y1[0], y1[1]); w.w = pk2f(y1[2], y1[3]); *(u32x4*)(X1B + idx) = w; }
                s += __shfl_xor(s, 16); s += __shfl_xor(s, 32);
                if (fq == 0) __hip_atomic_fetch_add(SS + row, s, __ATOMIC_RELAXED, __HIP_MEMORY_SCOPE_AGENT); }
        }
    }
};
struct EpiRes2 {
    static constexpr bool PERM = true, AFTER_DRAIN = false;
    const bf16_t* X1B; float* O; const float* gate;
    __device__ __forceinline__ void operator()(const f32x4 (&acc)[2][2][4][2], const Unit& u, int wr, int wc, int fr, int fq) const {
        const int row0 = u.pm * BM + wr * 64 + fr, col0 = u.pn * BM + wc * 32 + 8 * fq, b = (u.pm * BM) >> 13;
        f32x4 gv[2][2];
#pragma unroll
        for (int bj = 0; bj < 2; ++bj)
#pragma unroll
            for (int n = 0; n < 2; ++n) gv[bj][n] = *(const f32x4*)(gate + b * 3072 + col0 + bj * HALF + n * 4);
#pragma unroll
        for (int ai = 0; ai < 2; ++ai) {
            u32x4 xw[4][2];
#pragma unroll
            for (int m = 0; m < 4; ++m)
#pragma unroll
                for (int bj = 0; bj < 2; ++bj) xw[m][bj] = *(const u32x4*)(X1B + (size_t)(row0 + ai * HALF + m * 16) * 1024 + col0 + bj * HALF);
#pragma unroll
            for (int m = 0; m < 4; ++m) { const size_t ro = (size_t)(row0 + ai * HALF + m * 16) * 1024 + col0;
#pragma unroll
                for (int bj = 0; bj < 2; ++bj) { const size_t idx = ro + bj * HALF; const u32x4 q = xw[m][bj];
                    f32x4 x0, x1; x0[0] = bflo(q.x); x0[1] = bfhi(q.x); x0[2] = bflo(q.y); x0[3] = bfhi(q.y); x1[0] = bflo(q.z); x1[1] = bfhi(q.z); x1[2] = bflo(q.w); x1[3] = bfhi(q.w);
                    *(f32x4*)(O + idx) = x0 + gv[bj][0] * acc[ai][bj][m][0]; *(f32x4*)(O + idx + 4) = x1 + gv[bj][1] * acc[ai][bj][m][1]; } }
        }
    }
};
struct EpiStoreN {
    static constexpr bool PERM = true, AFTER_DRAIN = false;
    bf16_t* O; int ldc; const float* SS; const float* shw;
    __device__ __forceinline__ void operator()(const f32x4 (&acc)[2][2][4][2], const Unit& u, int wr, int wc, int fr, int fq) const {
        const int row0 = u.pm * BM + wr * 64 + fr, col0 = u.pn * BM + wc * 32 + 8 * fq, b = (u.pm * BM) >> 13;
        f32x4 sw[2][2];
#pragma unroll
        for (int bj = 0; bj < 2; ++bj) { sw[bj][0] = *(const f32x4*)(shw + b * 3072 + col0 + bj * HALF); sw[bj][1] = *(const f32x4*)(shw + b * 3072 + col0 + bj * HALF + 4); }
        float ssv[2][4];
#pragma unroll
        for (int ai = 0; ai < 2; ++ai)
#pragma unroll
            for (int m = 0; m < 4; ++m) ssv[ai][m] = SS[row0 + ai * HALF + m * 16];
#pragma unroll
        for (int ai = 0; ai < 2; ++ai)
#pragma unroll
            for (int m = 0; m < 4; ++m) { const int row = row0 + ai * HALF + m * 16; bf16_t* rowp = O + (size_t)row * ldc + col0;
                const float rstd = __builtin_amdgcn_rsqf(ssv[ai][m] * (1.f / 1024.f) + 1e-6f);
#pragma unroll
                for (int bj = 0; bj < 2; ++bj) { const f32x4 v0 = acc[ai][bj][m][0] * rstd + sw[bj][0], v1 = acc[ai][bj][m][1] * rstd + sw[bj][1];
                    u32x4 w; w.x = pk2f(v0[0], v0[1]); w.y = pk2f(v0[2], v0[3]); w.z = pk2f(v1[0], v1[1]); w.w = pk2f(v1[2], v1[3]);
                    *(u32x4*)(rowp + bj * HALF) = w; } }
    }
};
struct EpiGlu {
    static constexpr bool PERM = true, AFTER_DRAIN = false;
    const float* bias; const bf16_t* proj; bf16_t* mix;
    __device__ __forceinline__ void operator()(const f32x4 (&acc)[2][2][4][2], const Unit& u, int wr, int wc, int fr, int fq) const {
        const int row0 = u.pm * BM + wr * 64 + fr, colv = u.pn * 128 + wc * 32 + 8 * fq;
        const f32x4 bv0 = *(const f32x4*)(bias + colv), bv1 = *(const f32x4*)(bias + colv + 4), bg0 = *(const f32x4*)(bias + 512 + colv), bg1 = *(const f32x4*)(bias + 512 + colv + 4);
        u32x4 gsv[2][4];
#pragma unroll
        for (int ai = 0; ai < 2; ++ai)
#pragma unroll
            for (int m = 0; m < 4; ++m) gsv[ai][m] = *(const u32x4*)(proj + (size_t)(row0 + ai * HALF + m * 16) * 3072 + 2560 + colv);
#pragma unroll
        for (int ai = 0; ai < 2; ++ai)
#pragma unroll
            for (int m = 0; m < 4; ++m) { const size_t row = (size_t)(row0 + ai * HALF + m * 16);
                const u32x4 gs = gsv[ai][m];
                const f32x4 va = acc[ai][0][m][0] + bv0, vb = acc[ai][0][m][1] + bv1, ga = acc[ai][1][m][0] + bg0, gb = acc[ai][1][m][1] + bg1;
                float y[8];
#pragma unroll
                for (int e = 0; e < 4; ++e) { const float g0 = (e & 1) ? bfhi(gs[e >> 1]) : bflo(gs[e >> 1]); const float g1 = (e & 1) ? bfhi(gs[2 + (e >> 1)]) : bflo(gs[2 + (e >> 1)]);
                    y[e] = va[e] * __builtin_amdgcn_rcpf(1.f + __expf(-ga[e])) * (g0 * __builtin_amdgcn_rcpf(1.f + __expf(-g0))); y[4 + e] = vb[e] * __builtin_amdgcn_rcpf(1.f + __expf(-gb[e])) * (g1 * __builtin_amdgcn_rcpf(1.f + __expf(-g1))); }
                u32x4 w; w.x = pk2f(y[0], y[1]); w.y = pk2f(y[2], y[3]); w.z = pk2f(y[4], y[5]); w.w = pk2f(y[6], y[7]);
                *(u32x4*)(mix + row * 1024 + 512 + colv) = w; }
    }
};
template <class Epi, class Sched, bool ALIGN_EPI = false, bool SP2 = false>
__device__ __forceinline__ void gemm_phase(PG8_LAS unsigned char* lds, const Gemm g, const Sched& S, const Epi& E) {
    int tid_ = threadIdx.x; asm volatile("" : "+v"(tid_));
    const int tid = tid_, wid = __builtin_amdgcn_readfirstlane(tid >> 6), lane = tid & 63, wr = wid >> 2, wc = wid & 3, fr = lane & 15, fq = lane >> 4;
    const int K = g.K, nt = K / BK;
    unsigned voffA[2], voffB[2];
#pragma unroll
    for (int i = 0; i < 2; ++i) { int R, C; stage_rc(tid * 16 + i * 8192, R, C); const int Rb = Epi::PERM ? ((R & ~31) + perm32(R & 31)) : R;
        voffA[i] = (unsigned)(R * K + C) * 2u; voffB[i] = (unsigned)(Rb * K + C) * 2u; }
    const size_t kstep = (size_t)(BK * 2);
    const size_t hstep = (size_t)HALF * K * 2;
    const size_t tstep = 2 * hstep;
    const unsigned ldsw = (unsigned)wid * 1024u;
    const int aoff = lds_byte(wr * 64 + fr, fq * 8), boff = lds_byte(wc * 32 + fr, fq * 8);
#define PG8_SA(b, h) (((b) * 2 + (h)) * HTB)
#define PG8_SB(b, h) ((4 + (b) * 2 + (h)) * HTB)
#define PG8_STAGE(bufoff, gbase, voff) do { _Pragma("unroll") for (int _i = 0; _i < 2; ++_i) \
        __builtin_amdgcn_global_load_lds((const unsigned*)((const char*)(gbase) + (voff)[_i]), (PG8_LAS unsigned*)(lds + (bufoff) + ldsw + _i * 8192), 16, 0, 0); } while (0)
#define PG8_LDA(dst, b, h) do { _Pragma("unroll") for (int m = 0; m < 4; ++m) _Pragma("unroll") for (int k = 0; k < 2; ++k) dst[m][k] = *(const PG8_LAS bf16x8*)(lds + PG8_SA(b, h) + aoff + m * 2048 + k * 1024); } while (0)
#define PG8_LDB(dst, b, h) do { _Pragma("unroll") for (int n = 0; n < 2; ++n) _Pragma("unroll") for (int k = 0; k < 2; ++k) dst[n][k] = *(const PG8_LAS bf16x8*)(lds + PG8_SB(b, h) + boff + n * 2048 + k * 1024); } while (0)
#define PG8_MMA(ai, bj, At, Bt) do { __builtin_amdgcn_s_setprio(1); _Pragma("unroll") for (int m = 0; m < 4; ++m) _Pragma("unroll") for (int n = 0; n < 2; ++n) _Pragma("unroll") for (int k = 0; k < 2; ++k) \
        acc[ai][bj][m][n] = __builtin_amdgcn_mfma_f32_16x16x32_bf16(Bt[n][k], At[m][k], acc[ai][bj][m][n], 0, 0, 0); __builtin_amdgcn_s_setprio(0); } while (0)
#define PG8_WAIT_V(n) asm volatile("s_waitcnt vmcnt(" #n ")" ::: "memory")
#define PG8_WAIT_L(n) asm volatile("s_waitcnt lgkmcnt(" #n ")" ::: "memory")
#define PG8_BAR __builtin_amdgcn_s_barrier()
#define PG8_SCHED __builtin_amdgcn_sched_barrier(0)
    Unit cur, nxt; int ui = 0;
    if (!S.next(0, cur)) return;
    f32x4 acc[2][2][4][2];
#pragma unroll
    for (int a = 0; a < 2; ++a)
#pragma unroll
        for (int b = 0; b < 2; ++b)
#pragma unroll
            for (int m = 0; m < 4; ++m)
#pragma unroll
                for (int n = 0; n < 2; ++n) acc[a][b][m][n] = (f32x4){0.f, 0.f, 0.f, 0.f};
    bf16x8 At[4][2], B0[2][2], B1[2][2];
    const char* cA = (const char*)g.A + (size_t)cur.pm * tstep; const char* cB = (const char*)g.Bt + (size_t)cur.pn * tstep + (size_t)(cur.pm >> 5) * g.bstride;
    S.a_ready(cur);
    if constexpr (SP2) {
        PG8_STAGE(PG8_SB(0, 0), cB, voffB); PG8_STAGE(PG8_SB(0, 1), cB + hstep, voffB); PG8_STAGE(PG8_SA(0, 0), cA, voffA); PG8_STAGE(PG8_SA(0, 1), cA + hstep, voffA);
        if (wr == 1) PG8_BAR;
        PG8_WAIT_V(2); PG8_BAR;
        PG8_STAGE(PG8_SB(1, 0), cB + kstep, voffB); PG8_STAGE(PG8_SA(1, 0), cA + kstep, voffA); PG8_STAGE(PG8_SB(1, 1), cB + hstep + kstep, voffB);
        PG8_WAIT_V(6); PG8_BAR;
    } else {
        PG8_STAGE(PG8_SB(0, 0), cB, voffB); PG8_STAGE(PG8_SA(0, 0), cA, voffA); PG8_STAGE(PG8_SB(0, 1), cB + hstep, voffB); PG8_STAGE(PG8_SA(0, 1), cA + hstep, voffA);
        if (wr == 1) PG8_BAR;
        PG8_WAIT_V(4); PG8_BAR;
        PG8_STAGE(PG8_SB(1, 0), cB + kstep, voffB); PG8_STAGE(PG8_SA(1, 0), cA + kstep, voffA); PG8_STAGE(PG8_SB(1, 1), cB + hstep + kstep, voffB);
        PG8_WAIT_V(6); PG8_BAR;
    }
    for (;;) {
        const bool has_next = S.next(ui + 1, nxt);
        const char* nA = has_next ? (const char*)g.A + (size_t)nxt.pm * tstep : cA; const char* nB = has_next ? (const char*)g.Bt + (size_t)nxt.pn * tstep + (size_t)(nxt.pm >> 5) * g.bstride : cB;
        for (int t = 0; t < nt; t += 2) {
            const bool last = (t == nt - 2);
            const char* a1 = cA + (size_t)(t + 1) * kstep;
            const char* a2 = last ? nA : cA + (size_t)(t + 2) * kstep; const char* b2 = last ? nB : cB + (size_t)(t + 2) * kstep;
            const char* a3 = a2 + kstep; const char* b3 = b2 + kstep;
            if (last && has_next) S.a_ready(nxt);
            if constexpr (SP2) {
            PG8_LDB(B0, 0, 0); PG8_LDB(B1, 0, 1); PG8_SCHED; PG8_LDA(At, 0, 0); PG8_STAGE(PG8_SA(1, 1), a1 + hstep, voffA);
            PG8_WAIT_V(8); PG8_WAIT_L(0); PG8_BAR; PG8_MMA(0, 0, At, B0); PG8_MMA(0, 1, At, B1); PG8_BAR; PG8_SCHED;
            PG8_LDA(At, 0, 1); PG8_STAGE(PG8_SB(0, 0), b2, voffB); PG8_STAGE(PG8_SB(0, 1), b2 + hstep, voffB); PG8_STAGE(PG8_SA(0, 0), a2, voffA);
            PG8_WAIT_V(8); PG8_WAIT_L(0); PG8_BAR; PG8_MMA(1, 0, At, B0); PG8_MMA(1, 1, At, B1); PG8_BAR; PG8_SCHED;
            PG8_LDB(B0, 1, 0); PG8_LDB(B1, 1, 1); PG8_SCHED; PG8_LDA(At, 1, 0); PG8_STAGE(PG8_SA(0, 1), a2 + hstep, voffA);
            PG8_WAIT_V(8); PG8_WAIT_L(0); PG8_BAR; PG8_MMA(0, 0, At, B0); PG8_MMA(0, 1, At, B1); PG8_BAR; PG8_SCHED;
            PG8_LDA(At, 1, 1); PG8_STAGE(PG8_SB(1, 0), b3, voffB); PG8_STAGE(PG8_SB(1, 1), b3 + hstep, voffB); PG8_STAGE(PG8_SA(1, 0), a3, voffA);
            PG8_WAIT_V(8); PG8_WAIT_L(0); PG8_BAR; PG8_MMA(1, 0, At, B0); PG8_MMA(1, 1, At, B1); PG8_BAR; PG8_SCHED;
            } else {
            PG8_LDB(B0, 0, 0); PG8_SCHED; PG8_LDA(At, 0, 0); PG8_STAGE(PG8_SA(1, 1), a1 + hstep, voffA);
            PG8_WAIT_L(8); PG8_BAR; PG8_WAIT_L(0); PG8_MMA(0, 0, At, B0); PG8_BAR; PG8_SCHED;
            PG8_LDB(B1, 0, 1); PG8_STAGE(PG8_SB(0, 0), b2, voffB);
            PG8_BAR; PG8_WAIT_L(0); PG8_MMA(0, 1, At, B1); PG8_BAR;
            PG8_LDA(At, 0, 1); PG8_STAGE(PG8_SA(0, 0), a2, voffA);
            PG8_BAR; PG8_WAIT_L(0); PG8_MMA(1, 0, At, B0); PG8_BAR; PG8_SCHED;
            PG8_STAGE(PG8_SB(0, 1), b2 + hstep, voffB);
            PG8_WAIT_V(6); PG8_BAR; PG8_MMA(1, 1, At, B1); PG8_BAR;
            PG8_LDB(B0, 1, 0); PG8_SCHED; PG8_LDA(At, 1, 0); PG8_STAGE(PG8_SA(0, 1), a2 + hstep, voffA);
            PG8_WAIT_L(8); PG8_BAR; PG8_WAIT_L(0); PG8_MMA(0, 0, At, B0); PG8_BAR; PG8_SCHED;
            PG8_LDB(B1, 1, 1); PG8_STAGE(PG8_SB(1, 0), b3, voffB);
            PG8_BAR; PG8_WAIT_L(0); PG8_MMA(0, 1, At, B1); PG8_BAR;
            PG8_LDA(At, 1, 1); PG8_STAGE(PG8_SA(1, 0), a3, voffA);
            PG8_BAR; PG8_WAIT_L(0); PG8_MMA(1, 0, At, B0); PG8_BAR; PG8_SCHED;
            PG8_STAGE(PG8_SB(1, 1), b3 + hstep, voffB);
            PG8_WAIT_V(6); PG8_BAR; PG8_MMA(1, 1, At, B1); PG8_BAR;
            }
        }
        if constexpr (ALIGN_EPI) { if (wr == 0) PG8_BAR; }
        if constexpr (!Epi::AFTER_DRAIN) { E(acc, cur, wr, wc, fr, fq); S.done(cur); }
        if (!has_next) break;
#pragma unroll
        for (int a = 0; a < 2; ++a)
#pragma unroll
            for (int b = 0; b < 2; ++b)
#pragma unroll
                for (int m = 0; m < 4; ++m)
#pragma unroll
                    for (int n = 0; n < 2; ++n) acc[a][b][m][n] = (f32x4){0.f, 0.f, 0.f, 0.f};
        cur = nxt; cA = nA; cB = nB; ++ui;
        if constexpr (ALIGN_EPI) { if (wr == 1) PG8_BAR; }
    }
    PG8_WAIT_V(0);
    if constexpr (!ALIGN_EPI) { if (wr == 0) PG8_BAR; }
    PG8_BAR;
    if constexpr (Epi::AFTER_DRAIN) { E.fused(acc, cur, wr, wc, fr, fq, lds, wid, lane); S.done(cur); }
#undef PG8_SA
#undef PG8_SB
#undef PG8_STAGE
#undef PG8_LDA
#undef PG8_LDB
#undef PG8_MMA
#undef PG8_WAIT_V
#undef PG8_WAIT_L
#undef PG8_BAR
#undef PG8_SCHED
}
}
#define DI __device__ __forceinline__
#define LAS __attribute__((address_space(3)))
typedef unsigned short bf16;
typedef short bf16x8 __attribute__((ext_vector_type(8)));
typedef float f32x4 __attribute__((ext_vector_type(4)));
typedef float f32x2 __attribute__((ext_vector_type(2)));
typedef float f32x16 __attribute__((ext_vector_type(16)));
typedef unsigned u32x4 __attribute__((ext_vector_type(4)));
typedef unsigned u32x2 __attribute__((ext_vector_type(2)));
#define MFMA32(a, b, c) __builtin_amdgcn_mfma_f32_32x32x16_bf16((a), (b), (c), 0, 0, 0)

constexpr int NB = 4, T = 8192, D = 1024, M = NB * T, NP = 3072;
constexpr int NWAVES = 8, NTHR = 512;
constexpr int LDS_BYTES = 155648;
constexpr size_t MiB = 1u << 20;
constexpr size_t WS_MOD = 1 * MiB;
constexpr size_t WS_SS = 128 * 1024;
constexpr size_t WS_SHW = 1 * MiB + 256 * 1024;
constexpr size_t WS_GW = 1 * MiB + 512 * 1024;
constexpr size_t WS_ABL = 2 * MiB;
constexpr size_t WS_BB = 2 * MiB + 65536;
constexpr size_t WS_PW = 3 * MiB;
constexpr size_t WS_F = 5 * MiB;
constexpr size_t WS_VBIG = 8 * MiB;
constexpr size_t WS_WBIG = 16 * MiB;
constexpr size_t WS_WIN0 = 24 * MiB, WS_WOUT0 = 30 * MiB, WS_WIN1 = 32 * MiB, WS_WGLU = 38 * MiB, WS_WOUT1 = 39 * MiB;
constexpr size_t WS_KMEAN = 41 * MiB;
constexpr size_t WS_LRUSUM = 42 * MiB;
constexpr size_t WS_S5S = 44 * MiB;
constexpr size_t WS_VT = 52 * MiB;
constexpr size_t WS_H = 84 * MiB;
constexpr size_t WS_MIX = 148 * MiB;
constexpr size_t WS_PROJ = 212 * MiB;
constexpr size_t WS_KF = 404 * MiB;
constexpr size_t WS_X1B = 436 * MiB;
constexpr size_t WS_W1S = 116 * MiB;
constexpr size_t WS_END = 500 * MiB;

struct Args { const float* in[33]; float* out; unsigned char* ws; };

DI unsigned f2bf(float f) { unsigned u = __builtin_bit_cast(unsigned, f); return (u + 0x7fffu + ((u >> 16) & 1u)) >> 16; }
DI unsigned pk2(float lo, float hi) { return pg8::pk2f(lo, hi); }
DI float bf2f(unsigned short b) { return __builtin_bit_cast(float, (unsigned)b << 16); }
DI float bflo(unsigned w) { return __builtin_bit_cast(float, w << 16); }
DI float bfhi(unsigned w) { return __builtin_bit_cast(float, w & 0xffff0000u); }
DI int crow(int reg, int h) { return (reg & 3) + 8 * (reg >> 2) + 4 * h; }
DI float sigm(float x) { return __builtin_amdgcn_rcpf(1.f + __expf(-x)); }
DI float silu(float x) { return x * __builtin_amdgcn_rcpf(1.f + __expf(-x)); }
DI bf16x8 mk8(u32x4 v) { return __builtin_bit_cast(bf16x8, v); }
DI bf16x8 pack8(float a0, float a1, float a2, float a3, float a4, float a5, float a6, float a7) { u32x4 v; v.x = pk2(a0, a1); v.y = pk2(a2, a3); v.z = pk2(a4, a5); v.w = pk2(a6, a7); return __builtin_bit_cast(bf16x8, v); }
DI f32x16 zero16() { f32x16 z;
#pragma unroll
  for (int i = 0; i < 16; ++i) z[i] = 0.f; return z; }

#define XB_TMO      128
#define XB_XCNT(j)  (256  + 64 * (j))
#define XB_XSUB(j)  (1280 + 64 * (j))
#define XB_XGEN(j)  (2304 + 64 * (j))
#define XB_TOP      3328
#define XB_TOPGEN   3392
#define XCD_BAR_WORDS 3456
#define XB_SPIN_CAP (1u << 18)

__device__ __forceinline__ unsigned xb_ld(unsigned* p)              { return __hip_atomic_load(p, __ATOMIC_RELAXED, __HIP_MEMORY_SCOPE_AGENT); }
__device__ __forceinline__ unsigned xb_add(unsigned* p, unsigned v) { return __hip_atomic_fetch_add(p, v, __ATOMIC_RELAXED, __HIP_MEMORY_SCOPE_AGENT); }
__device__ __forceinline__ unsigned xb_xcc_id() { return (unsigned)__builtin_amdgcn_s_getreg((3 << 11) | 20) & 0xFu; }
#define XB_SPIN(cond, bar) do { unsigned _sp = 0; while (cond) { __builtin_amdgcn_s_sleep(1); \
    if ((++_sp & 255u) == 0u) { if (xb_ld(&(bar)[XB_TMO])) break; if (_sp > XB_SPIN_CAP) { atomicAdd(&(bar)[XB_TMO], 1u); break; } } } } while (0)

struct XcdBarrier {
    unsigned* bar; unsigned x;
    volatile LAS unsigned* st;
};

__device__ __forceinline__ XcdBarrier xcd_barrier_post(unsigned* bar, volatile LAS unsigned* st) {
    XcdBarrier b; b.bar = bar; b.x = xb_xcc_id(); b.st = st;
    if (threadIdx.x == 0) (void)xb_add(&bar[XB_XCNT(b.x)], 1u);
    return b;
}
__device__ __forceinline__ void xcd_barrier_complete(unsigned* bar, unsigned x, unsigned& nloc, unsigned& nx) {
    const unsigned G = gridDim.x * gridDim.y * gridDim.z;
    unsigned sum, cnt, mine, sp = 0u;
    for (;;) {
        sum = 0u; cnt = 0u; mine = 0u;
#pragma unroll
        for (unsigned j = 0; j < 16; ++j) { const unsigned c = xb_ld(&bar[XB_XCNT(j)]); sum += c; cnt += (c > 0u) ? 1u : 0u; mine = (j == x) ? c : mine; }
        if (sum == G) break;
        __builtin_amdgcn_s_sleep(1);
        if ((++sp & 255u) == 0u) { if (xb_ld(&bar[XB_TMO])) break; if (sp > XB_SPIN_CAP) { atomicAdd(&bar[XB_TMO], 1u); break; } }
    }
    nloc = mine > 0u ? mine : 1u; nx = cnt > 0u ? cnt : 1u;
}

__device__ __forceinline__ void xcd_barrier(const XcdBarrier& b) {
    asm volatile("s_waitcnt vmcnt(0)" ::: "memory");
    __syncthreads();
    if (threadIdx.x == 0) {
        unsigned* bar = b.bar;
        __builtin_amdgcn_s_waitcnt(0);
        unsigned nloc = b.st[0], nx = b.st[1];
        if (nloc == 0u) { xcd_barrier_complete(bar, b.x, nloc, nx); b.st[0] = nloc; b.st[1] = nx; }
        const unsigned old = xb_add(&bar[XB_XSUB(b.x)], 1u);
        const unsigned gen = old / nloc;
        if (old + 1u == (gen + 1u) * nloc) {
            __builtin_amdgcn_fence(__ATOMIC_RELEASE, "agent");
            asm volatile("s_waitcnt vmcnt(0)" ::: "memory");
            const unsigned og = xb_add(&bar[XB_TOP], 1u);
            const unsigned tg = og / nx;
            if (og + 1u == (tg + 1u) * nx) xb_add(&bar[XB_TOPGEN], 1u);
            else XB_SPIN(xb_ld(&bar[XB_TOPGEN]) == tg, bar);
            __builtin_amdgcn_fence(__ATOMIC_ACQUIRE, "agent");
            xb_add(&bar[XB_XGEN(b.x)], 1u);
            asm volatile("s_waitcnt vmcnt(0)" ::: "memory");
        } else {
            XB_SPIN(xb_ld(&bar[XB_XGEN(b.x)]) == gen, bar);
            __builtin_amdgcn_fence(__ATOMIC_ACQUIRE, "agent");
            asm volatile("s_waitcnt vmcnt(0)" ::: "memory");
        }
    }
    __syncthreads();
}

DI void transpose_item(const float* W, int K, int N, bf16* WT, int dst_row0, LAS float* scr, int kb, int nb, int lane) {
    const int k0 = 64 * kb, n0 = 32 * nb;
#pragma unroll 8
    for (int i = 0; i < 32; ++i) { const int kk = 2 * i + (lane >> 5); scr[kk * 33 + (lane & 31)] = W[(size_t)(k0 + kk) * N + n0 + (lane & 31)]; }
    asm volatile("s_waitcnt lgkmcnt(0)" ::: "memory");
    const int c = lane & 7;
#pragma unroll
    for (int j = 0; j < 4; ++j) { const int n = (lane >> 3) + 8 * j; const LAS float* s = scr + (8 * c) * 33 + n;
        u32x4 o; o.x = pk2(s[0 * 33], s[1 * 33]); o.y = pk2(s[2 * 33], s[3 * 33]); o.z = pk2(s[4 * 33], s[5 * 33]); o.w = pk2(s[6 * 33], s[7 * 33]);
        *(u32x4*)(WT + (size_t)(dst_row0 + n) * K + k0 + 8 * c) = o; }
    asm volatile("s_waitcnt lgkmcnt(0)" ::: "memory");
}

DI void phase0(const Args& a, LAS unsigned char* lds, int tid, int lane, int wave) {
    unsigned char* ws = a.ws;
    const int bx = blockIdx.x;
    if (bx < 192) {
        const int layer = bx / 96, cc = bx % 96, l31 = lane & 31, hh = lane >> 5, col = 32 * cc + l31;
        const float* W = layer ? a.in[17] : a.in[3]; const float* cv = a.in[1];
        LAS float* SC = (LAS float*)lds;
        LAS float* red = (LAS float*)(lds + 16384);
        for (int i = tid; i < 4096; i += NTHR) SC[i] = silu(cv[i]);
        __syncthreads();
        float a0 = 0.f, a1 = 0.f, a2 = 0.f, a3 = 0.f;
        const float* wp = W + (size_t)(128 * wave + hh) * 3072 + col;
#pragma unroll 1
        for (int i0 = 0; i0 < 64; i0 += 16) { float wv[16];
#pragma unroll
            for (int i = 0; i < 16; ++i) wv[i] = wp[(size_t)(2 * (i0 + i)) * 3072];
#pragma unroll
            for (int i = 0; i < 16; ++i) { const int k = 128 * wave + 2 * (i0 + i) + hh; a0 += SC[k] * wv[i]; a1 += SC[1024 + k] * wv[i]; a2 += SC[2048 + k] * wv[i]; a3 += SC[3072 + k] * wv[i]; } }
        a0 += __shfl_xor(a0, 32); a1 += __shfl_xor(a1, 32); a2 += __shfl_xor(a2, 32); a3 += __shfl_xor(a3, 32);
        if (hh == 0) { red[(wave * 4 + 0) * 32 + l31] = a0; red[(wave * 4 + 1) * 32 + l31] = a1; red[(wave * 4 + 2) * 32 + l31] = a2; red[(wave * 4 + 3) * 32 + l31] = a3; }
        __syncthreads();
        if (tid < 128) { const int b = tid >> 5, l = tid & 31; float s = 0.f;
#pragma unroll
            for (int w = 0; w < 8; ++w) s += red[(w * 4 + b) * 32 + l];
            const float* bias = layer ? a.in[18] : a.in[4];
            ((float*)(ws + WS_MOD))[(layer * 4 + b) * 3072 + 32 * cc + l] = s + bias[32 * cc + l]; }
        __syncthreads();
    } else if (bx < 196) {
        const int gp = (bx - 192) * 512 + tid, g = gp >> 6;
        const float step = __expf(a.in[24][g]);
        const float lr = a.in[22][gp], li = a.in[23][gp];
        const float decay = __expf(lr * step);
        float rev = li * step * 0.15915494309189535f; rev -= floorf(rev);
        const float abr = decay * __builtin_amdgcn_cosf(rev), abi = decay * __builtin_amdgcn_sinf(rev);
        const float den = lr * lr + li * li;
        const float fr = ((abr - 1.f) * lr + abi * li) / den, fi = (abi * lr - (abr - 1.f) * li) / den;
        float* BB = (float*)(ws + WS_BB) + (size_t)gp * 32;
#pragma unroll
        for (int h = 0; h < 16; ++h) { const float br = a.in[25][gp * 16 + h], bi = a.in[26][gp * 16 + h]; BB[2 * h] = fr * br - fi * bi; BB[2 * h + 1] = fr * bi + fi * br; }
        float* PW = (float*)(ws + WS_PW) + ((size_t)g * 65 * 64 + (gp & 63)) * 2;
        float pr = 1.f, pi = 0.f;
        for (int t = 0; t < 64; ++t) { PW[(size_t)t * 128] = pr; PW[(size_t)t * 128 + 1] = pi; const float nr = pr * abr - pi * abi, ni = pr * abi + pi * abr; pr = nr; pi = ni; }
        PW[(size_t)64 * 128] = pr; PW[(size_t)64 * 128 + 1] = pi;
        float* ABL = (float*)(ws + WS_ABL) + gp * 2; ABL[0] = pr; ABL[1] = pi;
    }
    if (bx == 200 && tid == 0) { float gq = 0.f, gk = 0.f;
        for (int i = 0; i < 64; ++i) { gq = fmaxf(gq, fabsf(a.in[13][i])); gk = fmaxf(gk, fabsf(a.in[14][i])); }
        ((float*)(ws + WS_MOD))[2 * 4 * 3072] = 8.f * gq * gk; }
    if (bx >= 201 && bx < 217) {
        const int v = (bx - 201) * 512 + tid, ln = v & 63, s = (v >> 6) & 3, ct = (v >> 8) & 1, g = (v >> 9) & 7, gate = v >> 12, l31 = ln & 31, hh = ln >> 5;
        const float* wsrc = (gate ? a.in[10] : a.in[8]) + (size_t)g * 4096 + (16 * s + 8 * hh) * 64 + 32 * ct + l31;
        u32x4 o; o.x = pk2(wsrc[0], wsrc[64]); o.y = pk2(wsrc[128], wsrc[192]); o.z = pk2(wsrc[256], wsrc[320]); o.w = pk2(wsrc[384], wsrc[448]);
        *(u32x4*)(ws + WS_GW + (size_t)v * 16) = o; }
    LAS float* scr = (LAS float*)(lds + 16384 + wave * 8704);
    const int gw = bx * NWAVES + wave, NGW = gridDim.x * NWAVES;
    constexpr int I0 = 16 * 96, I1 = 16 * 32, I2 = 16 * 96, I3 = 8 * 32, I4 = 16 * 32;
    for (int it = gw; it < I0 + I1 + I2 + I3 + I4; it += NGW) {
        int r = it;
        if (r < I0) { transpose_item(a.in[5], 1024, 3072, (bf16*)(ws + WS_WIN0), 32 * (r % 96), scr, r / 96, r % 96, lane); continue; } r -= I0;
        if (r < I1) { transpose_item(a.in[15], 1024, 1024, (bf16*)(ws + WS_WOUT0), 32 * (r % 32), scr, r / 32, r % 32, lane); continue; } r -= I1;
        if (r < I2) { transpose_item(a.in[19], 1024, 3072, (bf16*)(ws + WS_WIN1), 32 * (r % 96), scr, r / 96, r % 96, lane); continue; } r -= I2;
        if (r < I3) { const int nb = r % 32, n0 = 32 * nb; const int nn = n0 & 511; const int dst = 256 * (nn >> 7) + (n0 >= 512 ? 128 : 0) + (nn & 127);
            transpose_item(a.in[30], 512, 1024, (bf16*)(ws + WS_WGLU), dst, scr, r / 32, nb, lane); continue; } r -= I3;
        transpose_item(a.in[32], 1024, 1024, (bf16*)(ws + WS_WOUT1), 32 * (r % 32), scr, r / 32, r % 32, lane);
    }
}

DI float wave_sum(float v) {
#pragma unroll
    for (int o = 1; o < 64; o <<= 1) v += __shfl_xor(v, o);
    return v;
}
DI void norm_rows(const float* xin, const float* gain, const float* modl, bf16* H, int gw, int NGW, int lane) {
    f32x4 gs[4], sh[4]; int curb = -1;
    for (int m = gw; m < M; m += NGW) {
        const f32x4* xr = (const f32x4*)(xin + (size_t)m * D) + lane;
        f32x4 v[4]; float s = 0.f;
#pragma unroll
        for (int j = 0; j < 4; ++j) v[j] = xr[64 * j];
        const int b = m >> 13;
        if (b != curb) { curb = b; const float* mb = modl + b * 3072;
#pragma unroll
            for (int j = 0; j < 4; ++j) { const int c = 4 * lane + 256 * j; gs[j] = *(const f32x4*)(gain + c) * (*(const f32x4*)(mb + 1024 + c) + 1.f); sh[j] = *(const f32x4*)(mb + c); } }
#pragma unroll
        for (int j = 0; j < 4; ++j) s += (v[j].x * v[j].x + v[j].y * v[j].y) + (v[j].z * v[j].z + v[j].w * v[j].w);
        const float rstd = rsqrtf(wave_sum(s) * (1.f / D) + 1e-6f);
        unsigned long long* o8 = (unsigned long long*)(H + (size_t)m * D) + lane;
#pragma unroll
        for (int j = 0; j < 4; ++j) { const f32x4 y = v[j] * rstd * gs[j] + sh[j];
            o8[64 * j] = (unsigned long long)pk2(y.x, y.y) | ((unsigned long long)pk2(y.z, y.w) << 32); }
    }
}

DI void s5_tables(const Args& a, LAS unsigned char* lds, int gt, int NT) {
    unsigned char* ws = a.ws;
    const float* PW = (const float*)(ws + WS_PW); const float* BB = (const float*)(ws + WS_BB);
    const float* cre = a.in[27]; const float* cim = a.in[28]; const float* dd = a.in[29];
    const bool staged = (NT == 32 * 64 * 16 * 4);
    LAS float* LB = (LAS float*)lds; LAS float* LP = LB + 2048; LAS float* LC = LP + 1024; LAS float* LI = LC + 1024;
    if (staged) { const int g = blockIdx.x >> 3, tau0 = (8 * blockIdx.x) & 63; const int t = threadIdx.x;
#pragma unroll
        for (int i = 0; i < 4; ++i) LB[t + 512 * i] = BB[(size_t)g * 2048 + t + 512 * i];
#pragma unroll
        for (int i = 0; i < 2; ++i) { LP[t + 512 * i] = PW[((size_t)(g * 65 + tau0) * 64) * 2 + t + 512 * i]; LC[t + 512 * i] = cre[g * 1024 + t + 512 * i]; LI[t + 512 * i] = cim[g * 1024 + t + 512 * i]; }
        __syncthreads(); }
    for (int v4 = gt; v4 < 32 * 64 * 16 * 4; v4 += NT) {
        const int v = v4 >> 2, pq = v4 & 3, g = v >> 10, tau = (v >> 4) & 63, h = v & 15;
        float acc[16];
#pragma unroll
        for (int e = 0; e < 16; ++e) acc[e] = 0.f;
        if (staged) {
#pragma unroll 4
            for (int pi = 0; pi < 16; ++pi) { const int p = 16 * pq + pi;
                const float cr = LC[h * 64 + p], ci = LI[h * 64 + p];
                const f32x2 pw = *(const LAS f32x2*)(LP + ((tau & 7) * 64 + p) * 2);
                const float wr = cr * pw.x - ci * pw.y, wi = cr * pw.y + ci * pw.x;
                const LAS f32x4* bb = (const LAS f32x4*)(LB + p * 32);
#pragma unroll
                for (int e2 = 0; e2 < 8; ++e2) { const f32x4 b4 = bb[e2]; acc[2 * e2] += wr * b4.x - wi * b4.y; acc[2 * e2 + 1] += wr * b4.z - wi * b4.w; }
            }
        } else {
#pragma unroll 4
        for (int pi = 0; pi < 16; ++pi) { const int p = 16 * pq + pi;
            const float cr = cre[(g * 16 + h) * 64 + p], ci = cim[(g * 16 + h) * 64 + p];
            const f32x2 pw = *(const f32x2*)(PW + ((size_t)(g * 65 + tau) * 64 + p) * 2);
            const float wr = cr * pw.x - ci * pw.y, wi = cr * pw.y + ci * pw.x;
            const f32x4* bb = (const f32x4*)(BB + (size_t)(g * 64 + p) * 32);
#pragma unroll
            for (int e2 = 0; e2 < 8; ++e2) { const f32x4 b4 = bb[e2]; acc[2 * e2] += wr * b4.x - wi * b4.y; acc[2 * e2 + 1] += wr * b4.z - wi * b4.w; }
        }
        }
#pragma unroll
        for (int e = 0; e < 16; ++e) { acc[e] += __shfl_xor(acc[e], 1); acc[e] += __shfl_xor(acc[e], 2); }
        if (pq != 0) continue;
        if (tau == 0) { const float dv = dd[g * 16 + h];
#pragma unroll
            for (int e = 0; e < 16; ++e) if (e == h) acc[e] += dv; }
        u32x4 lo, hi; lo.x = pk2(acc[0], acc[1]); lo.y = pk2(acc[2], acc[3]); lo.z = pk2(acc[4], acc[5]); lo.w = pk2(acc[6], acc[7]);
        hi.x = pk2(acc[8], acc[9]); hi.y = pk2(acc[10], acc[11]); hi.z = pk2(acc[12], acc[13]); hi.w = pk2(acc[14], acc[15]);
        unsigned char* fb = ws + WS_F + (size_t)g * 65536;
        if (tau + 1 < 64) { *(u32x4*)(fb + (size_t)((tau + 1) * 64 + h) * 16) = lo; *(u32x4*)(fb + (size_t)((tau + 1) * 64 + 32 + h) * 16) = hi; }
        *(u32x4*)(fb + (size_t)(tau * 64 + 16 + h) * 16) = lo; *(u32x4*)(fb + (size_t)(tau * 64 + 48 + h) * 16) = hi;
        if (tau == 0) { u32x4 z; z.x = 0u; z.y = 0u; z.z = 0u; z.w = 0u; *(u32x4*)(fb + (size_t)h * 16) = z; *(u32x4*)(fb + (size_t)(32 + h) * 16) = z; }
    }
    for (int vb_ = gt; vb_ < 32 * 4 * 64 * 64; vb_ += 4 * NT)
#pragma unroll
    for (int u_ = 0; u_ < 4; ++u_) { const int v = vb_ + u_ * NT; if (v >= 32 * 4 * 64 * 64) continue;
        const int g = v >> 14, rt = (v >> 12) & 3, s = (v >> 6) & 63, lane = v & 63, q = 32 * rt + (lane & 31), part = q >> 6, p = q & 63, hh = lane >> 5;
        const f32x2 pw = *(const f32x2*)(PW + ((size_t)(g * 65 + (63 - s)) * 64 + p) * 2);
        const float* bb = BB + ((size_t)(g * 64 + p) * 16 + 8 * hh) * 2;
        float o[8];
#pragma unroll
        for (int e = 0; e < 8; ++e) o[e] = part ? (pw.x * bb[2 * e + 1] + pw.y * bb[2 * e]) : (pw.x * bb[2 * e] - pw.y * bb[2 * e + 1]);
        u32x4 w; w.x = pk2(o[0], o[1]); w.y = pk2(o[2], o[3]); w.z = pk2(o[4], o[5]); w.w = pk2(o[6], o[7]);
        *(u32x4*)(ws + WS_VBIG + (size_t)v * 16) = w;
    }
    for (int vb_ = gt; vb_ < 32 * 32 * 8 * 64; vb_ += 4 * NT)
#pragma unroll
    for (int u_ = 0; u_ < 4; ++u_) { const int v = vb_ + u_ * NT; if (v >= 32 * 32 * 8 * 64) continue;
        const int g = v >> 14, R = (v >> 9) & 31, ks = (v >> 6) & 7, lane = v & 63, r = lane & 31, jj = r >> 4, h = r & 15, hh = lane >> 5, tok = 2 * R + jj, part = ks >> 2;
        float o[8];
#pragma unroll
        for (int e = 0; e < 8; ++e) { const int p = 16 * (ks & 3) + 8 * hh + e;
            const float cr = cre[(g * 16 + h) * 64 + p], ci = cim[(g * 16 + h) * 64 + p];
            const f32x2 pw = *(const f32x2*)(PW + ((size_t)(g * 65 + tok + 1) * 64 + p) * 2);
            o[e] = part ? -(cr * pw.y + ci * pw.x) : (cr * pw.x - ci * pw.y); }
        u32x4 w; w.x = pk2(o[0], o[1]); w.y = pk2(o[2], o[3]); w.z = pk2(o[4], o[5]); w.w = pk2(o[6], o[7]);
        *(u32x4*)(ws + WS_WBIG + (size_t)v * 16) = w;
    }
}
template <int PASS>
DI void lru_item(const Args& a, LAS unsigned char* lds, int item, int tid, int lane, int wave) {
    unsigned char* ws = a.ws;
    const bf16* PROJ = (const bf16*)(ws + WS_PROJ); bf16* MIX = (bf16*)(ws + WS_MIX); float* SUM = (float*)(ws + WS_LRUSUM);
    const int b = item >> 7, ch = item & 127; const size_t m0 = (size_t)b * T + 64 * ch;
    constexpr int XP = 520;
    LAS bf16* XC = (LAS bf16*)lds; LAS bf16* HB = (LAS bf16*)(lds + 66560);
    {
        LAS bf16* XR = HB;
        u32x4 xv[9];
#pragma unroll
        for (int i = 0; i < 9; ++i) { const int idx = tid + 512 * i, r = idx >> 6, c8 = idx & 63;
            xv[i].x = 0u; xv[i].y = 0u; xv[i].z = 0u; xv[i].w = 0u;
            if (idx < 67 * 64 && (ch > 0 || r >= 3)) xv[i] = *(const u32x4*)(PROJ + (m0 + r - 3) * NP + 8 * c8); }
#pragma unroll
        for (int i = 0; i < 9; ++i) { const int idx = tid + 512 * i, r = idx >> 6, c8 = idx & 63;
            if (idx < 67 * 64) *(LAS u32x4*)(XR + r * XP + 8 * c8) = xv[i]; }
        __syncthreads();
        const int c = tid; const float* cw = a.in[6];
        const float w0 = cw[c], w1 = cw[512 + c], w2 = cw[1024 + c], w3 = cw[1536 + c], cb = a.in[7][c];
        float xm3 = bf2f(XR[c]), xm2 = bf2f(XR[XP + c]), xm1 = bf2f(XR[2 * XP + c]);
#pragma unroll 4
        for (int j = 0; j < 64; ++j) { const float x0 = bf2f(XR[(j + 3) * XP + c]); const float xc = w0 * xm3 + w1 * xm2 + w2 * xm1 + w3 * x0 + cb; XC[j * XP + c] = (bf16)f2bf(xc); xm3 = xm2; xm2 = xm1; xm1 = x0; }
    }
    LAS float* CAR = (LAS float*)(lds + 136448);
    if (PASS == 2) { float h = 0.f; const float* sp2 = SUM + ((size_t)(b * 128) * 512 + tid) * 2;
#pragma unroll 16
        for (int cc = 0; cc < ch; ++cc) { const f32x2 s2 = *(const f32x2*)(sp2 + (size_t)cc * 1024); h = s2.x * h + s2.y; }
        CAR[tid] = h; }
    __syncthreads();
    const int g = wave, hh = lane >> 5, l31 = lane & 31;
    const bf16* GW = (const bf16*)(ws + WS_GW);
#pragma unroll 1
    for (int ct = 0; ct < 2; ++ct) {
        const int j = 32 * ct + l31, c = 64 * g + j;
        bf16x8 Br[4], Bi[4];
#pragma unroll
        for (int s = 0; s < 4; ++s) { Br[s] = mk8(*(const u32x4*)(GW + ((size_t)(((0 * 8 + g) * 2 + ct) * 4 + s) * 64 + lane) * 8)); Bi[s] = mk8(*(const u32x4*)(GW + ((size_t)(((1 * 8 + g) * 2 + ct) * 4 + s) * 64 + lane) * 8)); }
        f32x16 Rr[2], Ii[2];
#pragma unroll
        for (int rt = 0; rt < 2; ++rt) { Rr[rt] = zero16(); Ii[rt] = zero16();
#pragma unroll
            for (int s = 0; s < 4; ++s) { const bf16x8 A = *(const LAS bf16x8*)(XC + (32 * rt + l31) * XP + 64 * g + 16 * s + 8 * hh); Rr[rt] = MFMA32(A, Br[s], Rr[rt]); Ii[rt] = MFMA32(A, Bi[s], Ii[rt]); } }
        const float rb = a.in[9][c], ib = a.in[11][c];
        const float sp = log1pf(__expf(-a.in[12][c]));
#pragma unroll
        for (int rt = 0; rt < 2; ++rt)
#pragma unroll
            for (int i = 0; i < 16; ++i) { const int tok = 32 * rt + crow(i, hh);
                const float r = sigm(Rr[rt][i] + rb), ig = sigm(Ii[rt][i] + ib);
                const float la = -8.f * r * sp; const float av = __expf(la); const float x2 = 2.f * la;
                const float ser = -x2 * (1.f + 0.5f * x2 * (1.f + (1.f / 3.f) * x2 * (1.f + 0.25f * x2 * (1.f + 0.2f * x2 * (1.f + (1.f / 6.f) * x2)))));
                const float om = (x2 > -0.25f) ? ser : (1.f - av * av); const float mult = __builtin_amdgcn_sqrtf(om);
                const float xv = bf2f(XC[tok * XP + c]);
                Rr[rt][i] = av; Ii[rt][i] = mult * ig * xv; if ((i & 3) == 3) __builtin_amdgcn_sched_barrier(0); }
        float Ag[8], Bg[8], Ao[8], Bo[8];
#pragma unroll
        for (int rt = 0; rt < 2; ++rt)
#pragma unroll
            for (int k = 0; k < 4; ++k) { float A = 1.f, Bv = 0.f;
#pragma unroll
                for (int e = 0; e < 4; ++e) { const float av = Rr[rt][4 * k + e]; Bv = av * Bv + Ii[rt][4 * k + e]; A *= av; }
                Ag[rt * 4 + k] = A; Bg[rt * 4 + k] = Bv; }
#pragma unroll
        for (int q = 0; q < 8; ++q) { Ao[q] = __shfl_xor(Ag[q], 32); Bo[q] = __shfl_xor(Bg[q], 32); }
        float h = (PASS == 2) ? CAR[c] : 0.f;
        float hs[8]; float Atot = 1.f;
#pragma unroll
        for (int q = 0; q < 8; ++q) {
            const float A1 = hh ? Ao[q] : Ag[q], B1 = hh ? Bo[q] : Bg[q], A2 = hh ? Ag[q] : Ao[q], B2 = hh ? Bg[q] : Bo[q];
            const float h1 = A1 * h + B1; hs[q] = hh ? h1 : h; h = A2 * h1 + B2; Atot *= A1 * A2; }
        if (PASS == 1) { if (hh == 0) { f32x2 o; o.x = Atot; o.y = h; *(f32x2*)(SUM + ((size_t)(b * 128 + ch) * 512 + c) * 2) = o; } }
        else {
#pragma unroll
            for (int rt = 0; rt < 2; ++rt)
#pragma unroll
                for (int k = 0; k < 4; ++k) { float hc = hs[rt * 4 + k];
#pragma unroll
                    for (int e = 0; e < 4; ++e) { const int i = 4 * k + e; hc = Rr[rt][i] * hc + Ii[rt][i]; HB[(32 * rt + 8 * k + 4 * hh + e) * XP + c] = (bf16)f2bf(hc); } }
        }
    }
    __syncthreads();
    if (PASS == 2) {
#pragma unroll
        for (int i = 0; i < 8; ++i) { const int idx = tid + 512 * i, tok = idx >> 6, c8 = idx & 63;
            const u32x4 hv = *(const LAS u32x4*)(HB + tok * XP + 8 * c8); const u32x4 gv = *(const u32x4*)(PROJ + (m0 + tok) * NP + 512 + 8 * c8);
            u32x4 o;
#pragma unroll
            for (int e = 0; e < 4; ++e) o[e] = pk2(bflo(hv[e]) * silu(bflo(gv[e])), bfhi(hv[e]) * silu(bfhi(gv[e])));
            *(u32x4*)(MIX + (m0 + tok) * 1024 + 8 * c8) = o; }
        __syncthreads();
    }
}

template <int LAYER>
DI void prep_item(const Args& a, LAS unsigned char* lds, int item, int tid) {
    unsigned char* ws = a.ws;
    bf16* PROJ = (bf16*)(ws + WS_PROJ); bf16* VF = (bf16*)(ws + WS_VT); bf16* KF = (bf16*)(ws + WS_KF);
    constexpr int qoff = LAYER ? 0 : 1024, koff = LAYER ? 512 : 1536, voff = LAYER ? 1024 : 2048;
    const float* qg = LAYER ? a.in[20] : a.in[13]; const float* kg = LAYER ? a.in[21] : a.in[14];
    const int h = item & 7, n = (item >> 3) & 31, b = item >> 8;
    LAS bf16* VL = (LAS bf16*)lds; LAS float* RED = (LAS float*)(lds + 40960);
    const int c8 = tid & 7, r0 = tid >> 3;
    float qgv[8], kgv[8], ksum[8];
#pragma unroll
    for (int e = 0; e < 8; ++e) { qgv[e] = qg[8 * c8 + e]; kgv[e] = kg[8 * c8 + e]; ksum[e] = 0.f; }
    u32x4 lq[4], lk[4], lv[4];
#pragma unroll
    for (int i = 0; i < 4; ++i) { const bf16* base = PROJ + ((size_t)b * T + 256 * n + r0 + 64 * i) * NP + 64 * h + 8 * c8; lq[i] = *(const u32x4*)(base + qoff); lk[i] = *(const u32x4*)(base + koff); lv[i] = *(const u32x4*)(base + voff); }
#pragma unroll
    for (int i = 0; i < 4; ++i) {
        const int row = r0 + 64 * i; bf16* base = PROJ + ((size_t)b * T + 256 * n + row) * NP + 64 * h + 8 * c8;
        {   u32x4 v = lq[i]; float f[8];
#pragma unroll
            for (int e = 0; e < 4; ++e) { f[2 * e] = bflo(v[e]); f[2 * e + 1] = bfhi(v[e]); }
            float ss = 0.f;
#pragma unroll
            for (int e = 0; e < 8; ++e) ss += f[e] * f[e];
            ss += __shfl_xor(ss, 1); ss += __shfl_xor(ss, 2); ss += __shfl_xor(ss, 4);
            const float rstd = rsqrtf(ss * (1.f / 64.f) + 1e-6f);
#pragma unroll
            for (int e = 0; e < 8; ++e) f[e] = f[e] * rstd * qgv[e];
            u32x4 o; o.x = pk2(f[0], f[1]); o.y = pk2(f[2], f[3]); o.z = pk2(f[4], f[5]); o.w = pk2(f[6], f[7]); *(u32x4*)(base + qoff) = o; }
        {   u32x4 v = lk[i]; float f[8];
#pragma unroll
            for (int e = 0; e < 4; ++e) { f[2 * e] = bflo(v[e]); f[2 * e + 1] = bfhi(v[e]); }
            float ss = 0.f;
#pragma unroll
            for (int e = 0; e < 8; ++e) ss += f[e] * f[e];
            ss += __shfl_xor(ss, 1); ss += __shfl_xor(ss, 2); ss += __shfl_xor(ss, 4);
            const float rstd = rsqrtf(ss * (1.f / 64.f) + 1e-6f);
#pragma unroll
            for (int e = 0; e < 8; ++e) { f[e] = f[e] * rstd * kgv[e]; ksum[e] += f[e]; }
            u32x4 o; o.x = pk2(f[0], f[1]); o.y = pk2(f[2], f[3]); o.z = pk2(f[4], f[5]); o.w = pk2(f[6], f[7]);
            *(u32x4*)(KF + ((((size_t)(b * 8 + h) * 256 + 8 * n + (row >> 5)) * 4 + (c8 >> 1)) * 64 + (c8 & 1) * 32 + (row & 31)) * 8) = o; }
        *(LAS u32x4*)(VL + row * 72 + 8 * c8) = lv[i];
    }
    if (LAYER == 0) {
#pragma unroll
        for (int e = 0; e < 8; ++e) RED[r0 * 64 + 8 * c8 + e] = ksum[e]; }
    __syncthreads();
    if (LAYER == 0 && tid < 64) { float s = 0.f;
        for (int r = 0; r < 64; ++r) s += RED[r * 64 + tid];
        ((float*)(ws + WS_KMEAN))[((size_t)(b * 8 + h) * 32 + n) * 64 + tid] = s * (1.f / 256.f); }
#pragma unroll
    for (int i = 0; i < 4; ++i) { const int idx = tid + 512 * i, ln = idx & 63, s = (idx >> 6) & 1, dt = (idx >> 7) & 1, kt = idx >> 8, l31 = ln & 31, hh = ln >> 5;
        const LAS bf16* vp = VL + (32 * kt + 16 * s + 4 * hh) * 72 + 32 * dt + l31;
        const unsigned short e0 = vp[0], e1 = vp[72], e2 = vp[144], e3 = vp[216], e4 = vp[8 * 72], e5 = vp[9 * 72], e6 = vp[10 * 72], e7 = vp[11 * 72];
        u32x4 o; o.x = e0 | ((unsigned)e1 << 16); o.y = e2 | ((unsigned)e3 << 16); o.z = e4 | ((unsigned)e5 << 16); o.w = e6 | ((unsigned)e7 << 16);
        *(u32x4*)(VF + (((((size_t)(b * 8 + h) * 256 + 8 * n + kt) * 2 + dt) * 2 + s) * 64 + ln) * 8) = o; }
    __syncthreads();
}

DI void moba_item(const Args& a, LAS unsigned char* lds, int item, int tid, int lane, int wave) {
    unsigned char* ws = a.ws;
    const bf16* PROJ = (const bf16*)(ws + WS_PROJ); const bf16* VT = (const bf16*)(ws + WS_VT); bf16* MIX = (bf16*)(ws + WS_MIX);
    const int bh = item & 31, m = item >> 5, b = bh >> 3, h = bh & 7;
    constexpr int QP = 72, SP = 68;
    LAS bf16* QS = (LAS bf16*)lds;
    LAS bf16* SLAB = (LAS bf16*)(lds + 36864);
    LAS float* KM = (LAS float*)(lds + 36864);
    LAS float* SL = (LAS float*)(lds + 141312);
    LAS unsigned short* LISTQ = (LAS unsigned short*)(lds + 144384);
    LAS unsigned short* SELROW = (LAS unsigned short*)(lds + 145920);
    LAS int* CNT = (LAS int*)(lds + 147968);
    LAS int* OFF = (LAS int*)(lds + 148096);
    LAS unsigned short* TILES = (LAS unsigned short*)(lds + 148224);
    LAS int* NTL = (LAS int*)(lds + 148352);
    const size_t mq0 = (size_t)b * T + 256 * m;
    {   const int row = tid >> 1, half = tid & 1; const bf16* src = PROJ + (mq0 + row) * NP + 1024 + 64 * h + 32 * half;
#pragma unroll
        for (int i = 0; i < 4; ++i) { const u32x4 v = *(const u32x4*)(src + 8 * i); u32x4 o;
#pragma unroll
            for (int e = 0; e < 4; ++e) o[e] = pk2(bflo(v[e]) * (0.125f * 1.4426950408889634f), bfhi(v[e]) * (0.125f * 1.4426950408889634f));
            *(LAS u32x4*)(QS + row * QP + 32 * half + 8 * i) = o; } }
    {   const float* km = (const float*)(ws + WS_KMEAN) + (size_t)(b * 8 + h) * 2048;
        for (int i = tid; i < m * 64; i += NTHR) KM[i] = km[i]; }
    if (tid < 32) CNT[tid] = 0;
    __syncthreads();
    int i0 = 255, i1 = 255, i2 = 255, ps0 = 0, ps1 = 0, ps2 = 0;
    if (tid < 256 && m > 0) {
        float q[64];
#pragma unroll
        for (int i = 0; i < 8; ++i) { const u32x4 v = *(const LAS u32x4*)(QS + tid * QP + 8 * i);
#pragma unroll
            for (int e = 0; e < 4; ++e) { q[8 * i + 2 * e] = bflo(v[e]); q[8 * i + 2 * e + 1] = bfhi(v[e]); } }
        float v0 = -INFINITY, v1 = -INFINITY, v2 = -INFINITY;
        for (int n = 0; n < m; ++n) { float dot = 0.f;
#pragma unroll
            for (int d4 = 0; d4 < 16; ++d4) { const f32x4 kv = *(const LAS f32x4*)(KM + n * 64 + 4 * d4); dot += q[4 * d4] * kv.x + q[4 * d4 + 1] * kv.y + q[4 * d4 + 2] * kv.z + q[4 * d4 + 3] * kv.w; }
            if (dot > v0) { v2 = v1; i2 = i1; v1 = v0; i1 = i0; v0 = dot; i0 = n; }
            else if (dot > v1) { v2 = v1; i2 = i1; v1 = dot; i1 = n; }
            else if (dot > v2) { v2 = dot; i2 = n; } }
        if (i0 != 255) ps0 = __hip_atomic_fetch_add(CNT + i0, 1, __ATOMIC_RELAXED, __HIP_MEMORY_SCOPE_WORKGROUP);
        if (i1 != 255) ps1 = __hip_atomic_fetch_add(CNT + i1, 1, __ATOMIC_RELAXED, __HIP_MEMORY_SCOPE_WORKGROUP);
        if (i2 != 255) ps2 = __hip_atomic_fetch_add(CNT + i2, 1, __ATOMIC_RELAXED, __HIP_MEMORY_SCOPE_WORKGROUP);
    }
    __syncthreads();
    if (tid < 64) {
        const int c = (lane < m) ? CNT[lane] : 0, ntile = (c + 31) >> 5;
        int pc = c, ptile = ntile;
#pragma unroll
        for (int o = 1; o < 32; o <<= 1) { const int uc = __shfl_up(pc, o), ut = __shfl_up(ptile, o); if ((lane & 31) >= o) { pc += uc; ptile += ut; } }
        if (lane < 32) { OFF[lane] = pc - c; for (int qt = 0; qt < ntile; ++qt) TILES[ptile - ntile + qt] = (unsigned short)(lane | (qt << 8)); if (lane == 31) NTL[0] = ptile; }
    }
    __syncthreads();
    if (tid < 256) {
        unsigned short r0 = 0xffff, r1 = 0xffff, r2 = 0xffff;
        if (i0 != 255) { r0 = (unsigned short)(OFF[i0] + ps0); LISTQ[r0] = (unsigned short)tid; }
        if (i1 != 255) { r1 = (unsigned short)(OFF[i1] + ps1); LISTQ[r1] = (unsigned short)tid; }
        if (i2 != 255) { r2 = (unsigned short)(OFF[i2] + ps2); LISTQ[r2] = (unsigned short)tid; }
        SELROW[tid * 4] = r0; SELROW[tid * 4 + 1] = r1; SELROW[tid * 4 + 2] = r2;
    }
    __syncthreads();
    const float cb2 = ((const float*)(ws + WS_MOD))[2 * 4 * 3072] * 1.4426950408889634f;
    f32x16 sinit;
#pragma unroll
    for (int i = 0; i < 16; ++i) sinit[i] = -cb2;
    const int hh = lane >> 5, l31 = lane & 31, w = wave;
    const bf16* Kb = (const bf16*)(ws + WS_KF) + ((size_t)(b * 8 + h) * 256 * 4 * 64 + lane) * 8;
    const bf16* Vb = VT + ((size_t)(b * 8 + h) * 256 * 4 * 64 + lane) * 8;
    const int nt = NTL[0];
#define MOBA_LOADKV(AK, AV, key0) do { const size_t kt_ = (size_t)((key0) >> 5) * 2048; \
    _Pragma("unroll") for (int s = 0; s < 4; ++s) AK[s] = mk8(*(const u32x4*)(Kb + kt_ + s * 512)); \
    _Pragma("unroll") for (int dt = 0; dt < 2; ++dt) _Pragma("unroll") for (int s = 0; s < 2; ++s) AV[dt][s] = mk8(*(const u32x4*)(Vb + kt_ + (dt * 2 + s) * 512)); } while (0)
    for (int t = w; t < nt; t += 8) {
        const int tl = TILES[t], n = tl & 255, qt = tl >> 8, cnt = CNT[n], rowb = OFF[n] + 32 * qt;
        const bool valid = (32 * qt + l31) < cnt; const int qrow = valid ? (int)LISTQ[rowb + l31] : 0;
        bf16x8 bq[4];
#pragma unroll
        for (int s = 0; s < 4; ++s) bq[s] = *(const LAS bf16x8*)(QS + qrow * QP + 16 * s + 8 * hh);
        f32x16 o0 = zero16(), o1 = zero16(); f32x2 ls2; ls2.x = 0.f; ls2.y = 0.f;
        bf16x8 ak[4], av[2][2], akn[4], avn[2][2];
        MOBA_LOADKV(ak, av, 256 * n);
#define MOBA_STEP(AK, AV, AKN, AVN, knext) do { \
            MOBA_LOADKV(AKN, AVN, knext); \
            f32x16 sacc = sinit; \
            _Pragma("unroll") for (int s = 0; s < 4; ++s) sacc = MFMA32(AK[s], bq[s], sacc); \
            _Pragma("unroll") for (int i = 0; i < 16; i += 2) { f32x2 p2; p2.x = __builtin_amdgcn_exp2f(sacc[i]); p2.y = __builtin_amdgcn_exp2f(sacc[i + 1]); sacc[i] = p2.x; sacc[i + 1] = p2.y; ls2 += p2; } \
            const bf16x8 p0 = pack8(sacc[0], sacc[1], sacc[2], sacc[3], sacc[4], sacc[5], sacc[6], sacc[7]); \
            const bf16x8 p1 = pack8(sacc[8], sacc[9], sacc[10], sacc[11], sacc[12], sacc[13], sacc[14], sacc[15]); \
            o0 = MFMA32(AV[0][0], p0, o0); o0 = MFMA32(AV[0][1], p1, o0); o1 = MFMA32(AV[1][0], p0, o1); o1 = MFMA32(AV[1][1], p1, o1); } while (0)
#pragma unroll 1
        for (int ks = 0; ks < 8; ks += 2) {
            MOBA_STEP(ak, av, akn, avn, 256 * n + 32 * (ks + 1));
            MOBA_STEP(akn, avn, ak, av, 256 * n + 32 * (ks < 6 ? ks + 2 : ks + 1));
        }
        float lsum = ls2.x + ls2.y;
        lsum += __shfl_xor(lsum, 32);
        if (valid) {
            LAS bf16* sr = SLAB + (rowb + l31) * SP + 4 * hh;
#pragma unroll
            for (int k = 0; k < 4; ++k) { u32x2 wv; wv.x = pk2(o0[4 * k], o0[4 * k + 1]); wv.y = pk2(o0[4 * k + 2], o0[4 * k + 3]); *(LAS u32x2*)(sr + 8 * k) = wv;
                u32x2 wu; wu.x = pk2(o1[4 * k], o1[4 * k + 1]); wu.y = pk2(o1[4 * k + 2], o1[4 * k + 3]); *(LAS u32x2*)(sr + 32 + 8 * k) = wu; }
            if (hh == 0) SL[rowb + l31] = lsum;
        }
    }
    f32x16 o0 = zero16(), o1 = zero16(); float lsum = 0.f;
    {
        const int qrow = 32 * w + l31;
        bf16x8 bq[4];
#pragma unroll
        for (int s = 0; s < 4; ++s) bq[s] = *(const LAS bf16x8*)(QS + qrow * QP + 16 * s + 8 * hh);
        bf16x8 ak[4], av[2][2], akn[4], avn[2][2];
        MOBA_LOADKV(ak, av, 256 * m);
#pragma unroll 1
        for (int ks = 0; ks <= w; ++ks) {
            const int kn = 256 * m + 32 * (ks < w ? ks + 1 : ks);
            MOBA_LOADKV(akn, avn, kn);
            f32x16 sacc = sinit;
#pragma unroll
            for (int s = 0; s < 4; ++s) sacc = MFMA32(ak[s], bq[s], sacc);
#pragma unroll
            for (int i = 0; i < 16; ++i) { float p = __builtin_amdgcn_exp2f(sacc[i]); if (ks == w && crow(i, hh) > l31) p = 0.f; sacc[i] = p; lsum += p; }
            const bf16x8 p0 = pack8(sacc[0], sacc[1], sacc[2], sacc[3], sacc[4], sacc[5], sacc[6], sacc[7]);
            const bf16x8 p1 = pack8(sacc[8], sacc[9], sacc[10], sacc[11], sacc[12], sacc[13], sacc[14], sacc[15]);
            o0 = MFMA32(av[0][0], p0, o0); o0 = MFMA32(av[0][1], p1, o0); o1 = MFMA32(av[1][0], p0, o1); o1 = MFMA32(av[1][1], p1, o1);
#pragma unroll
            for (int s = 0; s < 4; ++s) ak[s] = akn[s];
#pragma unroll
            for (int dt = 0; dt < 2; ++dt) { av[dt][0] = avn[dt][0]; av[dt][1] = avn[dt][1]; }
        }
        lsum += __shfl_xor(lsum, 32);
    }
    __syncthreads();
    {
        const int qrow = 32 * w + l31;
#pragma unroll
        for (int j = 0; j < 3; ++j) { const int r = SELROW[qrow * 4 + j];
            if (r != 0xffff) { lsum += SL[r]; const LAS bf16* sr = SLAB + r * SP + 4 * hh;
#pragma unroll
                for (int k = 0; k < 4; ++k) { const u32x2 u0 = *(const LAS u32x2*)(sr + 8 * k), u1 = *(const LAS u32x2*)(sr + 32 + 8 * k);
                    o0[4 * k] += bflo(u0.x); o0[4 * k + 1] += bfhi(u0.x); o0[4 * k + 2] += bflo(u0.y); o0[4 * k + 3] += bfhi(u0.y);
                    o1[4 * k] += bflo(u1.x); o1[4 * k + 1] += bfhi(u1.x); o1[4 * k + 2] += bflo(u1.y); o1[4 * k + 3] += bfhi(u1.y); } } }
        const float inv = 1.f / lsum;
        LAS bf16* sl = QS + (32 * w) * QP;
#pragma unroll
        for (int dt = 0; dt < 2; ++dt)
#pragma unroll
            for (int k = 0; k < 4; ++k) { const f32x16& o = dt ? o1 : o0; u32x2 wv; wv.x = pk2(o[4 * k] * inv, o[4 * k + 1] * inv); wv.y = pk2(o[4 * k + 2] * inv, o[4 * k + 3] * inv);
                *(LAS u32x2*)(sl + l31 * QP + 32 * dt + 8 * k + 4 * hh) = wv; }
#pragma unroll
        for (int i = 0; i < 4; ++i) { const int c = lane + 64 * i, row = c >> 3, part = c & 7;
            const u32x4 ov = *(const LAS u32x4*)(sl + row * QP + 8 * part); const u32x4 gv = *(const u32x4*)(PROJ + (mq0 + 32 * w + row) * NP + 2560 + 64 * h + 8 * part);
            u32x4 wv;
#pragma unroll
            for (int e = 0; e < 4; ++e) wv[e] = pk2(bflo(ov[e]) * silu(bflo(gv[e])), bfhi(ov[e]) * silu(bfhi(gv[e])));
            *(u32x4*)(MIX + (mq0 + 32 * w + row) * 1024 + 512 + 64 * h + 8 * part) = wv; }
    }
    __syncthreads();
#undef MOBA_LOADKV
#undef MOBA_STEP
}

DI void sb_item(const Args& a, LAS unsigned char* slab, int item, int lane) {
    unsigned char* ws = a.ws;
    const bf16* PROJ = (const bf16*)(ws + WS_PROJ); const bf16* VT = (const bf16*)(ws + WS_VT); const bf16* KF = (const bf16*)(ws + WS_KF); bf16* MIX = (bf16*)(ws + WS_MIX);
    const int qt = 255 - (item >> 5), bh = item & 31, b = bh >> 3, h = bh & 7;
    const int hh = lane >> 5, l31 = lane & 31;
    const size_t mq = (size_t)b * T + 32 * qt + l31;
    bf16x8 bq[4];
#pragma unroll
    for (int s = 0; s < 4; ++s) bq[s] = mk8(*(const u32x4*)(PROJ + mq * NP + 64 * h + 16 * s + 8 * hh));
    f32x16 o0 = zero16(), o1 = zero16();
    float carry = 0.f;
    const size_t kfb = (size_t)(b * 8 + h) * 256 * 2048 + lane * 8;
#define SB_LOADKV(AK, AV, kt_) do { const size_t kb_ = kfb + (size_t)(kt_) * 2048; \
    _Pragma("unroll") for (int s = 0; s < 4; ++s) AK[s] = mk8(*(const u32x4*)(KF + kb_ + s * 512)); \
    _Pragma("unroll") for (int dt = 0; dt < 2; ++dt) _Pragma("unroll") for (int s = 0; s < 2; ++s) AV[dt][s] = mk8(*(const u32x4*)(VT + kb_ + (dt * 2 + s) * 512)); } while (0)
    bf16x8 ak[4], av[2][2], akn[4], avn[2][2];
    SB_LOADKV(ak, av, qt);
#pragma unroll 1
    for (int kt = qt; kt >= 0; --kt) {
        SB_LOADKV(akn, avn, (kt > 0 ? kt - 1 : 0));
        f32x16 z = zero16();
#pragma unroll
        for (int s = 0; s < 4; ++s) z = MFMA32(ak[s], bq[s], z);
        float kp[16], bt[16];
        if (kt == qt) {
#pragma unroll
            for (int i = 0; i < 16; ++i) { const float zz = __builtin_amdgcn_fmed3f(z[i] * 0.125f, -80.f, 80.f); const bool strict = crow(i, hh) < l31;
                const float t = __expf(-zz), r = __builtin_amdgcn_rcpf(1.f + t);
                kp[i] = strict ? t * r : 1.f; bt[i] = strict ? r : 0.f; }
        } else {
#pragma unroll
            for (int i = 0; i < 16; ++i) { const float zz = __builtin_amdgcn_fmed3f(z[i] * 0.125f, -80.f, 80.f);
                const float t = __expf(-zz), r = __builtin_amdgcn_rcpf(1.f + t);
                kp[i] = t * r; bt[i] = r; }
        }
        float gs[4], go[4];
#pragma unroll
        for (int k = 0; k < 4; ++k) { gs[k] = (kp[4 * k] * kp[4 * k + 1]) * (kp[4 * k + 2] * kp[4 * k + 3]); go[k] = __shfl_xor(gs[k], 32); }
        float after[4]; float run = 1.f;
#pragma unroll
        for (int k = 3; k >= 0; --k) { after[k] = hh ? run : run * go[k]; run *= gs[k] * go[k]; }
        const float base = __expf(carry);
        float wv[16];
#pragma unroll
        for (int k = 0; k < 4; ++k) { float suf = base * after[k];
#pragma unroll
            for (int e = 3; e >= 0; --e) { wv[4 * k + e] = bt[4 * k + e] * suf; suf *= kp[4 * k + e]; } }
        carry += __logf(run);
        const bf16x8 p0 = pack8(wv[0], wv[1], wv[2], wv[3], wv[4], wv[5], wv[6], wv[7]);
        const bf16x8 p1 = pack8(wv[8], wv[9], wv[10], wv[11], wv[12], wv[13], wv[14], wv[15]);
        o0 = MFMA32(av[0][0], p0, o0); o0 = MFMA32(av[0][1], p1, o0);
        o1 = MFMA32(av[1][0], p0, o1); o1 = MFMA32(av[1][1], p1, o1);
        if (__all(carry < -104.f)) break;
#pragma unroll
        for (int s = 0; s < 4; ++s) ak[s] = akn[s];
#pragma unroll
        for (int dt = 0; dt < 2; ++dt) { av[dt][0] = avn[dt][0]; av[dt][1] = avn[dt][1]; }
    }
#undef SB_LOADKV
    {
        LAS bf16* sl = (LAS bf16*)slab;
#pragma unroll
        for (int dt = 0; dt < 2; ++dt)
#pragma unroll
            for (int k = 0; k < 4; ++k) { const f32x16& o = dt ? o1 : o0; u32x2 w; w.x = pk2(o[4 * k], o[4 * k + 1]); w.y = pk2(o[4 * k + 2], o[4 * k + 3]);
                *(LAS u32x2*)(sl + l31 * 72 + 32 * dt + 8 * k + 4 * hh) = w; }
        const size_t mb = (size_t)b * T + 32 * qt;
#pragma unroll
        for (int i = 0; i < 4; ++i) { const int c = lane + 64 * i, row = c >> 3, part = c & 7;
            const u32x4 ov = *(const LAS u32x4*)(sl + row * 72 + 8 * part); const u32x4 gv = *(const u32x4*)(PROJ + (mb + row) * NP + 1536 + 64 * h + 8 * part);
            u32x4 w;
#pragma unroll
            for (int e = 0; e < 4; ++e) w[e] = pk2(bflo(ov[e]) * silu(bflo(gv[e])), bfhi(ov[e]) * silu(bfhi(gv[e])));
            *(u32x4*)(MIX + (mb + row) * 1024 + 64 * h + 8 * part) = w; }
    }
}

DI void s5_pass1(const Args& a, LAS unsigned char* lds, int item, int tid, int lane, int wave) {
    unsigned char* ws = a.ws;
    const bf16* PROJ = (const bf16*)(ws + WS_PROJ); float* S5S = (float*)(ws + WS_S5S);
    const int g = item & 31, b = (item >> 5) & 3, ct = item >> 7;
    const int rt = wave & 3, kh = wave >> 2, hh = lane >> 5, l31 = lane & 31;
    constexpr int UP = 2064;
    LAS unsigned char* UL = lds + 16384;
#pragma unroll
    for (int i = 0; i < 8; ++i) { const int idx = tid + 512 * i, tok = idx >> 1, hf = idx & 1;
        const u32x4 v = *(const u32x4*)(PROJ + ((size_t)b * T + 2048 * ct + tok) * NP + 2048 + 16 * g + 8 * hf);
        *(LAS u32x4*)(UL + (tok >> 6) * UP + (tok & 63) * 32 + 16 * hf) = v; }
    __syncthreads();
    const unsigned char* vb = ws + WS_VBIG + ((size_t)((g * 4 + rt) * 64) * 64 + lane) * 16;
    f32x16 acc = zero16();
#pragma unroll 4
    for (int s = 32 * kh; s < 32 * kh + 32; ++s) { const bf16x8 A = mk8(*(const u32x4*)(vb + (size_t)s * 1024)); const bf16x8 Bf = *(const LAS bf16x8*)(UL + l31 * UP + s * 32 + 16 * hh); acc = MFMA32(A, Bf, acc); }
    LAS float* red = (LAS float*)lds;
    if (kh == 1) {
#pragma unroll
        for (int i = 0; i < 16; ++i) red[(rt * 16 + i) * 64 + lane] = acc[i]; }
    __syncthreads();
    if (kh == 0) {
        float* dst = S5S + ((size_t)((b * 32 + g) * 128 + 32 * ct + l31)) * 128 + 32 * rt;
#pragma unroll
        for (int k = 0; k < 4; ++k) { f32x4 o;
#pragma unroll
            for (int e = 0; e < 4; ++e) o[e] = acc[4 * k + e] + red[(rt * 16 + 4 * k + e) * 64 + lane];
            *(f32x4*)(dst + 8 * k + 4 * hh) = o; } }
    __syncthreads();
}
DI void s5_pass2(const Args& a, LAS unsigned char* lds, int item, int tid, int lane, int wave) {
    unsigned char* ws = a.ws;
    const bf16* PROJ = (const bf16*)(ws + WS_PROJ); const float* S5S = (const float*)(ws + WS_S5S); bf16* S5Y = (bf16*)(ws + WS_H);
    const int g = item & 31, b = (item >> 5) & 3, ct = item >> 7;
    constexpr int UP = 2064, XPP = 136;
    LAS unsigned char* FL = lds;
    LAS unsigned char* UL = lds + 65536;
    LAS bf16* XPl = (LAS bf16*)(lds + 65536 + 66048);
    {   const unsigned char* fsrc = ws + WS_F + (size_t)g * 65536;
#pragma unroll
        for (int i = 0; i < 8; ++i) { const int idx = tid + 512 * i; *(LAS u32x4*)(FL + idx * 16) = *(const u32x4*)(fsrc + (size_t)idx * 16); }
#pragma unroll
        for (int i = 0; i < 8; ++i) { const int idx = tid + 512 * i, tok = idx >> 1, half = idx & 1;
            const u32x4 v = *(const u32x4*)(PROJ + ((size_t)b * T + 2048 * ct + tok) * NP + 2048 + 16 * g + 8 * half);
            *(LAS u32x4*)(UL + (tok >> 6) * UP + (tok & 63) * 32 + 16 * half) = v; } }
    {
        const int p = lane; const float ar = ((const float*)(ws + WS_ABL))[(g * 64 + p) * 2], ai = ((const float*)(ws + WS_ABL))[(g * 64 + p) * 2 + 1];
        const float* Sp = S5S + (size_t)((b * 32 + g) * 128) * 128;
        LAS float* SEG = (LAS float*)(lds + 65536 + 66048 + 8704);
        const int seg = 4 * ct;
        {   float xr = 0.f, xi = 0.f, qr = 1.f, qi = 0.f;
            for (int c = wave * seg; c < (wave + 1) * seg; ++c) { const float sr = Sp[c * 128 + p], si = Sp[c * 128 + 64 + p];
                const float nr = ar * xr - ai * xi + sr, ni = ar * xi + ai * xr + si; xr = nr; xi = ni; const float tr = qr * ar - qi * ai, ti = qr * ai + qi * ar; qr = tr; qi = ti; }
            SEG[(wave * 4 + 0) * 64 + p] = xr; SEG[(wave * 4 + 1) * 64 + p] = xi; SEG[(wave * 4 + 2) * 64 + p] = qr; SEG[(wave * 4 + 3) * 64 + p] = qi; }
        __syncthreads();
        if (wave == 0) {
            float xr = 0.f, xi = 0.f;
#pragma unroll
            for (int w = 0; w < 8; ++w) { const float sr = SEG[(w * 4 + 0) * 64 + p], si = SEG[(w * 4 + 1) * 64 + p], qr = SEG[(w * 4 + 2) * 64 + p], qi = SEG[(w * 4 + 3) * 64 + p];
                const float nr = qr * xr - qi * xi + sr, ni = qr * xi + qi * xr + si; xr = nr; xi = ni; }
#pragma unroll 8
            for (int n = 0; n < 32; ++n) { XPl[n * XPP + p] = (bf16)f2bf(xr); XPl[n * XPP + 64 + p] = (bf16)f2bf(xi);
                const int c = 32 * ct + n; const float sr = Sp[c * 128 + p], si = Sp[c * 128 + 64 + p]; const float nr = ar * xr - ai * xi + sr, ni = ar * xi + ai * xr + si; xr = nr; xi = ni; }
        }
    }
    __syncthreads();
    const int hh = lane >> 5, l31 = lane & 31;
    f32x16 acc[4];
#pragma unroll
    for (int i = 0; i < 4; ++i) acc[i] = zero16();
#define S5_SEG(I0, SLO, SHI) do { _Pragma("unroll 2") for (int s = (SLO); s <= (SHI); ++s) { \
        const bf16x8 Bf = *(const LAS bf16x8*)(UL + l31 * UP + s * 32 + 16 * hh); bf16x8 Af[4]; \
        _Pragma("unroll") for (int i = (I0); i < 4; ++i) Af[i] = *(const LAS bf16x8*)(FL + (2 * (wave + 8 * i) - s + 1) * 1024 + lane * 16); \
        _Pragma("unroll") for (int i = (I0); i < 4; ++i) acc[i] = MFMA32(Af[i], Bf, acc[i]); } } while (0)
    S5_SEG(0, 0, 2 * wave + 1);
    S5_SEG(1, 2 * wave + 2, 2 * wave + 17);
    S5_SEG(2, 2 * wave + 18, 2 * wave + 33);
    S5_SEG(3, 2 * wave + 34, 2 * wave + 49);
#undef S5_SEG
#pragma unroll
    for (int ks = 0; ks < 8; ++ks) { const bf16x8 Bf = *(const LAS bf16x8*)(XPl + l31 * XPP + 16 * ks + 8 * hh);
#pragma unroll
        for (int i = 0; i < 4; ++i) { const int R = wave + 8 * i;
            const bf16x8 A = mk8(*(const u32x4*)(ws + WS_WBIG + ((size_t)((g * 32 + R) * 8 + ks) * 64 + lane) * 16)); acc[i] = MFMA32(A, Bf, acc[i]); } }
#pragma unroll
    for (int i = 0; i < 4; ++i) { const int R = wave + 8 * i;
#pragma unroll
        for (int k = 0; k < 4; ++k) { const int jj = k >> 1; const size_t tok = (size_t)b * T + 2048 * ct + 64 * l31 + 2 * R + jj;
            u32x2 w; w.x = pk2(acc[i][4 * k], acc[i][4 * k + 1]); w.y = pk2(acc[i][4 * k + 2], acc[i][4 * k + 3]);
            *(u32x2*)(S5Y + tok * 512 + 16 * g + 8 * (k & 1) + 4 * hh) = w; } }
    __syncthreads();
}

__global__ void __launch_bounds__(NTHR, 2) hybrid_fwd(Args a) {
    extern __shared__ __attribute__((aligned(16))) unsigned char lds_raw[];
    LAS unsigned char* lds = (LAS unsigned char*)lds_raw;
    cg::grid_group grid = cg::this_grid();
    const int tid = threadIdx.x, lane = tid & 63, wave = __builtin_amdgcn_readfirstlane(tid >> 6);
    const int bx = blockIdx.x, G = gridDim.x, gw = bx * NWAVES + wave, NGW = G * NWAVES;
    unsigned char* ws = a.ws;
    const float* MOD = (const float*)(ws + WS_MOD);
    bf16* H = (bf16*)(ws + WS_H); bf16* PROJ = (bf16*)(ws + WS_PROJ); bf16* MIX = (bf16*)(ws + WS_MIX);

    if (tid < 4) ((LAS unsigned*)(lds + LDS_BYTES - 16))[tid] = 0u;
    __syncthreads();
    XcdBarrier xbar = xcd_barrier_post((unsigned*)ws, (volatile LAS unsigned*)(lds + LDS_BYTES - 16));
    phase0(a, lds, tid, lane, wave);
    xcd_barrier(xbar);
    norm_rows(a.in[0], a.in[2], MOD, H, gw, NGW, lane);
    __syncthreads();
    s5_tables(a, lds, bx * NTHR + tid, G * NTHR);
    {
        const bf16* WT = (const bf16*)(ws + WS_WIN1); float* SHW = (float*)(ws + WS_SHW);
        for (int col = gw; col < NP; col += NGW) {
            const u32x4 w0 = *(const u32x4*)(WT + (size_t)col * D + 16 * lane), w1 = *(const u32x4*)(WT + (size_t)col * D + 16 * lane + 8);
            float wf[16];
#pragma unroll
            for (int e = 0; e < 4; ++e) { wf[2 * e] = bflo(w0[e]); wf[2 * e + 1] = bfhi(w0[e]); wf[8 + 2 * e] = bflo(w1[e]); wf[8 + 2 * e + 1] = bfhi(w1[e]); }
#pragma unroll
            for (int b = 0; b < 4; ++b) { const float* sh = MOD + (4 + b) * 3072 + 16 * lane; float s = 0.f;
#pragma unroll
                for (int e = 0; e < 16; ++e) s += sh[e] * wf[e];
                s = wave_sum(s); if (lane == 0) SHW[b * 3072 + col] = s; } } }
    xcd_barrier(xbar);
    {   pg8::Gemm g{H, (const bf16*)(ws + WS_WIN0), M, NP, D}; pg8::StaticOrder S; S.init(M, NP, G, bx); pg8::EpiStore E{PROJ, NP};
        pg8::gemm_phase<pg8::EpiStore, pg8::StaticOrder, true, true>(lds, g, S, E); }
    xcd_barrier(xbar);
    for (int it = bx; it < 1024; it += G) prep_item<0>(a, lds, it, tid);
    for (int it = bx; it < 512; it += G) lru_item<1>(a, lds, it, tid, lane, wave);
    {
        const bf16* WT = (const bf16*)(ws + WS_WIN1); bf16* W1S = (bf16*)(ws + WS_W1S); const float* gain = a.in[16];
        for (int c = bx * NTHR + tid; c < 4 * 3072 * 128; c += G * NTHR) { const int b = c / (3072 * 128), rem = c % (3072 * 128), k8 = (rem & 127) * 8;
            const u32x4 wv = *(const u32x4*)(WT + (size_t)rem * 8); const float* sc = MOD + (4 + b) * 3072 + 1024 + k8; u32x4 o;
#pragma unroll
            for (int e = 0; e < 4; ++e) o[e] = pk2(bflo(wv[e]) * gain[k8 + 2 * e] * (1.f + sc[2 * e]), bfhi(wv[e]) * gain[k8 + 2 * e + 1] * (1.f + sc[2 * e + 1]));
            *(u32x4*)(W1S + (size_t)c * 8) = o; } }
    xcd_barrier(xbar);
    if (G == 256) {
        const int xcd = bx & 7, j = bx >> 3;
#pragma unroll 1
        for (int r = 0; r < 4; ++r) { const int bh = 4 * xcd + r, m = (r & 1) ? 31 - j : j; moba_item(a, lds, m * 32 + bh, tid, lane, wave); }
    } else {
#pragma unroll 1
        for (int it = bx; it < 1024; it += G) moba_item(a, lds, 1023 - it, tid, lane, wave);
    }
    for (int it = bx; it < 512; it += G) lru_item<2>(a, lds, it, tid, lane, wave);
    xcd_barrier(xbar);
    {   pg8::Gemm g{MIX, (const bf16*)(ws + WS_WOUT0), M, D, D}; pg8::StaticOrder S; S.init(M, D, G, bx);
        pg8::EpiRes1 E{a.in[0], MOD + 2048, (bf16*)(ws + WS_X1B), (float*)(ws + WS_SS)};
        pg8::gemm_phase<pg8::EpiRes1, pg8::StaticOrder, true, true>(lds, g, S, E); }
    xcd_barrier(xbar);
    {   pg8::Gemm g{(const bf16*)(ws + WS_X1B), (const bf16*)(ws + WS_W1S), M, NP, D, (size_t)3072 * 1024 * 2}; pg8::StaticOrder S; S.init(M, NP, G, bx); pg8::EpiStoreN E{PROJ, NP, (const float*)(ws + WS_SS), (const float*)(ws + WS_SHW)};
        pg8::gemm_phase<pg8::EpiStoreN, pg8::StaticOrder, true, true>(lds, g, S, E); }
    xcd_barrier(xbar);
    for (int it = bx; it < 1024; it += G) prep_item<1>(a, lds, it, tid);
    for (int it = bx; it < 512; it += G) s5_pass1(a, lds, it, tid, lane, wave);
    xcd_barrier(xbar);
    for (int it = bx; it < 512; it += G) s5_pass2(a, lds, it, tid, lane, wave);
    for (int it = gw; it < 8192; it += NGW) sb_item(a, lds + wave * 4608, it, lane);
    xcd_barrier(xbar);
    {   pg8::Gemm g{H, (const bf16*)(ws + WS_WGLU), M, 1024, 512}; pg8::StaticOrder S; S.init(M, 1024, G, bx); pg8::EpiGlu E{a.in[31], PROJ, MIX};
        pg8::gemm_phase<pg8::EpiGlu, pg8::StaticOrder, true, true>(lds, g, S, E); }
    xcd_barrier(xbar);
    {   pg8::Gemm g{MIX, (const bf16*)(ws + WS_WOUT1), M, D, D}; pg8::StaticOrder S; S.init(M, D, G, bx); pg8::EpiRes2 E{(const bf16*)(ws + WS_X1B), a.out, MOD + 4 * 3072 + 2048};
        pg8::gemm_phase<pg8::EpiRes2, pg8::StaticOrder, true, true>(lds, g, S, E); }
    if (gridDim.y == 0x7fffu) grid.sync();
}

extern "C" void kernel_launch(void* const* d_in, const int* in_sizes, int n_in, void* d_out, int out_size, void* d_ws, size_t ws_size, hipStream_t stream) {
    static int grid = 0;
    if (grid == 0) {
        if (n_in != 33 || out_size != M * D || ws_size < WS_END) { fprintf(stderr, "kernel_launch: unexpected shapes (n_in %d out %d ws %zu)\n", n_in, out_size, ws_size); grid = -1; return; }
        int dev = 0, cus = 0, per_cu = 0;
        hipGetDevice(&dev); hipDeviceGetAttribute(&cus, hipDeviceAttributeMultiprocessorCount, dev);
        hipFuncSetAttribute((const void*)hybrid_fwd, hipFuncAttributeMaxDynamicSharedMemorySize, LDS_BYTES);
        hipOccupancyMaxActiveBlocksPerMultiprocessor(&per_cu, (const void*)hybrid_fwd, NTHR, LDS_BYTES);
        if (per_cu < 1) per_cu = 1;
        grid = cus * per_cu; if (grid > 256) grid = 256;
        (void)hipGetLastError();
    }
    if (grid < 0) return;
    if (hipMemsetAsync(d_ws, 0, 262144, stream) != hipSuccess) { fprintf(stderr, "kernel_launch: memset failed\n"); return; }
    Args a{};
    for (int i = 0; i < 33; ++i) a.in[i] = (const float*)d_in[i];
    a.out = (float*)d_out; a.ws = (unsigned char*)d_ws;
    void* args[] = {&a};
    hipError_t e = hipLaunchCooperativeKernel((const void*)hybrid_fwd, dim3(grid), dim3(NTHR), args, LDS_BYTES, stream);
    if (e != hipSuccess) fprintf(stderr, "cooperative launch failed: %s (grid %d)\n", hipGetErrorString(e), grid);
}
```

```cpp
#include <hip/hip_runtime.h>
#include <hip/hip_cooperative_groups.h>
#include <cstdio>
#include <cstdint>
namespace cg = cooperative_groups;
namespace pg8 {
#define PG8_LAS __attribute__((address_space(3)))
typedef unsigned short bf16_t;
typedef short bf16x8 __attribute__((ext_vector_type(8)));
typedef float f32x4 __attribute__((ext_vector_type(4)));
typedef unsigned u32x4 __attribute__((ext_vector_type(4)));
constexpr int BM = 256, BK = 64, HALF = 128, HTB = HALF * BK * 2  , STAGE_BYTES = 8 * HTB, NXCD = 8, WGM = 8;

__host__ __device__ __forceinline__ int lds_byte(int r, int c) { const int st = (r >> 4) * 2 + (c >> 5), rr = r & 15, cc = c & 31, ob = rr * 64 + cc * 2; return st * 1024 + (ob ^ (((ob >> 9) & 1) << 5)); }
__host__ __device__ __forceinline__ void stage_rc(int b, int& R, int& C) { const int st = b / 1024, sb = b % 1024, swz = sb ^ (((sb >> 9) & 1) << 5); R = (st >> 1) * 16 + swz / 64; C = (st & 1) * 32 + (swz % 64) / 2; }
__host__ __device__ __forceinline__ int perm32(int rho) { const int n = rho >> 4, i = rho & 15; return 8 * (i >> 2) + 4 * n + (i & 3); }

struct Unit { int pm, pn; };
struct Gemm { const bf16_t* A; const bf16_t* Bt; int M, N, K; size_t bstride; };

struct StaticOrder {
    int nM, nN, nwg, G, c;
    __host__ __device__ void init(int M, int N, int G_, int c_) { nM = M / BM; nN = N / BM; nwg = nM * nN; G = G_; c = c_; }
    __host__ __device__ bool next(int i, Unit& u) const {
        const long L = (long)i * G + c; if (L >= nwg) return false;
        int wgid = (int)L; { const int q = nwg / NXCD, r = nwg % NXCD, xcd = wgid % NXCD, off = wgid / NXCD; wgid = (xcd < r ? xcd * (q + 1) : r * (q + 1) + (xcd - r) * q) + off; }
        const int nig = WGM * nN, gid = wgid / nig, fm = gid * WGM, gsz = (nM - fm) < WGM ? (nM - fm) : WGM;
        u.pm = fm + ((wgid % nig) % gsz); u.pn = (wgid % nig) / gsz; return true;
    }
    __device__ __forceinline__ void a_ready(const Unit&) const {}
    __device__ __forceinline__ void done(const Unit&) const {}
};

typedef __bf16 hwbf2 __attribute__((ext_vector_type(2)));
typedef float f32x2p __attribute__((ext_vector_type(2)));
__device__ __forceinline__ unsigned pk2f(float lo, float hi) { f32x2p v; v.x = lo; v.y = hi; return __builtin_bit_cast(unsigned, __builtin_convertvector(v, hwbf2)); }
__device__ __forceinline__ float bflo(unsigned w) { return __builtin_bit_cast(float, w << 16); }
__device__ __forceinline__ float bfhi(unsigned w) { return __builtin_bit_cast(float, w & 0xffff0000u); }
struct EpiStore {
    static constexpr bool PERM = true, AFTER_DRAIN = false;
    bf16_t* O; int ldc;
    __device__ __forceinline__ void operator()(const f32x4 (&acc)[2][2][4][2], const Unit& u, int wr, int wc, int fr, int fq) const {
        const int row0 = u.pm * BM + wr * 64 + fr, col0 = u.pn * BM + wc * 32 + 8 * fq;
#pragma unroll
        for (int ai = 0; ai < 2; ++ai)
#pragma unroll
            for (int m = 0; m < 4; ++m) { bf16_t* rowp = O + (size_t)(row0 + ai * HALF + m * 16) * ldc + col0;
#pragma unroll
                for (int bj = 0; bj < 2; ++bj) { const f32x4 v0 = acc[ai][bj][m][0], v1 = acc[ai][bj][m][1];
                    u32x4 w; w.x = pk2f(v0[0], v0[1]); w.y = pk2f(v0[2], v0[3]); w.z = pk2f(v1[0], v1[1]); w.w = pk2f(v1[2], v1[3]);
                    *(u32x4*)(rowp + bj * HALF) = w; } }
    }
};
struct EpiRes {
    static constexpr bool PERM = false, AFTER_DRAIN = false;
    const float* X; float* O; const float* gate;
    __device__ __forceinline__ void operator()(const f32x4 (&acc)[2][2][4][2], const Unit& u, int wr, int wc, int fr, int fq) const {
        const int row0 = u.pm * BM + wr * 64 + fr, col0 = u.pn * BM + wc * 32 + 4 * fq, b = (u.pm * BM) >> 13;
        f32x4 gv[2][2];
#pragma unroll
        for (int bj = 0; bj < 2; ++bj)
#pragma unroll
            for (int n = 0; n < 2; ++n) gv[bj][n] = *(const f32x4*)(gate + b * 3072 + col0 + bj * HALF + n * 16);
#pragma unroll
        for (int ai = 0; ai < 2; ++ai)
#pragma unroll
            for (int m = 0; m < 4; ++m) { const size_t ro = (size_t)(row0 + ai * HALF + m * 16) * 1024 + col0;
#pragma unroll
                for (int bj = 0; bj < 2; ++bj)
#pragma unroll
                    for (int n = 0; n < 2; ++n) { const size_t idx = ro + bj * HALF + n * 16; const f32x4 xv = *(const f32x4*)(X + idx); *(f32x4*)(O + idx) = xv + gv[bj][n] * acc[ai][bj][m][n]; } }
    }
};
struct EpiRes1 {
    static constexpr bool PERM = true, AFTER_DRAIN = false;
    const float* X; const float* gate; bf16_t* X1B; float* SS;
    __device__ __forceinline__ void operator()(const f32x4 (&acc)[2][2][4][2], const Unit& u, int wr, int wc, int fr, int fq) const {
        const int row0 = u.pm * BM + wr * 64 + fr, col0 = u.pn * BM + wc * 32 + 8 * fq, b = (u.pm * BM) >> 13;
        f32x4 gv[2][2];
#pragma unroll
        for (int bj = 0; bj < 2; ++bj)
#pragma unroll
            for (int n = 0; n < 2; ++n) gv[bj][n] = *(const f32x4*)(gate + b * 3072 + col0 + bj * HALF + n * 4);
#pragma unroll
        for (int ai = 0; ai < 2; ++ai)
#pragma unroll
        for (int mh = 0; mh < 2; ++mh) {
            f32x4 xv[2][2][2];
#pragma unroll
            for (int mm = 0; mm < 2; ++mm)
#pragma unroll
                for (int bj = 0; bj < 2; ++bj) { const size_t idx = (size_t)(row0 + ai * HALF + (2 * mh + mm) * 16) * 1024 + col0 + bj * HALF; xv[mm][bj][0] = *(const f32x4*)(X + idx); xv[mm][bj][1] = *(const f32x4*)(X + idx + 4); }
#pragma unroll
            for (int mm = 0; mm < 2; ++mm) { const int m = 2 * mh + mm; const int row = row0 + ai * HALF + m * 16; const size_t ro = (size_t)row * 1024 + col0; float s = 0.f;
#pragma unroll
                for (int bj = 0; bj < 2; ++bj) { const size_t idx = ro + bj * HALF;
                    const f32x4 y0 = xv[mm][bj][0] + gv[bj][0] * acc[ai][bj][m][0], y1 = xv[mm][bj][1] + gv[bj][1] * acc[ai][bj][m][1];
                    s += ((y0[0] * y0[0] + y0[1] * y0[1]) + (y0[2] * y0[2] + y0[3] * y0[3])) + ((y1[0] * y1[0] + y1[1] * y1[1]) + (y1[2] * y1[2] + y1[3] * y1[3]));
                    u32x4 w; w.x = pk2f(y0[0], y0[1]); w.y = pk2f(y0[2], y0[3]); w.z = pk2f(y1[0], y1[1]); w.w = pk2f(y1[2], y1[3]); *(u32x4*)(X1B + idx) = w; }
                s += __shfl_xor(s, 16); s += __shfl_xor(s, 32);
                if (fq == 0) __hip_atomic_fetch_add(SS + row, s, __ATOMIC_RELAXED, __HIP_MEMORY_SCOPE_AGENT); }
        }
    }
};
struct EpiRes2 {
    static constexpr bool PERM = true, AFTER_DRAIN = false;
    const bf16_t* X1B; float* O; const float* gate;
    __device__ __forceinline__ void operator()(const f32x4 (&acc)[2][2][4][2], const Unit& u, int wr, int wc, int fr, int fq) const {
        const int row0 = u.pm * BM + wr * 64 + fr, col0 = u.pn * BM + wc * 32 + 8 * fq, b = (u.pm * BM) >> 13;
        f32x4 gv[2][2];
#pragma unroll
        for (int bj = 0; bj < 2; ++bj)
#pragma unroll
            for (int n = 0; n < 2; ++n) gv[bj][n] = *(const f32x4*)(gate + b * 3072 + col0 + bj * HALF + n * 4);
#pragma unroll
        for (int ai = 0; ai < 2; ++ai) {
            u32x4 xw[4][2];
#pragma unroll
            for (int m = 0; m < 4; ++m)
#pragma unroll
                for (int bj = 0; bj < 2; ++bj) xw[m][bj] = *(const u32x4*)(X1B + (size_t)(row0 + ai * HALF + m * 16) * 1024 + col0 + bj * HALF);
#pragma unroll
            for (int m = 0; m < 4; ++m) { const size_t ro = (size_t)(row0 + ai * HALF + m * 16) * 1024 + col0;
#pragma unroll
                for (int bj = 0; bj < 2; ++bj) { const size_t idx = ro + bj * HALF; const u32x4 q = xw[m][bj];
                    f32x4 x0, x1; x0[0] = bflo(q.x); x0[1] = bfhi(q.x); x0[2] = bflo(q.y); x0[3] = bfhi(q.y); x1[0] = bflo(q.z); x1[1] = bfhi(q.z); x1[2] = bflo(q.w); x1[3] = bfhi(q.w);
                    *(f32x4*)(O + idx) = x0 + gv[bj][0] * acc[ai][bj][m][0]; *(f32x4*)(O + idx + 4) = x1 + gv[bj][1] * acc[ai][bj][m][1]; } }
        }
    }
};
struct EpiStoreN {
    static constexpr bool PERM = true, AFTER_DRAIN = false;
    bf16_t* O; int ldc; const float* SS; const float* shw;
    __device__ __forceinline__ void operator()(const f32x4 (&acc)[2][2][4][2], const Unit& u, int wr, int wc, int fr, int fq) const {
        const int row0 = u.pm * BM + wr * 64 + fr, col0 = u.pn * BM + wc * 32 + 8 * fq, b = (u.pm * BM) >> 13;
        f32x4 sw[2][2];
#pragma unroll
        for (int bj = 0; bj < 2; ++bj) { sw[bj][0] = *(const f32x4*)(shw + b * 3072 + col0 + bj * HALF); sw[bj][1] = *(const f32x4*)(shw + b * 3072 + col0 + bj * HALF + 4); }
        float ssv[2][4];
#pragma unroll
        for (int ai = 0; ai < 2; ++ai)
#pragma unroll
            for (int m = 0; m < 4; ++m) ssv[ai][m] = SS[row0 + ai * HALF + m * 16];
#pragma unroll
        for (int ai = 0; ai < 2; ++ai)
#pragma unroll
            for (int m = 0; m < 4; ++m) { const int row = row0 + ai * HALF + m * 16; bf16_t* rowp = O + (size_t)row * ldc + col0;
                const float rstd = __builtin_amdgcn_rsqf(ssv[ai][m] * (1.f / 1024.f) + 1e-6f);
#pragma unroll
                for (int bj = 0; bj < 2; ++bj) { const f32x4 v0 = acc[ai][bj][m][0] * rstd + sw[bj][0], v1 = acc[ai][bj][m][1] * rstd + sw[bj][1];
                    u32x4 w; w.x = pk2f(v0[0], v0[1]); w.y = pk2f(v0[2], v0[3]); w.z = pk2f(v1[0], v1[1]); w.w = pk2f(v1[2], v1[3]);
                    *(u32x4*)(rowp + bj * HALF) = w; } }
    }
};
struct EpiGlu {
    static constexpr bool PERM = true, AFTER_DRAIN = false;
    const float* bias; const bf16_t* proj; bf16_t* mix;
    __device__ __forceinline__ void operator()(const f32x4 (&acc)[2][2][4][2], const Unit& u, int wr, int wc, int fr, int fq) const {
        const int row0 = u.pm * BM + wr * 64 + fr, colv = u.pn * 128 + wc * 32 + 8 * fq;
        const f32x4 bv0 = *(const f32x4*)(bias + colv), bv1 = *(const f32x4*)(bias + colv + 4), bg0 = *(const f32x4*)(bias + 512 + colv), bg1 = *(const f32x4*)(bias + 512 + colv + 4);
        u32x4 gsv[2][4];
#pragma unroll
        for (int ai = 0; ai < 2; ++ai)
#pragma unroll
            for (int m = 0; m < 4; ++m) gsv[ai][m] = *(const u32x4*)(proj + (size_t)(row0 + ai * HALF + m * 16) * 3072 + 2560 + colv);
#pragma unroll
        for (int ai = 0; ai < 2; ++ai)
#pragma unroll
            for (int m = 0; m < 4; ++m) { const size_t row = (size_t)(row0 + ai * HALF + m * 16);
                const u32x4 gs = gsv[ai][m];
                const f32x4 va = acc[ai][0][m][0] + bv0, vb = acc[ai][0][m][1] + bv1, ga = acc[ai][1][m][0] + bg0, gb = acc[ai][1][m][1] + bg1;
                float y[8];
#pragma unroll
                for (int e = 0; e < 4; ++e) { const float g0 = (e & 1) ? bfhi(gs[e >> 1]) : bflo(gs[e >> 1]); const float g1 = (e & 1) ? bfhi(gs[2 + (e >> 1)]) : bflo(gs[2 + (e >> 1)]);
                    y[e] = va[e] * __builtin_amdgcn_rcpf(1.f + __expf(-ga[e])) * (g0 * __builtin_amdgcn_rcpf(1.f + __expf(-g0))); y[4 + e] = vb[e] * __builtin_amdgcn_rcpf(1.f + __expf(-gb[e])) * (g1 * __builtin_amdgcn_rcpf(1.f + __expf(-g1))); }
                u32x4 w; w.x = pk2f(y[0], y[1]); w.y = pk2f(y[2], y[3]); w.z = pk2f(y[4], y[5]); w.w = pk2f(y[6], y[7]);
                *(u32x4*)(mix + row * 1024 + 512 + colv) = w; }
    }
};
template <class Epi, class Sched, bool ALIGN_EPI = false, bool SP2 = false>
__device__ __forceinline__ void gemm_phase(PG8_LAS unsigned char* lds, const Gemm g, const Sched& S, const Epi& E) {
    int tid_ = threadIdx.x; asm volatile("" : "+v"(tid_));
    const int tid = tid_, wid = __builtin_amdgcn_readfirstlane(tid >> 6), lane = tid & 63, wr = wid >> 2, wc = wid & 3, fr = lane & 15, fq = lane >> 4;
    const int K = g.K, nt = K / BK;
    unsigned voffA[2], voffB[2];
#pragma unroll
    for (int i = 0; i < 2; ++i) { int R, C; stage_rc(tid * 16 + i * 8192, R, C); const int Rb = Epi::PERM ? ((R & ~31) + perm32(R & 31)) : R;
        voffA[i] = (unsigned)(R * K + C) * 2u; voffB[i] = (unsigned)(Rb * K + C) * 2u; }
    const size_t kstep = (size_t)(BK * 2);
    const size_t hstep = (size_t)HALF * K * 2;
    const size_t tstep = 2 * hstep;
    const unsigned ldsw = (unsigned)wid * 1024u;
    const int aoff = lds_byte(wr * 64 + fr, fq * 8), boff = lds_byte(wc * 32 + fr, fq * 8);
#define PG8_SA(b, h) (((b) * 2 + (h)) * HTB)
#define PG8_SB(b, h) ((4 + (b) * 2 + (h)) * HTB)
#define PG8_STAGE(bufoff, gbase, voff) do { _Pragma("unroll") for (int _i = 0; _i < 2; ++_i) \
        __builtin_amdgcn_global_load_lds((const unsigned*)((const char*)(gbase) + (voff)[_i]), (PG8_LAS unsigned*)(lds + (bufoff) + ldsw + _i * 8192), 16, 0, 0); } while (0)
#define PG8_LDA(dst, b, h) do { _Pragma("unroll") for (int m = 0; m < 4; ++m) _Pragma("unroll") for (int k = 0; k < 2; ++k) dst[m][k] = *(const PG8_LAS bf16x8*)(lds + PG8_SA(b, h) + aoff + m * 2048 + k * 1024); } while (0)
#define PG8_LDB(dst, b, h) do { _Pragma("unroll") for (int n = 0; n < 2; ++n) _Pragma("unroll") for (int k = 0; k < 2; ++k) dst[n][k] = *(const PG8_LAS bf16x8*)(lds + PG8_SB(b, h) + boff + n * 2048 + k * 1024); } while (0)
#define PG8_MMA(ai, bj, At, Bt) do { __builtin_amdgcn_s_setprio(1); _Pragma("unroll") for (int m = 0; m < 4; ++m) _Pragma("unroll") for (int n = 0; n < 2; ++n) _Pragma("unroll") for (int k = 0; k < 2; ++k) \
        acc[ai][bj][m][n] = __builtin_amdgcn_mfma_f32_16x16x32_bf16(Bt[n][k], At[m][k], acc[ai][bj][m][n], 0, 0, 0); __builtin_amdgcn_s_setprio(0); } while (0)
#define PG8_WAIT_V(n) asm volatile("s_waitcnt vmcnt(" #n ")" ::: "memory")
#define PG8_WAIT_L(n) asm volatile("s_waitcnt lgkmcnt(" #n ")" ::: "memory")
#define PG8_BAR __builtin_amdgcn_s_barrier()
#define PG8_SCHED __builtin_amdgcn_sched_barrier(0)
    Unit cur, nxt; int ui = 0;
    if (!S.next(0, cur)) return;
    f32x4 acc[2][2][4][2];
#pragma unroll
    for (int a = 0; a < 2; ++a)
#pragma unroll
        for (int b = 0; b < 2; ++b)
#pragma unroll
            for (int m = 0; m < 4; ++m)
#pragma unroll
                for (int n = 0; n < 2; ++n) acc[a][b][m][n] = (f32x4){0.f, 0.f, 0.f, 0.f};
    bf16x8 At[4][2], B0[2][2], B1[2][2];
    const char* cA = (const char*)g.A + (size_t)cur.pm * tstep; const char* cB = (const char*)g.Bt + (size_t)cur.pn * tstep + (size_t)(cur.pm >> 5) * g.bstride;
    S.a_ready(cur);
    if constexpr (SP2) {
        PG8_STAGE(PG8_SB(0, 0), cB, voffB); PG8_STAGE(PG8_SB(0, 1), cB + hstep, voffB); PG8_STAGE(PG8_SA(0, 0), cA, voffA); PG8_STAGE(PG8_SA(0, 1), cA + hstep, voffA);
        if (wr == 1) PG8_BAR;
        PG8_WAIT_V(2); PG8_BAR;
        PG8_STAGE(PG8_SB(1, 0), cB + kstep, voffB); PG8_STAGE(PG8_SA(1, 0), cA + kstep, voffA); PG8_STAGE(PG8_SB(1, 1), cB + hstep + kstep, voffB);
        PG8_WAIT_V(6); PG8_BAR;
    } else {
        PG8_STAGE(PG8_SB(0, 0), cB, voffB); PG8_STAGE(PG8_SA(0, 0), cA, voffA); PG8_STAGE(PG8_SB(0, 1), cB + hstep, voffB); PG8_STAGE(PG8_SA(0, 1), cA + hstep, voffA);
        if (wr == 1) PG8_BAR;
        PG8_WAIT_V(4); PG8_BAR;
        PG8_STAGE(PG8_SB(1, 0), cB + kstep, voffB); PG8_STAGE(PG8_SA(1, 0), cA + kstep, voffA); PG8_STAGE(PG8_SB(1, 1), cB + hstep + kstep, voffB);
        PG8_WAIT_V(6); PG8_BAR;
    }
    for (;;) {
        const bool has_next = S.next(ui + 1, nxt);
        const char* nA = has_next ? (const char*)g.A + (size_t)nxt.pm * tstep : cA; const char* nB = has_next ? (const char*)g.Bt + (size_t)nxt.pn * tstep + (size_t)(nxt.pm >> 5) * g.bstride : cB;
        for (int t = 0; t < nt; t += 2) {
            const bool last = (t == nt - 2);
            const char* a1 = cA + (size_t)(t + 1) * kstep;
            const char* a2 = last ? nA : cA + (size_t)(t + 2) * kstep; const char* b2 = last ? nB : cB + (size_t)(t + 2) * kstep;
            const char* a3 = a2 + kstep; const char* b3 = b2 + kstep;
            if (last && has_next) S.a_ready(nxt);
            if constexpr (SP2) {
            PG8_LDB(B0, 0, 0); PG8_LDB(B1, 0, 1); PG8_SCHED; PG8_LDA(At, 0, 0); PG8_STAGE(PG8_SA(1, 1), a1 + hstep, voffA);
            PG8_WAIT_V(8); PG8_WAIT_L(0); PG8_BAR; PG8_MMA(0, 0, At, B0); PG8_MMA(0, 1, At, B1); PG8_BAR; PG8_SCHED;
            PG8_LDA(At, 0, 1); PG8_STAGE(PG8_SB(0, 0), b2, voffB); PG8_STAGE(PG8_SB(0, 1), b2 + hstep, voffB); PG8_STAGE(PG8_SA(0, 0), a2, voffA);
            PG8_WAIT_V(8); PG8_WAIT_L(0); PG8_BAR; PG8_MMA(1, 0, At, B0); PG8_MMA(1, 1, At, B1); PG8_BAR; PG8_SCHED;
            PG8_LDB(B0, 1, 0); PG8_LDB(B1, 1, 1); PG8_SCHED; PG8_LDA(At, 1, 0); PG8_STAGE(PG8_SA(0, 1), a2 + hstep, voffA);
            PG8_WAIT_V(8); PG8_WAIT_L(0); PG8_BAR; PG8_MMA(0, 0, At, B0); PG8_MMA(0, 1, At, B1); PG8_BAR; PG8_SCHED;
            PG8_LDA(At, 1, 1); PG8_STAGE(PG8_SB(1, 0), b3, voffB); PG8_STAGE(PG8_SB(1, 1), b3 + hstep, voffB); PG8_STAGE(PG8_SA(1, 0), a3, voffA);
            PG8_WAIT_V(8); PG8_WAIT_L(0); PG8_BAR; PG8_MMA(1, 0, At, B0); PG8_MMA(1, 1, At, B1); PG8_BAR; PG8_SCHED;
            } else {
            PG8_LDB(B0, 0, 0); PG8_SCHED; PG8_LDA(At, 0, 0); PG8_STAGE(PG8_SA(1, 1), a1 + hstep, voffA);
            PG8_WAIT_L(8); PG8_BAR; PG8_WAIT_L(0); PG8_MMA(0, 0, At, B0); PG8_BAR; PG8_SCHED;
            PG8_LDB(B1, 0, 1); PG8_STAGE(PG8_SB(0, 0), b2, voffB);
            PG8_BAR; PG8_WAIT_L(0); PG8_MMA(0, 1, At, B1); PG8_BAR;
            PG8_LDA(At, 0, 1); PG8_STAGE(PG8_SA(0, 0), a2, voffA);
            PG8_BAR; PG8_WAIT_L(0); PG8_MMA(1, 0, At, B0); PG8_BAR; PG8_SCHED;
            PG8_STAGE(PG8_SB(0, 1), b2 + hstep, voffB);
            PG8_WAIT_V(6); PG8_BAR; PG8_MMA(1, 1, At, B1); PG8_BAR;
            PG8_LDB(B0, 1, 0); PG8_SCHED; PG8_LDA(At, 1, 0); PG8_STAGE(PG8_SA(0, 1), a2 + hstep, voffA);
            PG8_WAIT_L(8); PG8_BAR; PG8_WAIT_L(0); PG8_MMA(0, 0, At, B0); PG8_BAR; PG8_SCHED;
            PG8_LDB(B1, 1, 1); PG8_STAGE(PG8_SB(1, 0), b3, voffB);
            PG8_BAR; PG8_WAIT_L(0); PG8_MMA(0, 1, At, B1); PG8_BAR;
            PG8_LDA(At, 1, 1); PG8_STAGE(PG8_SA(1, 0), a3, voffA);
            PG8_BAR; PG8_WAIT_L(0); PG8_MMA(1, 0, At, B0); PG8_BAR; PG8_SCHED;
            PG8_STAGE(PG8_SB(1, 1), b3 + hstep, voffB);
            PG8_WAIT_V(6); PG8_BAR; PG8_MMA(1, 1, At, B1); PG8_BAR;
            }
        }
        if constexpr (ALIGN_EPI) { if (wr == 0) PG8_BAR; }
        if constexpr (!Epi::AFTER_DRAIN) { E(acc, cur, wr, wc, fr, fq); S.done(cur); }
        if (!has_next) break;
#pragma unroll
        for (int a = 0; a < 2; ++a)
#pragma unroll
            for (int b = 0; b < 2; ++b)
#pragma unroll
                for (int m = 0; m < 4; ++m)
#pragma unroll
                    for (int n = 0; n < 2; ++n) acc[a][b][m][n] = (f32x4){0.f, 0.f, 0.f, 0.f};
        cur = nxt; cA = nA; cB = nB; ++ui;
        if constexpr (ALIGN_EPI) { if (wr == 1) PG8_BAR; }
    }
    PG8_WAIT_V(0);
    if constexpr (!ALIGN_EPI) { if (wr == 0) PG8_BAR; }
    PG8_BAR;
    if constexpr (Epi::AFTER_DRAIN) { E.fused(acc, cur, wr, wc, fr, fq, lds, wid, lane); S.done(cur); }
#undef PG8_SA
#undef PG8_SB
#undef PG8_STAGE
#undef PG8_LDA
#undef PG8_LDB
#undef PG8_MMA
#undef PG8_WAIT_V
#undef PG8_WAIT_L
#undef PG8_BAR
#undef PG8_SCHED
}
}
#define DI __device__ __forceinline__
#define LAS __attribute__((address_space(3)))
typedef unsigned short bf16;
typedef short bf16x8 __attribute__((ext_vector_type(8)));
typedef float f32x4 __attribute__((ext_vector_type(4)));
typedef float f32x2 __attribute__((ext_vector_type(2)));
typedef float f32x16 __attribute__((ext_vector_type(16)));
typedef unsigned u32x4 __attribute__((ext_vector_type(4)));
typedef unsigned u32x2 __attribute__((ext_vector_type(2)));
#define MFMA32(a, b, c) __builtin_amdgcn_mfma_f32_32x32x16_bf16((a), (b), (c), 0, 0, 0)

constexpr int NB = 4, T = 8192, D = 1024, M = NB * T, NP = 3072;
constexpr int NWAVES = 8, NTHR = 512;
constexpr int LDS_BYTES = 155648;
constexpr size_t MiB = 1u << 20;
constexpr size_t WS_MOD = 1 * MiB;
constexpr size_t WS_SS = 128 * 1024;
constexpr size_t WS_SHW = 1 * MiB + 256 * 1024;
constexpr size_t WS_GW = 1 * MiB + 512 * 1024;
constexpr size_t WS_ABL = 2 * MiB;
constexpr size_t WS_BB = 2 * MiB + 65536;
constexpr size_t WS_PW = 3 * MiB;
constexpr size_t WS_F = 5 * MiB;
constexpr size_t WS_VBIG = 8 * MiB;
constexpr size_t WS_WBIG = 16 * MiB;
constexpr size_t WS_WIN0 = 24 * MiB, WS_WOUT0 = 30 * MiB, WS_WIN1 = 32 * MiB, WS_WGLU = 38 * MiB, WS_WOUT1 = 39 * MiB;
constexpr size_t WS_KMEAN = 41 * MiB;
constexpr size_t WS_LRUSUM = 42 * MiB;
constexpr size_t WS_S5S = 44 * MiB;
constexpr size_t WS_VT = 52 * MiB;
constexpr size_t WS_H = 84 * MiB;
constexpr size_t WS_MIX = 148 * MiB;
constexpr size_t WS_PROJ = 212 * MiB;
constexpr size_t WS_KF = 404 * MiB;
constexpr size_t WS_X1B = 436 * MiB;
constexpr size_t WS_W1S = 116 * MiB;
constexpr size_t WS_END = 500 * MiB;

struct Args { const float* in[33]; float* out; unsigned char* ws; };

DI unsigned f2bf(float f) { unsigned u = __builtin_bit_cast(unsigned, f); return (u + 0x7fffu + ((u >> 16) & 1u)) >> 16; }
DI unsigned pk2(float lo, float hi) { return pg8::pk2f(lo, hi); }
DI float bf2f(unsigned short b) { return __builtin_bit_cast(float, (unsigned)b << 16); }
DI float bflo(unsigned w) { return __builtin_bit_cast(float, w << 16); }
DI float bfhi(unsigned w) { return __builtin_bit_cast(float, w & 0xffff0000u); }
DI int crow(int reg, int h) { return (reg & 3) + 8 * (reg >> 2) + 4 * h; }
DI float sigm(float x) { return __builtin_amdgcn_rcpf(1.f + __expf(-x)); }
DI float silu(float x) { return x * __builtin_amdgcn_rcpf(1.f + __expf(-x)); }
DI bf16x8 mk8(u32x4 v) { return __builtin_bit_cast(bf16x8, v); }
DI bf16x8 pack8(float a0, float a1, float a2, float a3, float a4, float a5, float a6, float a7) { u32x4 v; v.x = pk2(a0, a1); v.y = pk2(a2, a3); v.z = pk2(a4, a5); v.w = pk2(a6, a7); return __builtin_bit_cast(bf16x8, v); }
DI f32x16 zero16() { f32x16 z;
#pragma unroll
  for (int i = 0; i < 16; ++i) z[i] = 0.f; return z; }

#define XB_TMO      128
#define XB_XCNT(j)  (256  + 64 * (j))
#define XB_XSUB(j)  (1280 + 64 * (j))
#define XB_XGEN(j)  (2304 + 64 * (j))
#define XB_TOP      3328
#define XB_TOPGEN   3392
#define XCD_BAR_WORDS 3456
#define XB_SPIN_CAP (1u << 18)

__device__ __forceinline__ unsigned xb_ld(unsigned* p)              { return __hip_atomic_load(p, __ATOMIC_RELAXED, __HIP_MEMORY_SCOPE_AGENT); }
__device__ __forceinline__ unsigned xb_add(unsigned* p, unsigned v) { return __hip_atomic_fetch_add(p, v, __ATOMIC_RELAXED, __HIP_MEMORY_SCOPE_AGENT); }
__device__ __forceinline__ unsigned xb_xcc_id() { return (unsigned)__builtin_amdgcn_s_getreg((3 << 11) | 20) & 0xFu; }
#define XB_SPIN(cond, bar) do { unsigned _sp = 0; while (cond) { __builtin_amdgcn_s_sleep(1); \
    if ((++_sp & 255u) == 0u) { if (xb_ld(&(bar)[XB_TMO])) break; if (_sp > XB_SPIN_CAP) { atomicAdd(&(bar)[XB_TMO], 1u); break; } } } } while (0)

struct XcdBarrier {
    unsigned* bar; unsigned x;
    volatile LAS unsigned* st;
};

__device__ __forceinline__ XcdBarrier xcd_barrier_post(unsigned* bar, volatile LAS unsigned* st) {
    XcdBarrier b; b.bar = bar; b.x = xb_xcc_id(); b.st = st;
    if (threadIdx.x == 0) (void)xb_add(&bar[XB_XCNT(b.x)], 1u);
    return b;
}
__device__ __forceinline__ void xcd_barrier_complete(unsigned* bar, unsigned x, unsigned& nloc, unsigned& nx) {
    const unsigned G = gridDim.x * gridDim.y * gridDim.z;
    unsigned sum, cnt, mine, sp = 0u;
    for (;;) {
        sum = 0u; cnt = 0u; mine = 0u;
#pragma unroll
        for (unsigned j = 0; j < 16; ++j) { const unsigned c = xb_ld(&bar[XB_XCNT(j)]); sum += c; cnt += (c > 0u) ? 1u : 0u; mine = (j == x) ? c : mine; }
        if (sum == G) break;
        __builtin_amdgcn_s_sleep(1);
        if ((++sp & 255u) == 0u) { if (xb_ld(&bar[XB_TMO])) break; if (sp > XB_SPIN_CAP) { atomicAdd(&bar[XB_TMO], 1u); break; } }
    }
    nloc = mine > 0u ? mine : 1u; nx = cnt > 0u ? cnt : 1u;
}

__device__ __forceinline__ void xcd_barrier(const XcdBarrier& b) {
    asm volatile("s_waitcnt vmcnt(0)" ::: "memory");
    __syncthreads();
    if (threadIdx.x == 0) {
        unsigned* bar = b.bar;
        __builtin_amdgcn_s_waitcnt(0);
        unsigned nloc = b.st[0], nx = b.st[1];
        if (nloc == 0u) { xcd_barrier_complete(bar, b.x, nloc, nx); b.st[0] = nloc; b.st[1] = nx; }
        const unsigned old = xb_add(&bar[XB_XSUB(b.x)], 1u);
        const unsigned gen = old / nloc;
        if (old + 1u == (gen + 1u) * nloc) {
            __builtin_amdgcn_fence(__ATOMIC_RELEASE, "agent");
            asm volatile("s_waitcnt vmcnt(0)" ::: "memory");
            const unsigned og = xb_add(&bar[XB_TOP], 1u);
            const unsigned tg = og / nx;
            if (og + 1u == (tg + 1u) * nx) xb_add(&bar[XB_TOPGEN], 1u);
            else XB_SPIN(xb_ld(&bar[XB_TOPGEN]) == tg, bar);
            __builtin_amdgcn_fence(__ATOMIC_ACQUIRE, "agent");
            xb_add(&bar[XB_XGEN(b.x)], 1u);
            asm volatile("s_waitcnt vmcnt(0)" ::: "memory");
        } else {
            XB_SPIN(xb_ld(&bar[XB_XGEN(b.x)]) == gen, bar);
            __builtin_amdgcn_fence(__ATOMIC_ACQUIRE, "agent");
            asm volatile("s_waitcnt vmcnt(0)" ::: "memory");
        }
    }
    __syncthreads();
}

DI void transpose_item(const float* W, int K, int N, bf16* WT, int dst_row0, LAS float* scr, int kb, int nb, int lane) {
    const int k0 = 64 * kb, n0 = 32 * nb;
#pragma unroll 8
    for (int i = 0; i < 32; ++i) { const int kk = 2 * i + (lane >> 5); scr[kk * 33 + (lane & 31)] = W[(size_t)(k0 + kk) * N + n0 + (lane & 31)]; }
    asm volatile("s_waitcnt lgkmcnt(0)" ::: "memory");
    const int c = lane & 7;
#pragma unroll
    for (int j = 0; j < 4; ++j) { const int n = (lane >> 3) + 8 * j; const LAS float* s = scr + (8 * c) * 33 + n;
        u32x4 o; o.x = pk2(s[0 * 33], s[1 * 33]); o.y = pk2(s[2 * 33], s[3 * 33]); o.z = pk2(s[4 * 33], s[5 * 33]); o.w = pk2(s[6 * 33], s[7 * 33]);
        *(u32x4*)(WT + (size_t)(dst_row0 + n) * K + k0 + 8 * c) = o; }
    asm volatile("s_waitcnt lgkmcnt(0)" ::: "memory");
}

DI void phase0(const Args& a, LAS unsigned char* lds, int tid, int lane, int wave) {
    unsigned char* ws = a.ws;
    const int bx = blockIdx.x;
    if (bx < 192) {
        const int layer = bx / 96, cc = bx % 96, l31 = lane & 31, hh = lane >> 5, col = 32 * cc + l31;
        const float* W = layer ? a.in[17] : a.in[3]; const float* cv = a.in[1];
        LAS float* SC = (LAS float*)lds;
        LAS float* red = (LAS float*)(lds + 16384);
        for (int i = tid; i < 4096; i += NTHR) SC[i] = silu(cv[i]);
        __syncthreads();
        float a0 = 0.f, a1 = 0.f, a2 = 0.f, a3 = 0.f;
        const float* wp = W + (size_t)(128 * wave + hh) * 3072 + col;
#pragma unroll 1
        for (int i0 = 0; i0 < 64; i0 += 16) { float wv[16];
#pragma unroll
            for (int i = 0; i < 16; ++i) wv[i] = wp[(size_t)(2 * (i0 + i)) * 3072];
#pragma unroll
            for (int i = 0; i < 16; ++i) { const int k = 128 * wave + 2 * (i0 + i) + hh; a0 += SC[k] * wv[i]; a1 += SC[1024 + k] * wv[i]; a2 += SC[2048 + k] * wv[i]; a3 += SC[3072 + k] * wv[i]; } }
        a0 += __shfl_xor(a0, 32); a1 += __shfl_xor(a1, 32); a2 += __shfl_xor(a2, 32); a3 += __shfl_xor(a3, 32);
        if (hh == 0) { red[(wave * 4 + 0) * 32 + l31] = a0; red[(wave * 4 + 1) * 32 + l31] = a1; red[(wave * 4 + 2) * 32 + l31] = a2; red[(wave * 4 + 3) * 32 + l31] = a3; }
        __syncthreads();
        if (tid < 128) { const int b = tid >> 5, l = tid & 31; float s = 0.f;
#pragma unroll
            for (int w = 0; w < 8; ++w) s += red[(w * 4 + b) * 32 + l];
            const float* bias = layer ? a.in[18] : a.in[4];
            ((float*)(ws + WS_MOD))[(layer * 4 + b) * 3072 + 32 * cc + l] = s + bias[32 * cc + l]; }
        __syncthreads();
    } else if (bx < 196) {
        const int gp = (bx - 192) * 512 + tid, g = gp >> 6;
        const float step = __expf(a.in[24][g]);
        const float lr = a.in[22][gp], li = a.in[23][gp];
        const float decay = __expf(lr * step);
        float rev = li * step * 0.15915494309189535f; rev -= floorf(rev);
        const float abr = decay * __builtin_amdgcn_cosf(rev), abi = decay * __builtin_amdgcn_sinf(rev);
        const float den = lr * lr + li * li;
        const float fr = ((abr - 1.f) * lr + abi * li) / den, fi = (abi * lr - (abr - 1.f) * li) / den;
        float* BB = (float*)(ws + WS_BB) + (size_t)gp * 32;
#pragma unroll
        for (int h = 0; h < 16; ++h) { const float br = a.in[25][gp * 16 + h], bi = a.in[26][gp * 16 + h]; BB[2 * h] = fr * br - fi * bi; BB[2 * h + 1] = fr * bi + fi * br; }
        float* PW = (float*)(ws + WS_PW) + ((size_t)g * 65 * 64 + (gp & 63)) * 2;
        float pr = 1.f, pi = 0.f;
        for (int t = 0; t < 64; ++t) { PW[(size_t)t * 128] = pr; PW[(size_t)t * 128 + 1] = pi; const float nr = pr * abr - pi * abi, ni = pr * abi + pi * abr; pr = nr; pi = ni; }
        PW[(size_t)64 * 128] = pr; PW[(size_t)64 * 128 + 1] = pi;
        float* ABL = (float*)(ws + WS_ABL) + gp * 2; ABL[0] = pr; ABL[1] = pi;
    }
    if (bx == 200 && tid == 0) { float gq = 0.f, gk = 0.f;
        for (int i = 0; i < 64; ++i) { gq = fmaxf(gq, fabsf(a.in[13][i])); gk = fmaxf(gk, fabsf(a.in[14][i])); }
        ((float*)(ws + WS_MOD))[2 * 4 * 3072] = 8.f * gq * gk; }
    if (bx >= 201 && bx < 217) {
        const int v = (bx - 201) * 512 + tid, ln = v & 63, s = (v >> 6) & 3, ct = (v >> 8) & 1, g = (v >> 9) & 7, gate = v >> 12, l31 = ln & 31, hh = ln >> 5;
        const float* wsrc = (gate ? a.in[10] : a.in[8]) + (size_t)g * 4096 + (16 * s + 8 * hh) * 64 + 32 * ct + l31;
        u32x4 o; o.x = pk2(wsrc[0], wsrc[64]); o.y = pk2(wsrc[128], wsrc[192]); o.z = pk2(wsrc[256], wsrc[320]); o.w = pk2(wsrc[384], wsrc[448]);
        *(u32x4*)(ws + WS_GW + (size_t)v * 16) = o; }
    LAS float* scr = (LAS float*)(lds + 16384 + wave * 8704);
    const int gw = bx * NWAVES + wave, NGW = gridDim.x * NWAVES;
    constexpr int I0 = 16 * 96, I1 = 16 * 32, I2 = 16 * 96, I3 = 8 * 32, I4 = 16 * 32;
    for (int it = gw; it < I0 + I1 + I2 + I3 + I4; it += NGW) {
        int r = it;
        if (r < I0) { transpose_item(a.in[5], 1024, 3072, (bf16*)(ws + WS_WIN0), 32 * (r % 96), scr, r / 96, r % 96, lane); continue; } r -= I0;
        if (r < I1) { transpose_item(a.in[15], 1024, 1024, (bf16*)(ws + WS_WOUT0), 32 * (r % 32), scr, r / 32, r % 32, lane); continue; } r -= I1;
        if (r < I2) { transpose_item(a.in[19], 1024, 3072, (bf16*)(ws + WS_WIN1), 32 * (r % 96), scr, r / 96, r % 96, lane); continue; } r -= I2;
        if (r < I3) { const int nb = r % 32, n0 = 32 * nb; const int nn = n0 & 511; const int dst = 256 * (nn >> 7) + (n0 >= 512 ? 128 : 0) + (nn & 127);
            transpose_item(a.in[30], 512, 1024, (bf16*)(ws + WS_WGLU), dst, scr, r / 32, nb, lane); continue; } r -= I3;
        transpose_item(a.in[32], 1024, 1024, (bf16*)(ws + WS_WOUT1), 32 * (r % 32), scr, r / 32, r % 32, lane);
    }
}

DI float wave_sum(float v) {
#pragma unroll
    for (int o = 1; o < 64; o <<= 1) v += __shfl_xor(v, o);
    return v;
}
DI void norm_rows(const float* xin, const float* gain, const float* modl, bf16* H, int gw, int NGW, int lane) {
    f32x4 gs[4], sh[4]; int curb = -1;
    for (int m = gw; m < M; m += NGW) {
        const f32x4* xr = (const f32x4*)(xin + (size_t)m * D) + lane;
        f32x4 v[4]; float s = 0.f;
#pragma unroll
        for (int j = 0; j < 4; ++j) v[j] = xr[64 * j];
        const int b = m >> 13;
        if (b != curb) { curb = b; const float* mb = modl + b * 3072;
#pragma unroll
            for (int j = 0; j < 4; ++j) { const int c = 4 * lane + 256 * j; gs[j] = *(const f32x4*)(gain + c) * (*(const f32x4*)(mb + 1024 + c) + 1.f); sh[j] = *(const f32x4*)(mb + c); } }
#pragma unroll
        for (int j = 0; j < 4; ++j) s += (v[j].x * v[j].x + v[j].y * v[j].y) + (v[j].z * v[j].z + v[j].w * v[j].w);
        const float rstd = rsqrtf(wave_sum(s) * (1.f / D) + 1e-6f);
        unsigned long long* o8 = (unsigned long long*)(H + (size_t)m * D) + lane;
#pragma unroll
        for (int j = 0; j < 4; ++j) { const f32x4 y = v[j] * rstd * gs[j] + sh[j];
            o8[64 * j] = (unsigned long long)pk2(y.x, y.y) | ((unsigned long long)pk2(y.z, y.w) << 32); }
    }
}

DI void s5_tables(const Args& a, LAS unsigned char* lds, int gt, int NT) {
    unsigned char* ws = a.ws;
    const float* PW = (const float*)(ws + WS_PW); const float* BB = (const float*)(ws + WS_BB);
    const float* cre = a.in[27]; const float* cim = a.in[28]; const float* dd = a.in[29];
    const bool staged = (NT == 32 * 64 * 16 * 4);
    LAS float* LB = (LAS float*)lds; LAS float* LP = LB + 2048; LAS float* LC = LP + 1024; LAS float* LI = LC + 1024;
    if (staged) { const int g = blockIdx.x >> 3, tau0 = (8 * blockIdx.x) & 63; const int t = threadIdx.x;
#pragma unroll
        for (int i = 0; i < 4; ++i) LB[t + 512 * i] = BB[(size_t)g * 2048 + t + 512 * i];
#pragma unroll
        for (int i = 0; i < 2; ++i) { LP[t + 512 * i] = PW[((size_t)(g * 65 + tau0) * 64) * 2 + t + 512 * i]; LC[t + 512 * i] = cre[g * 1024 + t + 512 * i]; LI[t + 512 * i] = cim[g * 1024 + t + 512 * i]; }
        __syncthreads(); }
    for (int v4 = gt; v4 < 32 * 64 * 16 * 4; v4 += NT) {
        const int v = v4 >> 2, pq = v4 & 3, g = v >> 10, tau = (v >> 4) & 63, h = v & 15;
        float acc[16];
#pragma unroll
        for (int e = 0; e < 16; ++e) acc[e] = 0.f;
        if (staged) {
#pragma unroll 4
            for (int pi = 0; pi < 16; ++pi) { const int p = 16 * pq + pi;
                const float cr = LC[h * 64 + p], ci = LI[h * 64 + p];
                const f32x2 pw = *(const LAS f32x2*)(LP + ((tau & 7) * 64 + p) * 2);
                const float wr = cr * pw.x - ci * pw.y, wi = cr * pw.y + ci * pw.x;
                const LAS f32x4* bb = (const LAS f32x4*)(LB + p * 32);
#pragma unroll
                for (int e2 = 0; e2 < 8; ++e2) { const f32x4 b4 = bb[e2]; acc[2 * e2] += wr * b4.x - wi * b4.y; acc[2 * e2 + 1] += wr * b4.z - wi * b4.w; }
            }
        } else {
#pragma unroll 4
        for (int pi = 0; pi < 16; ++pi) { const int p = 16 * pq + pi;
            const float cr = cre[(g * 16 + h) * 64 + p], ci = cim[(g * 16 + h) * 64 + p];
            const f32x2 pw = *(const f32x2*)(PW + ((size_t)(g * 65 + tau) * 64 + p) * 2);
            const float wr = cr * pw.x - ci * pw.y, wi = cr * pw.y + ci * pw.x;
            const f32x4* bb = (const f32x4*)(BB + (size_t)(g * 64 + p) * 32);
#pragma unroll
            for (int e2 = 0; e2 < 8; ++e2) { const f32x4 b4 = bb[e2]; acc[2 * e2] += wr * b4.x - wi * b4.y; acc[2 * e2 + 1] += wr * b4.z - wi * b4.w; }
        }
        }
#pragma unroll
        for (int e = 0; e < 16; ++e) { acc[e] += __shfl_xor(acc[e], 1); acc[e] += __shfl_xor(acc[e], 2); }
        if (pq != 0) continue;
        if (tau == 0) { const float dv = dd[g * 16 + h];
#pragma unroll
            for (int e = 0; e < 16; ++e) if (e == h) acc[e] += dv; }
        u32x4 lo, hi; lo.x = pk2(acc[0], acc[1]); lo.y = pk2(acc[2], acc[3]); lo.z = pk2(acc[4], acc[5]); lo.w = pk2(acc[6], acc[7]);
        hi.x = pk2(acc[8], acc[9]); hi.y = pk2(acc[10], acc[11]); hi.z = pk2(acc[12], acc[13]); hi.w = pk2(acc[14], acc[15]);
        unsigned char* fb = ws + WS_F + (size_t)g * 65536;
        if (tau + 1 < 64) { *(u32x4*)(fb + (size_t)((tau + 1) * 64 + h) * 16) = lo; *(u32x4*)(fb + (size_t)((tau + 1) * 64 + 32 + h) * 16) = hi; }
        *(u32x4*)(fb + (size_t)(tau * 64 + 16 + h) * 16) = lo; *(u32x4*)(fb + (size_t)(tau * 64 + 48 + h) * 16) = hi;
        if (tau == 0) { u32x4 z; z.x = 0u; z.y = 0u; z.z = 0u; z.w = 0u; *(u32x4*)(fb + (size_t)h * 16) = z; *(u32x4*)(fb + (size_t)(32 + h) * 16) = z; }
    }
    for (int vb_ = gt; vb_ < 32 * 4 * 64 * 64; vb_ += 4 * NT)
#pragma unroll
    for (int u_ = 0; u_ < 4; ++u_) { const int v = vb_ + u_ * NT; if (v >= 32 * 4 * 64 * 64) continue;
        const int g = v >> 14, rt = (v >> 12) & 3, s = (v >> 6) & 63, lane = v & 63, q = 32 * rt + (lane & 31), part = q >> 6, p = q & 63, hh = lane >> 5;
        const f32x2 pw = *(const f32x2*)(PW + ((size_t)(g * 65 + (63 - s)) * 64 + p) * 2);
        const float* bb = BB + ((size_t)(g * 64 + p) * 16 + 8 * hh) * 2;
        float o[8];
#pragma unroll
        for (int e = 0; e < 8; ++e) o[e] = part ? (pw.x * bb[2 * e + 1] + pw.y * bb[2 * e]) : (pw.x * bb[2 * e] - pw.y * bb[2 * e + 1]);
        u32x4 w; w.x = pk2(o[0], o[1]); w.y = pk2(o[2], o[3]); w.z = pk2(o[4], o[5]); w.w = pk2(o[6], o[7]);
        *(u32x4*)(ws + WS_VBIG + (size_t)v * 16) = w;
    }
    for (int vb_ = gt; vb_ < 32 * 32 * 8 * 64; vb_ += 4 * NT)
#pragma unroll
    for (int u_ = 0; u_ < 4; ++u_) { const int v = vb_ + u_ * NT; if (v >= 32 * 32 * 8 * 64) continue;
        const int g = v >> 14, R = (v >> 9) & 31, ks = (v >> 6) & 7, lane = v & 63, r = lane & 31, jj = r >> 4, h = r & 15, hh = lane >> 5, tok = 2 * R + jj, part = ks >> 2;
        float o[8];
#pragma unroll
        for (int e = 0; e < 8; ++e) { const int p = 16 * (ks & 3) + 8 * hh + e;
            const float cr = cre[(g * 16 + h) * 64 + p], ci = cim[(g * 16 + h) * 64 + p];
            const f32x2 pw = *(const f32x2*)(PW + ((size_t)(g * 65 + tok + 1) * 64 + p) * 2);
            o[e] = part ? -(cr * pw.y + ci * pw.x) : (cr * pw.x - ci * pw.y); }
        u32x4 w; w.x = pk2(o[0], o[1]); w.y = pk2(o[2], o[3]); w.z = pk2(o[4], o[5]); w.w = pk2(o[6], o[7]);
        *(u32x4*)(ws + WS_WBIG + (size_t)v * 16) = w;
    }
}
template <int PASS>
DI void lru_item(const Args& a, LAS unsigned char* lds, int item, int tid, int lane, int wave) {
    unsigned char* ws = a.ws;
    const bf16* PROJ = (const bf16*)(ws + WS_PROJ); bf16* MIX = (bf16*)(ws + WS_MIX); float* SUM = (float*)(ws + WS_LRUSUM);
    const int b = item >> 7, ch = item & 127; const size_t m0 = (size_t)b * T + 64 * ch;
    constexpr int XP = 520;
    LAS bf16* XC = (LAS bf16*)lds; LAS bf16* HB = (LAS bf16*)(lds + 66560);
    {
        LAS bf16* XR = HB;
        u32x4 xv[9];
#pragma unroll
        for (int i = 0; i < 9; ++i) { const int idx = tid + 512 * i, r = idx >> 6, c8 = idx & 63;
            xv[i].x = 0u; xv[i].y = 0u; xv[i].z = 0u; xv[i].w = 0u;
            if (idx < 67 * 64 && (ch > 0 || r >= 3)) xv[i] = *(const u32x4*)(PROJ + (m0 + r - 3) * NP + 8 * c8); }
#pragma unroll
        for (int i = 0; i < 9; ++i) { const int idx = tid + 512 * i, r = idx >> 6, c8 = idx & 63;
            if (idx < 67 * 64) *(LAS u32x4*)(XR + r * XP + 8 * c8) = xv[i]; }
        __syncthreads();
        const int c = tid; const float* cw = a.in[6];
        const float w0 = cw[c], w1 = cw[512 + c], w2 = cw[1024 + c], w3 = cw[1536 + c], cb = a.in[7][c];
        float xm3 = bf2f(XR[c]), xm2 = bf2f(XR[XP + c]), xm1 = bf2f(XR[2 * XP + c]);
#pragma unroll 4
        for (int j = 0; j < 64; ++j) { const float x0 = bf2f(XR[(j + 3) * XP + c]); const float xc = w0 * xm3 + w1 * xm2 + w2 * xm1 + w3 * x0 + cb; XC[j * XP + c] = (bf16)f2bf(xc); xm3 = xm2; xm2 = xm1; xm1 = x0; }
    }
    LAS float* CAR = (LAS float*)(lds + 136448);
    if (PASS == 2) { float h = 0.f; const float* sp2 = SUM + ((size_t)(b * 128) * 512 + tid) * 2;
#pragma unroll 16
        for (int cc = 0; cc < ch; ++cc) { const f32x2 s2 = *(const f32x2*)(sp2 + (size_t)cc * 1024); h = s2.x * h + s2.y; }
        CAR[tid] = h; }
    __syncthreads();
    const int g = wave, hh = lane >> 5, l31 = lane & 31;
    const bf16* GW = (const bf16*)(ws + WS_GW);
#pragma unroll 1
    for (int ct = 0; ct < 2; ++ct) {
        const int j = 32 * ct + l31, c = 64 * g + j;
        bf16x8 Br[4], Bi[4];
#pragma unroll
        for (int s = 0; s < 4; ++s) { Br[s] = mk8(*(const u32x4*)(GW + ((size_t)(((0 * 8 + g) * 2 + ct) * 4 + s) * 64 + lane) * 8)); Bi[s] = mk8(*(const u32x4*)(GW + ((size_t)(((1 * 8 + g) * 2 + ct) * 4 + s) * 64 + lane) * 8)); }
        f32x16 Rr[2], Ii[2];
#pragma unroll
        for (int rt = 0; rt < 2; ++rt) { Rr[rt] = zero16(); Ii[rt] = zero16();
#pragma unroll
            for (int s = 0; s < 4; ++s) { const bf16x8 A = *(const LAS bf16x8*)(XC + (32 * rt + l31) * XP + 64 * g + 16 * s + 8 * hh); Rr[rt] = MFMA32(A, Br[s], Rr[rt]); Ii[rt] = MFMA32(A, Bi[s], Ii[rt]); } }
        const float rb = a.in[9][c], ib = a.in[11][c];
        const float sp = log1pf(__expf(-a.in[12][c]));
#pragma unroll
        for (int rt = 0; rt < 2; ++rt)
#pragma unroll
            for (int i = 0; i < 16; ++i) { const int tok = 32 * rt + crow(i, hh);
                const float r = sigm(Rr[rt][i] + rb), ig = sigm(Ii[rt][i] + ib);
                const float la = -8.f * r * sp; const float av = __expf(la); const float x2 = 2.f * la;
                const float ser = -x2 * (1.f + 0.5f * x2 * (1.f + (1.f / 3.f) * x2 * (1.f + 0.25f * x2 * (1.f + 0.2f * x2 * (1.f + (1.f / 6.f) * x2)))));
                const float om = (x2 > -0.25f) ? ser : (1.f - av * av); const float mult = __builtin_amdgcn_sqrtf(om);
                const float xv = bf2f(XC[tok * XP + c]);
                Rr[rt][i] = av; Ii[rt][i] = mult * ig * xv; if ((i & 3) == 3) __builtin_amdgcn_sched_barrier(0); }
        float Ag[8], Bg[8], Ao[8], Bo[8];
#pragma unroll
        for (int rt = 0; rt < 2; ++rt)
#pragma unroll
            for (int k = 0; k < 4; ++k) { float A = 1.f, Bv = 0.f;
#pragma unroll
                for (int e = 0; e < 4; ++e) { const float av = Rr[rt][4 * k + e]; Bv = av * Bv + Ii[rt][4 * k + e]; A *= av; }
                Ag[rt * 4 + k] = A; Bg[rt * 4 + k] = Bv; }
#pragma unroll
        for (int q = 0; q < 8; ++q) { Ao[q] = __shfl_xor(Ag[q], 32); Bo[q] = __shfl_xor(Bg[q], 32); }
        float h = (PASS == 2) ? CAR[c] : 0.f;
        float hs[8]; float Atot = 1.f;
#pragma unroll
        for (int q = 0; q < 8; ++q) {
            const float A1 = hh ? Ao[q] : Ag[q], B1 = hh ? Bo[q] : Bg[q], A2 = hh ? Ag[q] : Ao[q], B2 = hh ? Bg[q] : Bo[q];
            const float h1 = A1 * h + B1; hs[q] = hh ? h1 : h; h = A2 * h1 + B2; Atot *= A1 * A2; }
        if (PASS == 1) { if (hh == 0) { f32x2 o; o.x = Atot; o.y = h; *(f32x2*)(SUM + ((size_t)(b * 128 + ch) * 512 + c) * 2) = o; } }
        else {
#pragma unroll
            for (int rt = 0; rt < 2; ++rt)
#pragma unroll
                for (int k = 0; k < 4; ++k) { float hc = hs[rt * 4 + k];
#pragma unroll
                    for (int e = 0; e < 4; ++e) { const int i = 4 * k + e; hc = Rr[rt][i] * hc + Ii[rt][i]; HB[(32 * rt + 8 * k + 4 * hh + e) * XP + c] = (bf16)f2bf(hc); } }
        }
    }
    __syncthreads();
    if (PASS == 2) {
#pragma unroll
        for (int i = 0; i < 8; ++i) { const int idx = tid + 512 * i, tok = idx >> 6, c8 = idx & 63;
            const u32x4 hv = *(const LAS u32x4*)(HB + tok * XP + 8 * c8); const u32x4 gv = *(const u32x4*)(PROJ + (m0 + tok) * NP + 512 + 8 * c8);
            u32x4 o;
#pragma unroll
            for (int e = 0; e < 4; ++e) o[e] = pk2(bflo(hv[e]) * silu(bflo(gv[e])), bfhi(hv[e]) * silu(bfhi(gv[e])));
            *(u32x4*)(MIX + (m0 + tok) * 1024 + 8 * c8) = o; }
        __syncthreads();
    }
}

template <int LAYER>
DI void prep_item(const Args& a, LAS unsigned char* lds, int item, int tid) {
    unsigned char* ws = a.ws;
    bf16* PROJ = (bf16*)(ws + WS_PROJ); bf16* VF = (bf16*)(ws + WS_VT); bf16* KF = (bf16*)(ws + WS_KF);
    constexpr int qoff = LAYER ? 0 : 1024, koff = LAYER ? 512 : 1536, voff = LAYER ? 1024 : 2048;
    const float* qg = LAYER ? a.in[20] : a.in[13]; const float* kg = LAYER ? a.in[21] : a.in[14];
    const int h = item & 7, n = (item >> 3) & 31, b = item >> 8;
    LAS bf16* VL = (LAS bf16*)lds; LAS float* RED = (LAS float*)(lds + 40960);
    const int c8 = tid & 7, r0 = tid >> 3;
    float qgv[8], kgv[8], ksum[8];
#pragma unroll
    for (int e = 0; e < 8; ++e) { qgv[e] = qg[8 * c8 + e]; kgv[e] = kg[8 * c8 + e]; ksum[e] = 0.f; }
    u32x4 lq[4], lk[4], lv[4];
#pragma unroll
    for (int i = 0; i < 4; ++i) { const bf16* base = PROJ + ((size_t)b * T + 256 * n + r0 + 64 * i) * NP + 64 * h + 8 * c8; lq[i] = *(const u32x4*)(base + qoff); lk[i] = *(const u32x4*)(base + koff); lv[i] = *(const u32x4*)(base + voff); }
#pragma unroll
    for (int i = 0; i < 4; ++i) {
        const int row = r0 + 64 * i; bf16* base = PROJ + ((size_t)b * T + 256 * n + row) * NP + 64 * h + 8 * c8;
        {   u32x4 v = lq[i]; float f[8];
#pragma unroll
            for (int e = 0; e < 4; ++e) { f[2 * e] = bflo(v[e]); f[2 * e + 1] = bfhi(v[e]); }
            float ss = 0.f;
#pragma unroll
            for (int e = 0; e < 8; ++e) ss += f[e] * f[e];
            ss += __shfl_xor(ss, 1); ss += __shfl_xor(ss, 2); ss += __shfl_xor(ss, 4);
            const float rstd = rsqrtf(ss * (1.f / 64.f) + 1e-6f);
#pragma unroll
            for (int e = 0; e < 8; ++e) f[e] = f[e] * rstd * qgv[e];
            u32x4 o; o.x = pk2(f[0], f[1]); o.y = pk2(f[2], f[3]); o.z = pk2(f[4], f[5]); o.w = pk2(f[6], f[7]); *(u32x4*)(base + qoff) = o; }
        {   u32x4 v = lk[i]; float f[8];
#pragma unroll
            for (int e = 0; e < 4; ++e) { f[2 * e] = bflo(v[e]); f[2 * e + 1] = bfhi(v[e]); }
            float ss = 0.f;
#pragma unroll
            for (int e = 0; e < 8; ++e) ss += f[e] * f[e];
            ss += __shfl_xor(ss, 1); ss += __shfl_xor(ss, 2); ss += __shfl_xor(ss, 4);
            const float rstd = rsqrtf(ss * (1.f / 64.f) + 1e-6f);
#pragma unroll
            for (int e = 0; e < 8; ++e) { f[e] = f[e] * rstd * kgv[e]; ksum[e] += f[e]; }
            u32x4 o; o.x = pk2(f[0], f[1]); o.y = pk2(f[2], f[3]); o.z = pk2(f[4], f[5]); o.w = pk2(f[6], f[7]);
            *(u32x4*)(KF + ((((size_t)(b * 8 + h) * 256 + 8 * n + (row >> 5)) * 4 + (c8 >> 1)) * 64 + (c8 & 1) * 32 + (row & 31)) * 8) = o; }
        *(LAS u32x4*)(VL + row * 72 + 8 * c8) = lv[i];
    }
    if (LAYER == 0) {
#pragma unroll
        for (int e = 0; e < 8; ++e) RED[r0 * 64 + 8 * c8 + e] = ksum[e]; }
    __syncthreads();
    if (LAYER == 0 && tid < 64) { float s = 0.f;
        for (int r = 0; r < 64; ++r) s += RED[r * 64 + tid];
        ((float*)(ws + WS_KMEAN))[((size_t)(b * 8 + h) * 32 + n) * 64 + tid] = s * (1.f / 256.f); }
#pragma unroll
    for (int i = 0; i < 4; ++i) { const int idx = tid + 512 * i, ln = idx & 63, s = (idx >> 6) & 1, dt = (idx >> 7) & 1, kt = idx >> 8, l31 = ln & 31, hh = ln >> 5;
        const LAS bf16* vp = VL + (32 * kt + 16 * s + 4 * hh) * 72 + 32 * dt + l31;
        const unsigned short e0 = vp[0], e1 = vp[72], e2 = vp[144], e3 = vp[216], e4 = vp[8 * 72], e5 = vp[9 * 72], e6 = vp[10 * 72], e7 = vp[11 * 72];
        u32x4 o; o.x = e0 | ((unsigned)e1 << 16); o.y = e2 | ((unsigned)e3 << 16); o.z = e4 | ((unsigned)e5 << 16); o.w = e6 | ((unsigned)e7 << 16);
        *(u32x4*)(VF + (((((size_t)(b * 8 + h) * 256 + 8 * n + kt) * 2 + dt) * 2 + s) * 64 + ln) * 8) = o; }
    __syncthreads();
}

DI void moba_item(const Args& a, LAS unsigned char* lds, int item, int tid, int lane, int wave) {
    unsigned char* ws = a.ws;
    const bf16* PROJ = (const bf16*)(ws + WS_PROJ); const bf16* VT = (const bf16*)(ws + WS_VT); bf16* MIX = (bf16*)(ws + WS_MIX);
    const int bh = item & 31, m = item >> 5, b = bh >> 3, h = bh & 7;
    constexpr int QP = 72, SP = 68;
    LAS bf16* QS = (LAS bf16*)lds;
    LAS bf16* SLAB = (LAS bf16*)(lds + 36864);
    LAS float* KM = (LAS float*)(lds + 36864);
    LAS float* SL = (LAS float*)(lds + 141312);
    LAS unsigned short* LISTQ = (LAS unsigned short*)(lds + 144384);
    LAS unsigned short* SELROW = (LAS unsigned short*)(lds + 145920);
    LAS int* CNT = (LAS int*)(lds + 147968);
    LAS int* OFF = (LAS int*)(lds + 148096);
    LAS unsigned short* TILES = (LAS unsigned short*)(lds + 148224);
    LAS int* NTL = (LAS int*)(lds + 148352);
    const size_t mq0 = (size_t)b * T + 256 * m;
    {   const int row = tid >> 1, half = tid & 1; const bf16* src = PROJ + (mq0 + row) * NP + 1024 + 64 * h + 32 * half;
#pragma unroll
        for (int i = 0; i < 4; ++i) { const u32x4 v = *(const u32x4*)(src + 8 * i); u32x4 o;
#pragma unroll
            for (int e = 0; e < 4; ++e) o[e] = pk2(bflo(v[e]) * (0.125f * 1.4426950408889634f), bfhi(v[e]) * (0.125f * 1.4426950408889634f));
            *(LAS u32x4*)(QS + row * QP + 32 * half + 8 * i) = o; } }
    {   const float* km = (const float*)(ws + WS_KMEAN) + (size_t)(b * 8 + h) * 2048;
        for (int i = tid; i < m * 64; i += NTHR) KM[i] = km[i]; }
    if (tid < 32) CNT[tid] = 0;
    __syncthreads();
    int i0 = 255, i1 = 255, i2 = 255, ps0 = 0, ps1 = 0, ps2 = 0;
    if (tid < 256 && m > 0) {
        float q[64];
#pragma unroll
        for (int i = 0; i < 8; ++i) { const u32x4 v = *(const LAS u32x4*)(QS + tid * QP + 8 * i);
#pragma unroll
            for (int e = 0; e < 4; ++e) { q[8 * i + 2 * e] = bflo(v[e]); q[8 * i + 2 * e + 1] = bfhi(v[e]); } }
        float v0 = -INFINITY, v1 = -INFINITY, v2 = -INFINITY;
        for (int n = 0; n < m; ++n) { float dot = 0.f;
#pragma unroll
            for (int d4 = 0; d4 < 16; ++d4) { const f32x4 kv = *(const LAS f32x4*)(KM + n * 64 + 4 * d4); dot += q[4 * d4] * kv.x + q[4 * d4 + 1] * kv.y + q[4 * d4 + 2] * kv.z + q[4 * d4 + 3] * kv.w; }
            if (dot > v0) { v2 = v1; i2 = i1; v1 = v0; i1 = i0; v0 = dot; i0 = n; }
            else if (dot > v1) { v2 = v1; i2 = i1; v1 = dot; i1 = n; }
            else if (dot > v2) { v2 = dot; i2 = n; } }
        if (i0 != 255) ps0 = __hip_atomic_fetch_add(CNT + i0, 1, __ATOMIC_RELAXED, __HIP_MEMORY_SCOPE_WORKGROUP);
        if (i1 != 255) ps1 = __hip_atomic_fetch_add(CNT + i1, 1, __ATOMIC_RELAXED, __HIP_MEMORY_SCOPE_WORKGROUP);
        if (i2 != 255) ps2 = __hip_atomic_fetch_add(CNT + i2, 1, __ATOMIC_RELAXED, __HIP_MEMORY_SCOPE_WORKGROUP);
    }
    __syncthreads();
    if (tid < 64) {
        const int c = (lane < m) ? CNT[lane] : 0, ntile = (c + 31) >> 5;
        int pc = c, ptile = ntile;
#pragma unroll
        for (int o = 1; o < 32; o <<= 1) { const int uc = __shfl_up(pc, o), ut = __shfl_up(ptile, o); if ((lane & 31) >= o) { pc += uc; ptile += ut; } }
        if (lane < 32) { OFF[lane] = pc - c; for (int qt = 0; qt < ntile; ++qt) TILES[ptile - ntile + qt] = (unsigned short)(lane | (qt << 8)); if (lane == 31) NTL[0] = ptile; }
    }
    __syncthreads();
    if (tid < 256) {
        unsigned short r0 = 0xffff, r1 = 0xffff, r2 = 0xffff;
        if (i0 != 255) { r0 = (unsigned short)(OFF[i0] + ps0); LISTQ[r0] = (unsigned short)tid; }
        if (i1 != 255) { r1 = (unsigned short)(OFF[i1] + ps1); LISTQ[r1] = (unsigned short)tid; }
        if (i2 != 255) { r2 = (unsigned short)(OFF[i2] + ps2); LISTQ[r2] = (unsigned short)tid; }
        SELROW[tid * 4] = r0; SELROW[tid * 4 + 1] = r1; SELROW[tid * 4 + 2] = r2;
    }
    __syncthreads();
    const float cb2 = ((const float*)(ws + WS_MOD))[2 * 4 * 3072] * 1.4426950408889634f;
    f32x16 sinit;
#pragma unroll
    for (int i = 0; i < 16; ++i) sinit[i] = -cb2;
    const int hh = lane >> 5, l31 = lane & 31, w = wave;
    const bf16* Kb = (const bf16*)(ws + WS_KF) + ((size_t)(b * 8 + h) * 256 * 4 * 64 + lane) * 8;
    const bf16* Vb = VT + ((size_t)(b * 8 + h) * 256 * 4 * 64 + lane) * 8;
    const int nt = NTL[0];
#define MOBA_LOADKV(AK, AV, key0) do { const size_t kt_ = (size_t)((key0) >> 5) * 2048; \
    _Pragma("unroll") for (int s = 0; s < 4; ++s) AK[s] = mk8(*(const u32x4*)(Kb + kt_ + s * 512)); \
    _Pragma("unroll") for (int dt = 0; dt < 2; ++dt) _Pragma("unroll") for (int s = 0; s < 2; ++s) AV[dt][s] = mk8(*(const u32x4*)(Vb + kt_ + (dt * 2 + s) * 512)); } while (0)
    for (int t = w; t < nt; t += 8) {
        const int tl = TILES[t], n = tl & 255, qt = tl >> 8, cnt = CNT[n], rowb = OFF[n] + 32 * qt;
        const bool valid = (32 * qt + l31) < cnt; const int qrow = valid ? (int)LISTQ[rowb + l31] : 0;
        bf16x8 bq[4];
#pragma unroll
        for (int s = 0; s < 4; ++s) bq[s] = *(const LAS bf16x8*)(QS + qrow * QP + 16 * s + 8 * hh);
        f32x16 o0 = zero16(), o1 = zero16(); f32x2 ls2; ls2.x = 0.f; ls2.y = 0.f;
        bf16x8 ak[4], av[2][2], akn[4], avn[2][2];
        MOBA_LOADKV(ak, av, 256 * n);
#define MOBA_STEP(AK, AV, AKN, AVN, knext) do { \
            MOBA_LOADKV(AKN, AVN, knext); \
            f32x16 sacc = sinit; \
            _Pragma("unroll") for (int s = 0; s < 4; ++s) sacc = MFMA32(AK[s], bq[s], sacc); \
            _Pragma("unroll") for (int i = 0; i < 16; i += 2) { f32x2 p2; p2.x = __builtin_amdgcn_exp2f(sacc[i]); p2.y = __builtin_amdgcn_exp2f(sacc[i + 1]); sacc[i] = p2.x; sacc[i + 1] = p2.y; ls2 += p2; } \
            const bf16x8 p0 = pack8(sacc[0], sacc[1], sacc[2], sacc[3], sacc[4], sacc[5], sacc[6], sacc[7]); \
            const bf16x8 p1 = pack8(sacc[8], sacc[9], sacc[10], sacc[11], sacc[12], sacc[13], sacc[14], sacc[15]); \
            o0 = MFMA32(AV[0][0], p0, o0); o0 = MFMA32(AV[0][1], p1, o0); o1 = MFMA32(AV[1][0], p0, o1); o1 = MFMA32(AV[1][1], p1, o1); } while (0)
#pragma unroll 1
        for (int ks = 0; ks < 8; ks += 2) {
            MOBA_STEP(ak, av, akn, avn, 256 * n + 32 * (ks + 1));
            MOBA_STEP(akn, avn, ak, av, 256 * n + 32 * (ks < 6 ? ks + 2 : ks + 1));
        }
        float lsum = ls2.x + ls2.y;
        lsum += __shfl_xor(lsum, 32);
        if (valid) {
            LAS bf16* sr = SLAB + (rowb + l31) * SP + 4 * hh;
#pragma unroll
            for (int k = 0; k < 4; ++k) { u32x2 wv; wv.x = pk2(o0[4 * k], o0[4 * k + 1]); wv.y = pk2(o0[4 * k + 2], o0[4 * k + 3]); *(LAS u32x2*)(sr + 8 * k) = wv;
                u32x2 wu; wu.x = pk2(o1[4 * k], o1[4 * k + 1]); wu.y = pk2(o1[4 * k + 2], o1[4 * k + 3]); *(LAS u32x2*)(sr + 32 + 8 * k) = wu; }
            if (hh == 0) SL[rowb + l31] = lsum;
        }
    }
    f32x16 o0 = zero16(), o1 = zero16(); float lsum = 0.f;
    {
        const int qrow = 32 * w + l31;
        bf16x8 bq[4];
#pragma unroll
        for (int s = 0; s < 4; ++s) bq[s] = *(const LAS bf16x8*)(QS + qrow * QP + 16 * s + 8 * hh);
        bf16x8 ak[4], av[2][2], akn[4], avn[2][2];
        MOBA_LOADKV(ak, av, 256 * m);
#pragma unroll 1
        for (int ks = 0; ks <= w; ++ks) {
            const int kn = 256 * m + 32 * (ks < w ? ks + 1 : ks);
            MOBA_LOADKV(akn, avn, kn);
            f32x16 sacc = sinit;
#pragma unroll
            for (int s = 0; s < 4; ++s) sacc = MFMA32(ak[s], bq[s], sacc);
#pragma unroll
            for (int i = 0; i < 16; ++i) { float p = __builtin_amdgcn_exp2f(sacc[i]); if (ks == w && crow(i, hh) > l31) p = 0.f; sacc[i] = p; lsum += p; }
            const bf16x8 p0 = pack8(sacc[0], sacc[1], sacc[2], sacc[3], sacc[4], sacc[5], sacc[6], sacc[7]);
            const bf16x8 p1 = pack8(sacc[8], sacc[9], sacc[10], sacc[11], sacc[12], sacc[13], sacc[14], sacc[15]);
            o0 = MFMA32(av[0][0], p0, o0); o0 = MFMA32(av[0][1], p1, o0); o1 = MFMA32(av[1][0], p0, o1); o1 = MFMA32(av[1][1], p1, o1);
#pragma unroll
            for (int s = 0; s < 4; ++s) ak[s] = akn[s];
#pragma unroll
            for (int dt = 0; dt < 2; ++dt) { av[dt][0] = avn[dt][0]; av[dt][1] = avn[dt][1]; }
        }
        lsum += __shfl_xor(lsum, 32);
    }
    __syncthreads();
    {
        const int qrow = 32 * w + l31;
#pragma unroll
        for (int j = 0; j < 3; ++j) { const int r = SELROW[qrow * 4 + j];
            if (r != 0xffff) { lsum += SL[r]; const LAS bf16* sr = SLAB + r * SP + 4 * hh;
#pragma unroll
                for (int k = 0; k < 4; ++k) { const u32x2 u0 = *(const LAS u32x2*)(sr + 8 * k), u1 = *(const LAS u32x2*)(sr + 32 + 8 * k);
                    o0[4 * k] += bflo(u0.x); o0[4 * k + 1] += bfhi(u0.x); o0[4 * k + 2] += bflo(u0.y); o0[4 * k + 3] += bfhi(u0.y);
                    o1[4 * k] += bflo(u1.x); o1[4 * k + 1] += bfhi(u1.x); o1[4 * k + 2] += bflo(u1.y); o1[4 * k + 3] += bfhi(u1.y); } } }
        const float inv = 1.f / lsum;
        LAS bf16* sl = QS + (32 * w) * QP;
#pragma unroll
        for (int dt = 0; dt < 2; ++dt)
#pragma unroll
            for (int k = 0; k < 4; ++k) { const f32x16& o = dt ? o1 : o0; u32x2 wv; wv.x = pk2(o[4 * k] * inv, o[4 * k + 1] * inv); wv.y = pk2(o[4 * k + 2] * inv, o[4 * k + 3] * inv);
                *(LAS u32x2*)(sl + l31 * QP + 32 * dt + 8 * k + 4 * hh) = wv; }
#pragma unroll
        for (int i = 0; i < 4; ++i) { const int c = lane + 64 * i, row = c >> 3, part = c & 7;
            const u32x4 ov = *(const LAS u32x4*)(sl + row * QP + 8 * part); const u32x4 gv = *(const u32x4*)(PROJ + (mq0 + 32 * w + row) * NP + 2560 + 64 * h + 8 * part);
            u32x4 wv;
#pragma unroll
            for (int e = 0; e < 4; ++e) wv[e] = pk2(bflo(ov[e]) * silu(bflo(gv[e])), bfhi(ov[e]) * silu(bfhi(gv[e])));
            *(u32x4*)(MIX + (mq0 + 32 * w + row) * 1024 + 512 + 64 * h + 8 * part) = wv; }
    }
    __syncthreads();
#undef MOBA_LOADKV
#undef MOBA_STEP
}

DI void sb_item(const Args& a, LAS unsigned char* slab, int item, int lane) {
    unsigned char* ws = a.ws;
    const bf16* PROJ = (const bf16*)(ws + WS_PROJ); const bf16* VT = (const bf16*)(ws + WS_VT); const bf16* KF = (const bf16*)(ws + WS_KF); bf16* MIX = (bf16*)(ws + WS_MIX);
    const int qt = 255 - (item >> 5), bh = item & 31, b = bh >> 3, h = bh & 7;
    const int hh = lane >> 5, l31 = lane & 31;
    const size_t mq = (size_t)b * T + 32 * qt + l31;
    bf16x8 bq[4];
#pragma unroll
    for (int s = 0; s < 4; ++s) bq[s] = mk8(*(const u32x4*)(PROJ + mq * NP + 64 * h + 16 * s + 8 * hh));
    f32x16 o0 = zero16(), o1 = zero16();
    float carry = 0.f;
    const size_t kfb = (size_t)(b * 8 + h) * 256 * 2048 + lane * 8;
#define SB_LOADKV(AK, AV, kt_) do { const size_t kb_ = kfb + (size_t)(kt_) * 2048; \
    _Pragma("unroll") for (int s = 0; s < 4; ++s) AK[s] = mk8(*(const u32x4*)(KF + kb_ + s * 512)); \
    _Pragma("unroll") for (int dt = 0; dt < 2; ++dt) _Pragma("unroll") for (int s = 0; s < 2; ++s) AV[dt][s] = mk8(*(const u32x4*)(VT + kb_ + (dt * 2 + s) * 512)); } while (0)
    bf16x8 ak[4], av[2][2], akn[4], avn[2][2];
    SB_LOADKV(ak, av, qt);
#pragma unroll 1
    for (int kt = qt; kt >= 0; --kt) {
        SB_LOADKV(akn, avn, (kt > 0 ? kt - 1 : 0));
        f32x16 z = zero16();
#pragma unroll
        for (int s = 0; s < 4; ++s) z = MFMA32(ak[s], bq[s], z);
        float kp[16], bt[16];
        if (kt == qt) {
#pragma unroll
            for (int i = 0; i < 16; ++i) { const float zz = __builtin_amdgcn_fmed3f(z[i] * 0.125f, -80.f, 80.f); const bool strict = crow(i, hh) < l31;
                const float t = __expf(-zz), r = __builtin_amdgcn_rcpf(1.f + t);
                kp[i] = strict ? t * r : 1.f; bt[i] = strict ? r : 0.f; }
        } else {
#pragma unroll
            for (int i = 0; i < 16; ++i) { const float zz = __builtin_amdgcn_fmed3f(z[i] * 0.125f, -80.f, 80.f);
                const float t = __expf(-zz), r = __builtin_amdgcn_rcpf(1.f + t);
                kp[i] = t * r; bt[i] = r; }
        }
        float gs[4], go[4];
#pragma unroll
        for (int k = 0; k < 4; ++k) { gs[k] = (kp[4 * k] * kp[4 * k + 1]) * (kp[4 * k + 2] * kp[4 * k + 3]); go[k] = __shfl_xor(gs[k], 32); }
        float after[4]; float run = 1.f;
#pragma unroll
        for (int k = 3; k >= 0; --k) { after[k] = hh ? run : run * go[k]; run *= gs[k] * go[k]; }
        const float base = __expf(carry);
        float wv[16];
#pragma unroll
        for (int k = 0; k < 4; ++k) { float suf = base * after[k];
#pragma unroll
            for (int e = 3; e >= 0; --e) { wv[4 * k + e] = bt[4 * k + e] * suf; suf *= kp[4 * k + e]; } }
        carry += __logf(run);
        const bf16x8 p0 = pack8(wv[0], wv[1], wv[2], wv[3], wv[4], wv[5], wv[6], wv[7]);
        const bf16x8 p1 = pack8(wv[8], wv[9], wv[10], wv[11], wv[12], wv[13], wv[14], wv[15]);
        o0 = MFMA32(av[0][0], p0, o0); o0 = MFMA32(av[0][1], p1, o0);
        o1 = MFMA32(av[1][0], p0, o1); o1 = MFMA32(av[1][1], p1, o1);
        if (__all(carry < -104.f)) break;
#pragma unroll
        for (int s = 0; s < 4; ++s) ak[s] = akn[s];
#pragma unroll
        for (int dt = 0; dt < 2; ++dt) { av[dt][0] = avn[dt][0]; av[dt][1] = avn[dt][1]; }
    }
#undef SB_LOADKV
    {
        LAS bf16* sl = (LAS bf16*)slab;
#pragma unroll
        for (int dt = 0; dt < 2; ++dt)
#pragma unroll
            for (int k = 0; k < 4; ++k) { const f32x16& o = dt ? o1 : o0; u32x2 w; w.x = pk2(o[4 * k], o[4 * k + 1]); w.y = pk2(o[4 * k + 2], o[4 * k + 3]);
                *(LAS u32x2*)(sl + l31 * 72 + 32 * dt + 8 * k + 4 * hh) = w; }
        const size_t mb = (size_t)b * T + 32 * qt;
#pragma unroll
        for (int i = 0; i < 4; ++i) { const int c = lane + 64 * i, row = c >> 3, part = c & 7;
            const u32x4 ov = *(const LAS u32x4*)(sl + row * 72 + 8 * part); const u32x4 gv = *(const u32x4*)(PROJ + (mb + row) * NP + 1536 + 64 * h + 8 * part);
            u32x4 w;
#pragma unroll
            for (int e = 0; e < 4; ++e) w[e] = pk2(bflo(ov[e]) * silu(bflo(gv[e])), bfhi(ov[e]) * silu(bfhi(gv[e])));
            *(u32x4*)(MIX + (mb + row) * 1024 + 64 * h + 8 * part) = w; }
    }
}

DI void s5_pass1(const Args& a, LAS unsigned char* lds, int item, int tid, int lane, int wave) {
    unsigned char* ws = a.ws;
    const bf16* PROJ = (const bf16*)(ws + WS_PROJ); float* S5S = (float*)(ws + WS_S5S);
    const int g = item & 31, b = (item >> 5) & 3, ct = item >> 7;
    const int rt = wave & 3, kh = wave >> 2, hh = lane >> 5, l31 = lane & 31;
    constexpr int UP = 2064;
    LAS unsigned char* UL = lds + 16384;
#pragma unroll
    for (int i = 0; i < 8; ++i) { const int idx = tid + 512 * i, tok = idx >> 1, hf = idx & 1;
        const u32x4 v = *(const u32x4*)(PROJ + ((size_t)b * T + 2048 * ct + tok) * NP + 2048 + 16 * g + 8 * hf);
        *(LAS u32x4*)(UL + (tok >> 6) * UP + (tok & 63) * 32 + 16 * hf) = v; }
    __syncthreads();
    const unsigned char* vb = ws + WS_VBIG + ((size_t)((g * 4 + rt) * 64) * 64 + lane) * 16;
    f32x16 acc = zero16();
#pragma unroll 4
    for (int s = 32 * kh; s < 32 * kh + 32; ++s) { const bf16x8 A = mk8(*(const u32x4*)(vb + (size_t)s * 1024)); const bf16x8 Bf = *(const LAS bf16x8*)(UL + l31 * UP + s * 32 + 16 * hh); acc = MFMA32(A, Bf, acc); }
    LAS float* red = (LAS float*)lds;
    if (kh == 1) {
#pragma unroll
        for (int i = 0; i < 16; ++i) red[(rt * 16 + i) * 64 + lane] = acc[i]; }
    __syncthreads();
    if (kh == 0) {
        float* dst = S5S + ((size_t)((b * 32 + g) * 128 + 32 * ct + l31)) * 128 + 32 * rt;
#pragma unroll
        for (int k = 0; k < 4; ++k) { f32x4 o;
#pragma unroll
            for (int e = 0; e < 4; ++e) o[e] = acc[4 * k + e] + red[(rt * 16 + 4 * k + e) * 64 + lane];
            *(f32x4*)(dst + 8 * k + 4 * hh) = o; } }
    __syncthreads();
}
DI void s5_pass2(const Args& a, LAS unsigned char* lds, int item, int tid, int lane, int wave) {
    unsigned char* ws = a.ws;
    const bf16* PROJ = (const bf16*)(ws + WS_PROJ); const float* S5S = (const float*)(ws + WS_S5S); bf16* S5Y = (bf16*)(ws + WS_H);
    const int g = item & 31, b = (item >> 5) & 3, ct = item >> 7;
    constexpr int UP = 2064, XPP = 136;
    LAS unsigned char* FL = lds;
    LAS unsigned char* UL = lds + 65536;
    LAS bf16* XPl = (LAS bf16*)(lds + 65536 + 66048);
    {   const unsigned char* fsrc = ws + WS_F + (size_t)g * 65536;
#pragma unroll
        for (int i = 0; i < 8; ++i) { const int idx = tid + 512 * i; *(LAS u32x4*)(FL + idx * 16) = *(const u32x4*)(fsrc + (size_t)idx * 16); }
#pragma unroll
        for (int i = 0; i < 8; ++i) { const int idx = tid + 512 * i, tok = idx >> 1, half = idx & 1;
            const u32x4 v = *(const u32x4*)(PROJ + ((size_t)b * T + 2048 * ct + tok) * NP + 2048 + 16 * g + 8 * half);
            *(LAS u32x4*)(UL + (tok >> 6) * UP + (tok & 63) * 32 + 16 * half) = v; } }
    {
        const int p = lane; const float ar = ((const float*)(ws + WS_ABL))[(g * 64 + p) * 2], ai = ((const float*)(ws + WS_ABL))[(g * 64 + p) * 2 + 1];
        const float* Sp = S5S + (size_t)((b * 32 + g) * 128) * 128;
        LAS float* SEG = (LAS float*)(lds + 65536 + 66048 + 8704);
        const int seg = 4 * ct;
        {   float xr = 0.f, xi = 0.f, qr = 1.f, qi = 0.f;
            for (int c = wave * seg; c < (wave + 1) * seg; ++c) { const float sr = Sp[c * 128 + p], si = Sp[c * 128 + 64 + p];
                const float nr = ar * xr - ai * xi + sr, ni = ar * xi + ai * xr + si; xr = nr; xi = ni; const float tr = qr * ar - qi * ai, ti = qr * ai + qi * ar; qr = tr; qi = ti; }
            SEG[(wave * 4 + 0) * 64 + p] = xr; SEG[(wave * 4 + 1) * 64 + p] = xi; SEG[(wave * 4 + 2) * 64 + p] = qr; SEG[(wave * 4 + 3) * 64 + p] = qi; }
        __syncthreads();
        if (wave == 0) {
            float xr = 0.f, xi = 0.f;
#pragma unroll
            for (int w = 0; w < 8; ++w) { const float sr = SEG[(w * 4 + 0) * 64 + p], si = SEG[(w * 4 + 1) * 64 + p], qr = SEG[(w * 4 + 2) * 64 + p], qi = SEG[(w * 4 + 3) * 64 + p];
                const float nr = qr * xr - qi * xi + sr, ni = qr * xi + qi * xr + si; xr = nr; xi = ni; }
#pragma unroll 8
            for (int n = 0; n < 32; ++n) { XPl[n * XPP + p] = (bf16)f2bf(xr); XPl[n * XPP + 64 + p] = (bf16)f2bf(xi);
                const int c = 32 * ct + n; const float sr = Sp[c * 128 + p], si = Sp[c * 128 + 64 + p]; const float nr = ar * xr - ai * xi + sr, ni = ar * xi + ai * xr + si; xr = nr; xi = ni; }
        }
    }
    __syncthreads();
    const int hh = lane >> 5, l31 = lane & 31;
    f32x16 acc[4];
#pragma unroll
    for (int i = 0; i < 4; ++i) acc[i] = zero16();
#define S5_SEG(I0, SLO, SHI) do { _Pragma("unroll 2") for (int s = (SLO); s <= (SHI); ++s) { \
        const bf16x8 Bf = *(const LAS bf16x8*)(UL + l31 * UP + s * 32 + 16 * hh); bf16x8 Af[4]; \
        _Pragma("unroll") for (int i = (I0); i < 4; ++i) Af[i] = *(const LAS bf16x8*)(FL + (2 * (wave + 8 * i) - s + 1) * 1024 + lane * 16); \
        _Pragma("unroll") for (int i = (I0); i < 4; ++i) acc[i] = MFMA32(Af[i], Bf, acc[i]); } } while (0)
    S5_SEG(0, 0, 2 * wave + 1);
    S5_SEG(1, 2 * wave + 2, 2 * wave + 17);
    S5_SEG(2, 2 * wave + 18, 2 * wave + 33);
    S5_SEG(3, 2 * wave + 34, 2 * wave + 49);
#undef S5_SEG
#pragma unroll
    for (int ks = 0; ks < 8; ++ks) { const bf16x8 Bf = *(const LAS bf16x8*)(XPl + l31 * XPP + 16 * ks + 8 * hh);
#pragma unroll
        for (int i = 0; i < 4; ++i) { const int R = wave + 8 * i;
            const bf16x8 A = mk8(*(const u32x4*)(ws + WS_WBIG + ((size_t)((g * 32 + R) * 8 + ks) * 64 + lane) * 16)); acc[i] = MFMA32(A, Bf, acc[i]); } }
#pragma unroll
    for (int i = 0; i < 4; ++i) { const int R = wave + 8 * i;
#pragma unroll
        for (int k = 0; k < 4; ++k) { const int jj = k >> 1; const size_t tok = (size_t)b * T + 2048 * ct + 64 * l31 + 2 * R + jj;
            u32x2 w; w.x = pk2(acc[i][4 * k], acc[i][4 * k + 1]); w.y = pk2(acc[i][4 * k + 2], acc[i][4 * k + 3]);
            *(u32x2*)(S5Y + tok * 512 + 16 * g + 8 * (k & 1) + 4 * hh) = w; } }
    __syncthreads();
}

__global__ void __launch_bounds__(NTHR, 2) hybrid_fwd(Args a) {
    extern __shared__ __attribute__((aligned(16))) unsigned char lds_raw[];
    LAS unsigned char* lds = (LAS unsigned char*)lds_raw;
    cg::grid_group grid = cg::this_grid();
    const int tid = threadIdx.x, lane = tid & 63, wave = __builtin_amdgcn_readfirstlane(tid >> 6);
    const int bx = blockIdx.x, G = gridDim.x, gw = bx * NWAVES + wave, NGW = G * NWAVES;
    unsigned char* ws = a.ws;
    const float* MOD = (const float*)(ws + WS_MOD);
    bf16* H = (bf16*)(ws + WS_H); bf16* PROJ = (bf16*)(ws + WS_PROJ); bf16* MIX = (bf16*)(ws + WS_MIX);

    if (tid < 4) ((LAS unsigned*)(lds + LDS_BYTES - 16))[tid] = 0u;
    __syncthreads();
    XcdBarrier xbar = xcd_barrier_post((unsigned*)ws, (volatile LAS unsigned*)(lds + LDS_BYTES - 16));
    phase0(a, lds, tid, lane, wave);
    xcd_barrier(xbar);
    norm_rows(a.in[0], a.in[2], MOD, H, gw, NGW, lane);
    __syncthreads();
    s5_tables(a, lds, bx * NTHR + tid, G * NTHR);
    {
        const bf16* WT = (const bf16*)(ws + WS_WIN1); float* SHW = (float*)(ws + WS_SHW);
        for (int col = gw; col < NP; col += NGW) {
            const u32x4 w0 = *(const u32x4*)(WT + (size_t)col * D + 16 * lane), w1 = *(const u32x4*)(WT + (size_t)col * D + 16 * lane + 8);
            float wf[16];
#pragma unroll
            for (int e = 0; e < 4; ++e) { wf[2 * e] = bflo(w0[e]); wf[2 * e + 1] = bfhi(w0[e]); wf[8 + 2 * e] = bflo(w1[e]); wf[8 + 2 * e + 1] = bfhi(w1[e]); }
#pragma unroll
            for (int b = 0; b < 4; ++b) { const float* sh = MOD + (4 + b) * 3072 + 16 * lane; float s = 0.f;
#pragma unroll
                for (int e = 0; e < 16; ++e) s += sh[e] * wf[e];
                s = wave_sum(s); if (lane == 0) SHW[b * 3072 + col] = s; } } }
    xcd_barrier(xbar);
    {   pg8::Gemm g{H, (const bf16*)(ws + WS_WIN0), M, NP, D}; pg8::StaticOrder S; S.init(M, NP, G, bx); pg8::EpiStore E{PROJ, NP};
        pg8::gemm_phase<pg8::EpiStore, pg8::StaticOrder, true, true>(lds, g, S, E); }
    xcd_barrier(xbar);
    for (int it = bx; it < 1024; it += G) prep_item<0>(a, lds, it, tid);
    for (int it = bx; it < 512; it += G) lru_item<1>(a, lds, it, tid, lane, wave);
    {
        const bf16* WT = (const bf16*)(ws + WS_WIN1); bf16* W1S = (bf16*)(ws + WS_W1S); const float* gain = a.in[16];
        for (int c = bx * NTHR + tid; c < 4 * 3072 * 128; c += G * NTHR) { const int b = c / (3072 * 128), rem = c % (3072 * 128), k8 = (rem & 127) * 8;
            const u32x4 wv = *(const u32x4*)(WT + (size_t)rem * 8); const float* sc = MOD + (4 + b) * 3072 + 1024 + k8; u32x4 o;
#pragma unroll
            for (int e = 0; e < 4; ++e) o[e] = pk2(bflo(wv[e]) * gain[k8 + 2 * e] * (1.f + sc[2 * e]), bfhi(wv[e]) * gain[k8 + 2 * e + 1] * (1.f + sc[2 * e + 1]));
            *(u32x4*)(W1S + (size_t)c * 8) = o; } }
    xcd_barrier(xbar);
    if (G == 256) {
        const int xcd = bx & 7, j = bx >> 3;
#pragma unroll 1
        for (int r = 0; r < 4; ++r) { const int bh = 4 * xcd + r, m = (r & 1) ? 31 - j : j; moba_item(a, lds, m * 32 + bh, tid, lane, wave); }
    } else {
#pragma unroll 1
        for (int it = bx; it < 1024; it += G) moba_item(a, lds, 1023 - it, tid, lane, wave);
    }
    for (int it = bx; it < 512; it += G) lru_item<2>(a, lds, it, tid, lane, wave);
    xcd_barrier(xbar);
    {   pg8::Gemm g{MIX, (const bf16*)(ws + WS_WOUT0), M, D, D}; pg8::StaticOrder S; S.init(M, D, G, bx);
        pg8::EpiRes1 E{a.in[0], MOD + 2048, (bf16*)(ws + WS_X1B), (float*)(ws + WS_SS)};
        pg8::gemm_phase<pg8::EpiRes1, pg8::StaticOrder, true, true>(lds, g, S, E); }
    xcd_barrier(xbar);
    {   pg8::Gemm g{(const bf16*)(ws + WS_X1B), (const bf16*)(ws + WS_W1S), M, NP, D, (size_t)3072 * 1024 * 2}; pg8::StaticOrder S; S.init(M, NP, G, bx); pg8::EpiStoreN E{PROJ, NP, (const float*)(ws + WS_SS), (const float*)(ws + WS_SHW)};
        pg8::gemm_phase<pg8::EpiStoreN, pg8::StaticOrder, true, true>(lds, g, S, E); }
    xcd_barrier(xbar);
    for (int it = bx; it < 1024; it += G) prep_item<1>(a, lds, it, tid);
    for (int it = bx; it < 512; it += G) s5_pass1(a, lds, it, tid, lane, wave);
    xcd_barrier(xbar);
    for (int it = bx; it < 512; it += G) s5_pass2(a, lds, it, tid, lane, wave);
    if (G == 256) {
#pragma unroll 1
        for (int k = 0; k < 4; ++k) { const int bh = (bx & 7) + 8 * k, qi = 8 * (bx >> 3) + wave; sb_item(a, lds + wave * 4608, (qi << 5) | bh, lane); }
    } else {
        for (int it = gw; it < 8192; it += NGW) sb_item(a, lds + wave * 4608, it, lane);
    }
    xcd_barrier(xbar);
    {   pg8::Gemm g{H, (const bf16*)(ws + WS_WGLU), M, 1024, 512}; pg8::StaticOrder S; S.init(M, 1024, G, bx); pg8::EpiGlu E{a.in[31], PROJ, MIX};
        pg8::gemm_phase<pg8::EpiGlu, pg8::StaticOrder, true, true>(lds, g, S, E); }
    xcd_barrier(xbar);
    {   pg8::Gemm g{MIX, (const bf16*)(ws + WS_WOUT1), M, D, D}; pg8::StaticOrder S; S.init(M, D, G, bx); pg8::EpiRes2 E{(const bf16*)(ws + WS_X1B), a.out, MOD + 4 * 3072 + 2048};
        pg8::gemm_phase<pg8::EpiRes2, pg8::StaticOrder, true, true>(lds, g, S, E); }
    if (gridDim.y == 0x7fffu) grid.sync();
}

extern "C" void kernel_launch(void* const* d_in, const int* in_sizes, int n_in, void* d_out, int out_size, void* d_ws, size_t ws_size, hipStream_t stream) {
    static int grid = 0;
    if (grid == 0) {
        if (n_in != 33 || out_size != M * D || ws_size < WS_END) { fprintf(stderr, "kernel_launch: unexpected shapes (n_in %d out %d ws %zu)\n", n_in, out_size, ws_size); grid = -1; return; }
        int dev = 0, cus = 0, per_cu = 0;
        hipGetDevice(&dev); hipDeviceGetAttribute(&cus, hipDeviceAttributeMultiprocessorCount, dev);
        hipFuncSetAttribute((const void*)hybrid_fwd, hipFuncAttributeMaxDynamicSharedMemorySize, LDS_BYTES);
        hipOccupancyMaxActiveBlocksPerMultiprocessor(&per_cu, (const void*)hybrid_fwd, NTHR, LDS_BYTES);
        if (per_cu < 1) per_cu = 1;
        grid = cus * per_cu; if (grid > 256) grid = 256;
        (void)hipGetLastError();
    }
    if (grid < 0) return;
    if (hipMemsetAsync(d_ws, 0, 262144, stream) != hipSuccess) { fprintf(stderr, "kernel_launch: memset failed\n"); return; }
    Args a{};
    for (int i = 0; i < 33; ++i) a.in[i] = (const float*)d_in[i];
    a.out = (float*)d_out; a.ws = (unsigned char*)d_ws;
    void* args[] = {&a};
    hipError_t e = hipLaunchCooperativeKernel((const void*)hybrid_fwd, dim3(grid), dim3(NTHR), args, LDS_BYTES, stream);
    if (e != hipSuccess) fprintf(stderr, "cooperative launch failed: %s (grid %d)\n", hipGetErrorString(e), grid);
}
```

```cpp
#include <hip/hip_runtime.h>
#include <hip/hip_cooperative_groups.h>
#include <cstdio>
#include <cstdint>
namespace cg = cooperative_groups;
namespace pg8 {
#define PG8_LAS __attribute__((address_space(3)))
typedef unsigned short bf16_t;
typedef short bf16x8 __attribute__((ext_vector_type(8)));
typedef float f32x4 __attribute__((ext_vector_type(4)));
typedef unsigned u32x4 __attribute__((ext_vector_type(4)));
constexpr int BM = 256, BK = 64, HALF = 128, HTB = HALF * BK * 2  , STAGE_BYTES = 8 * HTB, NXCD = 8, WGM = 8;

__host__ __device__ __forceinline__ int lds_byte(int r, int c) { const int st = (r >> 4) * 2 + (c >> 5), rr = r & 15, cc = c & 31, ob = rr * 64 + cc * 2; return st * 1024 + (ob ^ (((ob >> 9) & 1) << 5)); }
__host__ __device__ __forceinline__ void stage_rc(int b, int& R, int& C) { const int st = b / 1024, sb = b % 1024, swz = sb ^ (((sb >> 9) & 1) << 5); R = (st >> 1) * 16 + swz / 64; C = (st & 1) * 32 + (swz % 64) / 2; }
__host__ __device__ __forceinline__ int perm32(int rho) { const int n = rho >> 4, i = rho & 15; return 8 * (i >> 2) + 4 * n + (i & 3); }

struct Unit { int pm, pn; };
struct Gemm { const bf16_t* A; const bf16_t* Bt; int M, N, K; size_t bstride; };

struct StaticOrder {
    int nM, nN, nwg, G, c;
    __host__ __device__ void init(int M, int N, int G_, int c_) { nM = M / BM; nN = N / BM; nwg = nM * nN; G = G_; c = c_; }
    __host__ __device__ bool next(int i, Unit& u) const {
        const long L = (long)i * G + c; if (L >= nwg) return false;
        int wgid = (int)L; { const int q = nwg / NXCD, r = nwg % NXCD, xcd = wgid % NXCD, off = wgid / NXCD; wgid = (xcd < r ? xcd * (q + 1) : r * (q + 1) + (xcd - r) * q) + off; }
        const int nig = WGM * nN, gid = wgid / nig, fm = gid * WGM, gsz = (nM - fm) < WGM ? (nM - fm) : WGM;
        u.pm = fm + ((wgid % nig) % gsz); u.pn = (wgid % nig) / gsz; return true;
    }
    __device__ __forceinline__ void a_ready(const Unit&) const {}
    __device__ __forceinline__ void done(const Unit&) const {}
};

typedef __bf16 hwbf2 __attribute__((ext_vector_type(2)));
typedef float f32x2p __attribute__((ext_vector_type(2)));
__device__ __forceinline__ unsigned pk2f(float lo, float hi) { f32x2p v; v.x = lo; v.y = hi; return __builtin_bit_cast(unsigned, __builtin_convertvector(v, hwbf2)); }
__device__ __forceinline__ float bflo(unsigned w) { return __builtin_bit_cast(float, w << 16); }
__device__ __forceinline__ float bfhi(unsigned w) { return __builtin_bit_cast(float, w & 0xffff0000u); }
struct EpiStore {
    static constexpr bool PERM = true, AFTER_DRAIN = false;
    bf16_t* O; int ldc;
    __device__ __forceinline__ void operator()(const f32x4 (&acc)[2][2][4][2], const Unit& u, int wr, int wc, int fr, int fq) const {
        const int row0 = u.pm * BM + wr * 64 + fr, col0 = u.pn * BM + wc * 32 + 8 * fq;
#pragma unroll
        for (int ai = 0; ai < 2; ++ai)
#pragma unroll
            for (int m = 0; m < 4; ++m) { bf16_t* rowp = O + (size_t)(row0 + ai * HALF + m * 16) * ldc + col0;
#pragma unroll
                for (int bj = 0; bj < 2; ++bj) { const f32x4 v0 = acc[ai][bj][m][0], v1 = acc[ai][bj][m][1];
                    u32x4 w; w.x = pk2f(v0[0], v0[1]); w.y = pk2f(v0[2], v0[3]); w.z = pk2f(v1[0], v1[1]); w.w = pk2f(v1[2], v1[3]);
                    *(u32x4*)(rowp + bj * HALF) = w; } }
    }
};
struct EpiRes {
    static constexpr bool PERM = false, AFTER_DRAIN = false;
    const float* X; float* O; const float* gate;
    __device__ __forceinline__ void operator()(const f32x4 (&acc)[2][2][4][2], const Unit& u, int wr, int wc, int fr, int fq) const {
        const int row0 = u.pm * BM + wr * 64 + fr, col0 = u.pn * BM + wc * 32 + 4 * fq, b = (u.pm * BM) >> 13;
        f32x4 gv[2][2];
#pragma unroll
        for (int bj = 0; bj < 2; ++bj)
#pragma unroll
            for (int n = 0; n < 2; ++n) gv[bj][n] = *(const f32x4*)(gate + b * 3072 + col0 + bj * HALF + n * 16);
#pragma unroll
        for (int ai = 0; ai < 2; ++ai)
#pragma unroll
            for (int m = 0; m < 4; ++m) { const size_t ro = (size_t)(row0 + ai * HALF + m * 16) * 1024 + col0;
#pragma unroll
                for (int bj = 0; bj < 2; ++bj)
#pragma unroll
                    for (int n = 0; n < 2; ++n) { const size_t idx = ro + bj * HALF + n * 16; const f32x4 xv = *(const f32x4*)(X + idx); *(f32x4*)(O + idx) = xv + gv[bj][n] * acc[ai][bj][m][n]; } }
    }
};
struct EpiRes1 {
    static constexpr bool PERM = true, AFTER_DRAIN = false;
    const float* X; const float* gate; bf16_t* X1B; float* SS;
    __device__ __forceinline__ void operator()(const f32x4 (&acc)[2][2][4][2], const Unit& u, int wr, int wc, int fr, int fq) const {
        const int row0 = u.pm * BM + wr * 64 + fr, col0 = u.pn * BM + wc * 32 + 8 * fq, b = (u.pm * BM) >> 13;
        f32x4 gv[2][2];
#pragma unroll
        for (int bj = 0; bj < 2; ++bj)
#pragma unroll
            for (int n = 0; n < 2; ++n) gv[bj][n] = *(const f32x4*)(gate + b * 3072 + col0 + bj * HALF + n * 4);
#pragma unroll
        for (int ai = 0; ai < 2; ++ai)
#pragma unroll
        for (int mh = 0; mh < 2; ++mh) {
            f32x4 xv[2][2][2];
#pragma unroll
            for (int mm = 0; mm < 2; ++mm)
#pragma unroll
                for (int bj = 0; bj < 2; ++bj) { const size_t idx = (size_t)(row0 + ai * HALF + (2 * mh + mm) * 16) * 1024 + col0 + bj * HALF; xv[mm][bj][0] = __builtin_nontemporal_load((const f32x4*)(X + idx)); xv[mm][bj][1] = __builtin_nontemporal_load((const f32x4*)(X + idx + 4)); }
#pragma unroll
            for (int mm = 0; mm < 2; ++mm) { const int m = 2 * mh + mm; const int row = row0 + ai * HALF + m * 16; const size_t ro = (size_t)row * 1024 + col0; float s = 0.f;
#pragma unroll
                for (int bj = 0; bj < 2; ++bj) { const size_t idx = ro + bj * HALF;
                    const f32x4 y0 = xv[mm][bj][0] + gv[bj][0] * acc[ai][bj][m][0], y1 = xv[mm][bj][1] + gv[bj][1] * acc[ai][bj][m][1];
                    s += ((y0[0] * y0[0] + y0[1] * y0[1]) + (y0[2] * y0[2] + y0[3] * y0[3])) + ((y1[0] * y1[0] + y1[1] * y1[1]) + (y1[2] * y1[2] + y1[3] * y1[3]));
                    u32x4 w; w.x = pk2f(y0[0], y0[1]); w.y = pk2f(y0[2], y0[3]); w.z = pk2f(y1[0], y1[1]); w.w = pk2f(y1[2], y1[3]); *(u32x4*)(X1B + idx) = w; }
                s += __shfl_xor(s, 16); s += __shfl_xor(s, 32);
                if (fq == 0) __hip_atomic_fetch_add(SS + row, s, __ATOMIC_RELAXED, __HIP_MEMORY_SCOPE_AGENT); }
        }
    }
};
struct EpiRes2 {
    static constexpr bool PERM = true, AFTER_DRAIN = false;
    const bf16_t* X1B; float* O; const float* gate;
    __device__ __forceinline__ void operator()(const f32x4 (&acc)[2][2][4][2], const Unit& u, int wr, int wc, int fr, int fq) const {
        const int row0 = u.pm * BM + wr * 64 + fr, col0 = u.pn * BM + wc * 32 + 8 * fq, b = (u.pm * BM) >> 13;
        f32x4 gv[2][2];
#pragma unroll
        for (int bj = 0; bj < 2; ++bj)
#pragma unroll
            for (int n = 0; n < 2; ++n) gv[bj][n] = *(const f32x4*)(gate + b * 3072 + col0 + bj * HALF + n * 4);
#pragma unroll
        for (int ai = 0; ai < 2; ++ai) {
            u32x4 xw[4][2];
#pragma unroll
            for (int m = 0; m < 4; ++m)
#pragma unroll
                for (int bj = 0; bj < 2; ++bj) xw[m][bj] = *(const u32x4*)(X1B + (size_t)(row0 + ai * HALF + m * 16) * 1024 + col0 + bj * HALF);
#pragma unroll
            for (int m = 0; m < 4; ++m) { const size_t ro = (size_t)(row0 + ai * HALF + m * 16) * 1024 + col0;
#pragma unroll
                for (int bj = 0; bj < 2; ++bj) { const size_t idx = ro + bj * HALF; const u32x4 q = xw[m][bj];
                    f32x4 x0, x1; x0[0] = bflo(q.x); x0[1] = bfhi(q.x); x0[2] = bflo(q.y); x0[3] = bfhi(q.y); x1[0] = bflo(q.z); x1[1] = bfhi(q.z); x1[2] = bflo(q.w); x1[3] = bfhi(q.w);
                    *(f32x4*)(O + idx) = x0 + gv[bj][0] * acc[ai][bj][m][0]; *(f32x4*)(O + idx + 4) = x1 + gv[bj][1] * acc[ai][bj][m][1]; } }
        }
    }
};
struct EpiStoreN {
    static constexpr bool PERM = true, AFTER_DRAIN = false;
    bf16_t* O; int ldc; const float* SS; const float* shw;
    __device__ __forceinline__ void operator()(const f32x4 (&acc)[2][2][4][2], const Unit& u, int wr, int wc, int fr, int fq) const {
        const int row0 = u.pm * BM + wr * 64 + fr, col0 = u.pn * BM + wc * 32 + 8 * fq, b = (u.pm * BM) >> 13;
        f32x4 sw[2][2];
#pragma unroll
        for (int bj = 0; bj < 2; ++bj) { sw[bj][0] = *(const f32x4*)(shw + b * 3072 + col0 + bj * HALF); sw[bj][1] = *(const f32x4*)(shw + b * 3072 + col0 + bj * HALF + 4); }
        float ssv[2][4];
#pragma unroll
        for (int ai = 0; ai < 2; ++ai)
#pragma unroll
            for (int m = 0; m < 4; ++m) ssv[ai][m] = SS[row0 + ai * HALF + m * 16];
#pragma unroll
        for (int ai = 0; ai < 2; ++ai)
#pragma unroll
            for (int m = 0; m < 4; ++m) { const int row = row0 + ai * HALF + m * 16; bf16_t* rowp = O + (size_t)row * ldc + col0;
                const float rstd = __builtin_amdgcn_rsqf(ssv[ai][m] * (1.f / 1024.f) + 1e-6f);
#pragma unroll
                for (int bj = 0; bj < 2; ++bj) { const f32x4 v0 = acc[ai][bj][m][0] * rstd + sw[bj][0], v1 = acc[ai][bj][m][1] * rstd + sw[bj][1];
                    u32x4 w; w.x = pk2f(v0[0], v0[1]); w.y = pk2f(v0[2], v0[3]); w.z = pk2f(v1[0], v1[1]); w.w = pk2f(v1[2], v1[3]);
                    *(u32x4*)(rowp + bj * HALF) = w; } }
    }
};
struct EpiGlu {
    static constexpr bool PERM = true, AFTER_DRAIN = false;
    const float* bias; const bf16_t* proj; bf16_t* mix;
    __device__ __forceinline__ void operator()(const f32x4 (&acc)[2][2][4][2], const Unit& u, int wr, int wc, int fr, int fq) const {
        const int row0 = u.pm * BM + wr * 64 + fr, colv = u.pn * 128 + wc * 32 + 8 * fq;
        const f32x4 bv0 = *(const f32x4*)(bias + colv), bv1 = *(const f32x4*)(bias + colv + 4), bg0 = *(const f32x4*)(bias + 512 + colv), bg1 = *(const f32x4*)(bias + 512 + colv + 4);
        u32x4 gsv[2][4];
#pragma unroll
        for (int ai = 0; ai < 2; ++ai)
#pragma unroll
            for (int m = 0; m < 4; ++m) gsv[ai][m] = *(const u32x4*)(proj + (size_t)(row0 + ai * HALF + m * 16) * 3072 + 2560 + colv);
#pragma unroll
        for (int ai = 0; ai < 2; ++ai)
#pragma unroll
            for (int m = 0; m < 4; ++m) { const size_t row = (size_t)(row0 + ai * HALF + m * 16);
                const u32x4 gs = gsv[ai][m];
                const f32x4 va = acc[ai][0][m][0] + bv0, vb = acc[ai][0][m][1] + bv1, ga = acc[ai][1][m][0] + bg0, gb = acc[ai][1][m][1] + bg1;
                float y[8];
#pragma unroll
                for (int e = 0; e < 4; ++e) { const float g0 = (e & 1) ? bfhi(gs[e >> 1]) : bflo(gs[e >> 1]); const float g1 = (e & 1) ? bfhi(gs[2 + (e >> 1)]) : bflo(gs[2 + (e >> 1)]);
                    y[e] = va[e] * __builtin_amdgcn_rcpf(1.f + __expf(-ga[e])) * (g0 * __builtin_amdgcn_rcpf(1.f + __expf(-g0))); y[4 + e] = vb[e] * __builtin_amdgcn_rcpf(1.f + __expf(-gb[e])) * (g1 * __builtin_amdgcn_rcpf(1.f + __expf(-g1))); }
                u32x4 w; w.x = pk2f(y[0], y[1]); w.y = pk2f(y[2], y[3]); w.z = pk2f(y[4], y[5]); w.w = pk2f(y[6], y[7]);
                *(u32x4*)(mix + row * 1024 + 512 + colv) = w; }
    }
};
template <class Epi, class Sched, bool ALIGN_EPI = false, bool SP2 = false>
__device__ __forceinline__ void gemm_phase(PG8_LAS unsigned char* lds, const Gemm g, const Sched& S, const Epi& E) {
    int tid_ = threadIdx.x; asm volatile("" : "+v"(tid_));
    const int tid = tid_, wid = __builtin_amdgcn_readfirstlane(tid >> 6), lane = tid & 63, wr = wid >> 2, wc = wid & 3, fr = lane & 15, fq = lane >> 4;
    const int K = g.K, nt = K / BK;
    unsigned voffA[2], voffB[2];
#pragma unroll
    for (int i = 0; i < 2; ++i) { int R, C; stage_rc(tid * 16 + i * 8192, R, C); const int Rb = Epi::PERM ? ((R & ~31) + perm32(R & 31)) : R;
        voffA[i] = (unsigned)(R * K + C) * 2u; voffB[i] = (unsigned)(Rb * K + C) * 2u; }
    const size_t kstep = (size_t)(BK * 2);
    const size_t hstep = (size_t)HALF * K * 2;
    const size_t tstep = 2 * hstep;
    const unsigned ldsw = (unsigned)wid * 1024u;
    const int aoff = lds_byte(wr * 64 + fr, fq * 8), boff = lds_byte(wc * 32 + fr, fq * 8);
#define PG8_SA(b, h) (((b) * 2 + (h)) * HTB)
#define PG8_SB(b, h) ((4 + (b) * 2 + (h)) * HTB)
#define PG8_STAGE(bufoff, gbase, voff) do { _Pragma("unroll") for (int _i = 0; _i < 2; ++_i) \
        __builtin_amdgcn_global_load_lds((const unsigned*)((const char*)(gbase) + (voff)[_i]), (PG8_LAS unsigned*)(lds + (bufoff) + ldsw + _i * 8192), 16, 0, 0); } while (0)
#define PG8_LDA(dst, b, h) do { _Pragma("unroll") for (int m = 0; m < 4; ++m) _Pragma("unroll") for (int k = 0; k < 2; ++k) dst[m][k] = *(const PG8_LAS bf16x8*)(lds + PG8_SA(b, h) + aoff + m * 2048 + k * 1024); } while (0)
#define PG8_LDB(dst, b, h) do { _Pragma("unroll") for (int n = 0; n < 2; ++n) _Pragma("unroll") for (int k = 0; k < 2; ++k) dst[n][k] = *(const PG8_LAS bf16x8*)(lds + PG8_SB(b, h) + boff + n * 2048 + k * 1024); } while (0)
#define PG8_MMA(ai, bj, At, Bt) do { __builtin_amdgcn_s_setprio(1); _Pragma("unroll") for (int m = 0; m < 4; ++m) _Pragma("unroll") for (int n = 0; n < 2; ++n) _Pragma("unroll") for (int k = 0; k < 2; ++k) \
        acc[ai][bj][m][n] = __builtin_amdgcn_mfma_f32_16x16x32_bf16(Bt[n][k], At[m][k], acc[ai][bj][m][n], 0, 0, 0); __builtin_amdgcn_s_setprio(0); } while (0)
#define PG8_WAIT_V(n) asm volatile("s_waitcnt vmcnt(" #n ")" ::: "memory")
#define PG8_WAIT_L(n) asm volatile("s_waitcnt lgkmcnt(" #n ")" ::: "memory")
#define PG8_BAR __builtin_amdgcn_s_barrier()
#define PG8_SCHED __builtin_amdgcn_sched_barrier(0)
    Unit cur, nxt; int ui = 0;
    if (!S.next(0, cur)) return;
    f32x4 acc[2][2][4][2];
#pragma unroll
    for (int a = 0; a < 2; ++a)
#pragma unroll
        for (int b = 0; b < 2; ++b)
#pragma unroll
            for (int m = 0; m < 4; ++m)
#pragma unroll
                for (int n = 0; n < 2; ++n) acc[a][b][m][n] = (f32x4){0.f, 0.f, 0.f, 0.f};
    bf16x8 At[4][2], B0[2][2], B1[2][2];
    const char* cA = (const char*)g.A + (size_t)cur.pm * tstep; const char* cB = (const char*)g.Bt + (size_t)cur.pn * tstep + (size_t)(cur.pm >> 5) * g.bstride;
    S.a_ready(cur);
    if constexpr (SP2) {
        PG8_STAGE(PG8_SB(0, 0), cB, voffB); PG8_STAGE(PG8_SB(0, 1), cB + hstep, voffB); PG8_STAGE(PG8_SA(0, 0), cA, voffA); PG8_STAGE(PG8_SA(0, 1), cA + hstep, voffA);
        if (wr == 1) PG8_BAR;
        PG8_WAIT_V(2); PG8_BAR;
        PG8_STAGE(PG8_SB(1, 0), cB + kstep, voffB); PG8_STAGE(PG8_SA(1, 0), cA + kstep, voffA); PG8_STAGE(PG8_SB(1, 1), cB + hstep + kstep, voffB);
        PG8_WAIT_V(6); PG8_BAR;
    } else {
        PG8_STAGE(PG8_SB(0, 0), cB, voffB); PG8_STAGE(PG8_SA(0, 0), cA, voffA); PG8_STAGE(PG8_SB(0, 1), cB + hstep, voffB); PG8_STAGE(PG8_SA(0, 1), cA + hstep, voffA);
        if (wr == 1) PG8_BAR;
        PG8_WAIT_V(4); PG8_BAR;
        PG8_STAGE(PG8_SB(1, 0), cB + kstep, voffB); PG8_STAGE(PG8_SA(1, 0), cA + kstep, voffA); PG8_STAGE(PG8_SB(1, 1), cB + hstep + kstep, voffB);
        PG8_WAIT_V(6); PG8_BAR;
    }
    for (;;) {
        const bool has_next = S.next(ui + 1, nxt);
        const char* nA = has_next ? (const char*)g.A + (size_t)nxt.pm * tstep : cA; const char* nB = has_next ? (const char*)g.Bt + (size_t)nxt.pn * tstep + (size_t)(nxt.pm >> 5) * g.bstride : cB;
        for (int t = 0; t < nt; t += 2) {
            const bool last = (t == nt - 2);
            const char* a1 = cA + (size_t)(t + 1) * kstep;
            const char* a2 = last ? nA : cA + (size_t)(t + 2) * kstep; const char* b2 = last ? nB : cB + (size_t)(t + 2) * kstep;
            const char* a3 = a2 + kstep; const char* b3 = b2 + kstep;
            if (last && has_next) S.a_ready(nxt);
            if constexpr (SP2) {
            PG8_LDB(B0, 0, 0); PG8_LDB(B1, 0, 1); PG8_SCHED; PG8_LDA(At, 0, 0); PG8_STAGE(PG8_SA(1, 1), a1 + hstep, voffA);
            PG8_WAIT_V(8); PG8_WAIT_L(0); PG8_BAR; PG8_MMA(0, 0, At, B0); PG8_MMA(0, 1, At, B1); PG8_BAR; PG8_SCHED;
            PG8_LDA(At, 0, 1); PG8_STAGE(PG8_SB(0, 0), b2, voffB); PG8_STAGE(PG8_SB(0, 1), b2 + hstep, voffB); PG8_STAGE(PG8_SA(0, 0), a2, voffA);
            PG8_WAIT_V(8); PG8_WAIT_L(0); PG8_BAR; PG8_MMA(1, 0, At, B0); PG8_MMA(1, 1, At, B1); PG8_BAR; PG8_SCHED;
            PG8_LDB(B0, 1, 0); PG8_LDB(B1, 1, 1); PG8_SCHED; PG8_LDA(At, 1, 0); PG8_STAGE(PG8_SA(0, 1), a2 + hstep, voffA);
            PG8_WAIT_V(8); PG8_WAIT_L(0); PG8_BAR; PG8_MMA(0, 0, At, B0); PG8_MMA(0, 1, At, B1); PG8_BAR; PG8_SCHED;
            PG8_LDA(At, 1, 1); PG8_STAGE(PG8_SB(1, 0), b3, voffB); PG8_STAGE(PG8_SB(1, 1), b3 + hstep, voffB); PG8_STAGE(PG8_SA(1, 0), a3, voffA);
            PG8_WAIT_V(8); PG8_WAIT_L(0); PG8_BAR; PG8_MMA(1, 0, At, B0); PG8_MMA(1, 1, At, B1); PG8_BAR; PG8_SCHED;
            } else {
            PG8_LDB(B0, 0, 0); PG8_SCHED; PG8_LDA(At, 0, 0); PG8_STAGE(PG8_SA(1, 1), a1 + hstep, voffA);
            PG8_WAIT_L(8); PG8_BAR; PG8_WAIT_L(0); PG8_MMA(0, 0, At, B0); PG8_BAR; PG8_SCHED;
            PG8_LDB(B1, 0, 1); PG8_STAGE(PG8_SB(0, 0), b2, voffB);
            PG8_BAR; PG8_WAIT_L(0); PG8_MMA(0, 1, At, B1); PG8_BAR;
            PG8_LDA(At, 0, 1); PG8_STAGE(PG8_SA(0, 0), a2, voffA);
            PG8_BAR; PG8_WAIT_L(0); PG8_MMA(1, 0, At, B0); PG8_BAR; PG8_SCHED;
            PG8_STAGE(PG8_SB(0, 1), b2 + hstep, voffB);
            PG8_WAIT_V(6); PG8_BAR; PG8_MMA(1, 1, At, B1); PG8_BAR;
            PG8_LDB(B0, 1, 0); PG8_SCHED; PG8_LDA(At, 1, 0); PG8_STAGE(PG8_SA(0, 1), a2 + hstep, voffA);
            PG8_WAIT_L(8); PG8_BAR; PG8_WAIT_L(0); PG8_MMA(0, 0, At, B0); PG8_BAR; PG8_SCHED;
            PG8_LDB(B1, 1, 1); PG8_STAGE(PG8_SB(1, 0), b3, voffB);
            PG8_BAR; PG8_WAIT_L(0); PG8_MMA(0, 1, At, B1); PG8_BAR;
            PG8_LDA(At, 1, 1); PG8_STAGE(PG8_SA(1, 0), a3, voffA);
            PG8_BAR; PG8_WAIT_L(0); PG8_MMA(1, 0, At, B0); PG8_BAR; PG8_SCHED;
            PG8_STAGE(PG8_SB(1, 1), b3 + hstep, voffB);
            PG8_WAIT_V(6); PG8_BAR; PG8_MMA(1, 1, At, B1); PG8_BAR;
            }
        }
        if constexpr (ALIGN_EPI) { if (wr == 0) PG8_BAR; }
        if constexpr (!Epi::AFTER_DRAIN) { E(acc, cur, wr, wc, fr, fq); S.done(cur); }
        if (!has_next) break;
#pragma unroll
        for (int a = 0; a < 2; ++a)
#pragma unroll
            for (int b = 0; b < 2; ++b)
#pragma unroll
                for (int m = 0; m < 4; ++m)
#pragma unroll
                    for (int n = 0; n < 2; ++n) acc[a][b][m][n] = (f32x4){0.f, 0.f, 0.f, 0.f};
        cur = nxt; cA = nA; cB = nB; ++ui;
        if constexpr (ALIGN_EPI) { if (wr == 1) PG8_BAR; }
    }
    PG8_WAIT_V(0);
    if constexpr (!ALIGN_EPI) { if (wr == 0) PG8_BAR; }
    PG8_BAR;
    if constexpr (Epi::AFTER_DRAIN) { E.fused(acc, cur, wr, wc, fr, fq, lds, wid, lane); S.done(cur); }
#undef PG8_SA
#undef PG8_SB
#undef PG8_STAGE
#undef PG8_LDA
#undef PG8_LDB
#undef PG8_MMA
#undef PG8_WAIT_V
#undef PG8_WAIT_L
#undef PG8_BAR
#undef PG8_SCHED
}
}
#define DI __device__ __forceinline__
#define LAS __attribute__((address_space(3)))
typedef unsigned short bf16;
typedef short bf16x8 __attribute__((ext_vector_type(8)));
typedef float f32x4 __attribute__((ext_vector_type(4)));
typedef float f32x2 __attribute__((ext_vector_type(2)));
typedef float f32x16 __attribute__((ext_vector_type(16)));
typedef unsigned u32x4 __attribute__((ext_vector_type(4)));
typedef unsigned u32x2 __attribute__((ext_vector_type(2)));
#define MFMA32(a, b, c) __builtin_amdgcn_mfma_f32_32x32x16_bf16((a), (b), (c), 0, 0, 0)

constexpr int NB = 4, T = 8192, D = 1024, M = NB * T, NP = 3072;
constexpr int NWAVES = 8, NTHR = 512;
constexpr int LDS_BYTES = 155648;
constexpr size_t MiB = 1u << 20;
constexpr size_t WS_MOD = 1 * MiB;
constexpr size_t WS_SS = 128 * 1024;
constexpr size_t WS_SHW = 1 * MiB + 256 * 1024;
constexpr size_t WS_GW = 1 * MiB + 512 * 1024;
constexpr size_t WS_ABL = 2 * MiB;
constexpr size_t WS_BB = 2 * MiB + 65536;
constexpr size_t WS_PW = 3 * MiB;
constexpr size_t WS_F = 5 * MiB;
constexpr size_t WS_VBIG = 8 * MiB;
constexpr size_t WS_WBIG = 16 * MiB;
constexpr size_t WS_WIN0 = 24 * MiB, WS_WOUT0 = 30 * MiB, WS_WIN1 = 32 * MiB, WS_WGLU = 38 * MiB, WS_WOUT1 = 39 * MiB;
constexpr size_t WS_KMEAN = 41 * MiB;
constexpr size_t WS_LRUSUM = 42 * MiB;
constexpr size_t WS_S5S = 44 * MiB;
constexpr size_t WS_VT = 52 * MiB;
constexpr size_t WS_H = 84 * MiB;
constexpr size_t WS_MIX = 148 * MiB;
constexpr size_t WS_PROJ = 212 * MiB;
constexpr size_t WS_KF = 404 * MiB;
constexpr size_t WS_X1B = 436 * MiB;
constexpr size_t WS_W1S = 116 * MiB;
constexpr size_t WS_END = 500 * MiB;

struct Args { const float* in[33]; float* out; unsigned char* ws; };

DI unsigned f2bf(float f) { unsigned u = __builtin_bit_cast(unsigned, f); return (u + 0x7fffu + ((u >> 16) & 1u)) >> 16; }
DI unsigned pk2(float lo, float hi) { return pg8::pk2f(lo, hi); }
DI float bf2f(unsigned short b) { return __builtin_bit_cast(float, (unsigned)b << 16); }
DI float bflo(unsigned w) { return __builtin_bit_cast(float, w << 16); }
DI float bfhi(unsigned w) { return __builtin_bit_cast(float, w & 0xffff0000u); }
DI int crow(int reg, int h) { return (reg & 3) + 8 * (reg >> 2) + 4 * h; }
DI float sigm(float x) { return __builtin_amdgcn_rcpf(1.f + __expf(-x)); }
DI float silu(float x) { return x * __builtin_amdgcn_rcpf(1.f + __expf(-x)); }
DI bf16x8 mk8(u32x4 v) { return __builtin_bit_cast(bf16x8, v); }
DI bf16x8 pack8(float a0, float a1, float a2, float a3, float a4, float a5, float a6, float a7) { u32x4 v; v.x = pk2(a0, a1); v.y = pk2(a2, a3); v.z = pk2(a4, a5); v.w = pk2(a6, a7); return __builtin_bit_cast(bf16x8, v); }
DI f32x16 zero16() { f32x16 z;
#pragma unroll
  for (int i = 0; i < 16; ++i) z[i] = 0.f; return z; }

#define XB_TMO      128
#define XB_XCNT(j)  (256  + 64 * (j))
#define XB_XSUB(j)  (1280 + 64 * (j))
#define XB_XGEN(j)  (2304 + 64 * (j))
#define XB_TOP      3328
#define XB_TOPGEN   3392
#define XCD_BAR_WORDS 3456
#define XB_SPIN_CAP (1u << 18)

__device__ __forceinline__ unsigned xb_ld(unsigned* p)              { return __hip_atomic_load(p, __ATOMIC_RELAXED, __HIP_MEMORY_SCOPE_AGENT); }
__device__ __forceinline__ unsigned xb_add(unsigned* p, unsigned v) { return __hip_atomic_fetch_add(p, v, __ATOMIC_RELAXED, __HIP_MEMORY_SCOPE_AGENT); }
__device__ __forceinline__ unsigned xb_xcc_id() { return (unsigned)__builtin_amdgcn_s_getreg((3 << 11) | 20) & 0xFu; }
#define XB_SPIN(cond, bar) do { unsigned _sp = 0; while (cond) { __builtin_amdgcn_s_sleep(1); \
    if ((++_sp & 255u) == 0u) { if (xb_ld(&(bar)[XB_TMO])) break; if (_sp > XB_SPIN_CAP) { atomicAdd(&(bar)[XB_TMO], 1u); break; } } } } while (0)

struct XcdBarrier {
    unsigned* bar; unsigned x;
    volatile LAS unsigned* st;
};

__device__ __forceinline__ XcdBarrier xcd_barrier_post(unsigned* bar, volatile LAS unsigned* st) {
    XcdBarrier b; b.bar = bar; b.x = xb_xcc_id(); b.st = st;
    if (threadIdx.x == 0) (void)xb_add(&bar[XB_XCNT(b.x)], 1u);
    return b;
}
__device__ __forceinline__ void xcd_barrier_complete(unsigned* bar, unsigned x, unsigned& nloc, unsigned& nx) {
    const unsigned G = gridDim.x * gridDim.y * gridDim.z;
    unsigned sum, cnt, mine, sp = 0u;
    for (;;) {
        sum = 0u; cnt = 0u; mine = 0u;
#pragma unroll
        for (unsigned j = 0; j < 16; ++j) { const unsigned c = xb_ld(&bar[XB_XCNT(j)]); sum += c; cnt += (c > 0u) ? 1u : 0u; mine = (j == x) ? c : mine; }
        if (sum == G) break;
        __builtin_amdgcn_s_sleep(1);
        if ((++sp & 255u) == 0u) { if (xb_ld(&bar[XB_TMO])) break; if (sp > XB_SPIN_CAP) { atomicAdd(&bar[XB_TMO], 1u); break; } }
    }
    nloc = mine > 0u ? mine : 1u; nx = cnt > 0u ? cnt : 1u;
}

__device__ __forceinline__ void xcd_barrier(const XcdBarrier& b) {
    asm volatile("s_waitcnt vmcnt(0)" ::: "memory");
    __syncthreads();
    if (threadIdx.x == 0) {
        unsigned* bar = b.bar;
        __builtin_amdgcn_s_waitcnt(0);
        unsigned nloc = b.st[0], nx = b.st[1];
        if (nloc == 0u) { xcd_barrier_complete(bar, b.x, nloc, nx); b.st[0] = nloc; b.st[1] = nx; }
        const unsigned old = xb_add(&bar[XB_XSUB(b.x)], 1u);
        const unsigned gen = old / nloc;
        if (old + 1u == (gen + 1u) * nloc) {
            __builtin_amdgcn_fence(__ATOMIC_RELEASE, "agent");
            asm volatile("s_waitcnt vmcnt(0)" ::: "memory");
            const unsigned og = xb_add(&bar[XB_TOP], 1u);
            const unsigned tg = og / nx;
            if (og + 1u == (tg + 1u) * nx) xb_add(&bar[XB_TOPGEN], 1u);
            else XB_SPIN(xb_ld(&bar[XB_TOPGEN]) == tg, bar);
            __builtin_amdgcn_fence(__ATOMIC_ACQUIRE, "agent");
            xb_add(&bar[XB_XGEN(b.x)], 1u);
            asm volatile("s_waitcnt vmcnt(0)" ::: "memory");
        } else {
            XB_SPIN(xb_ld(&bar[XB_XGEN(b.x)]) == gen, bar);
            __builtin_amdgcn_fence(__ATOMIC_ACQUIRE, "agent");
            asm volatile("s_waitcnt vmcnt(0)" ::: "memory");
        }
    }
    __syncthreads();
}

DI void transpose_item(const float* W, int K, int N, bf16* WT, int dst_row0, LAS float* scr, int kb, int nb, int lane) {
    const int k0 = 64 * kb, n0 = 32 * nb;
#pragma unroll 8
    for (int i = 0; i < 32; ++i) { const int kk = 2 * i + (lane >> 5); scr[kk * 33 + (lane & 31)] = W[(size_t)(k0 + kk) * N + n0 + (lane & 31)]; }
    asm volatile("s_waitcnt lgkmcnt(0)" ::: "memory");
    const int c = lane & 7;
#pragma unroll
    for (int j = 0; j < 4; ++j) { const int n = (lane >> 3) + 8 * j; const LAS float* s = scr + (8 * c) * 33 + n;
        u32x4 o; o.x = pk2(s[0 * 33], s[1 * 33]); o.y = pk2(s[2 * 33], s[3 * 33]); o.z = pk2(s[4 * 33], s[5 * 33]); o.w = pk2(s[6 * 33], s[7 * 33]);
        *(u32x4*)(WT + (size_t)(dst_row0 + n) * K + k0 + 8 * c) = o; }
    asm volatile("s_waitcnt lgkmcnt(0)" ::: "memory");
}

DI void phase0(const Args& a, LAS unsigned char* lds, int tid, int lane, int wave) {
    unsigned char* ws = a.ws;
    const int bx = blockIdx.x;
    if (bx < 192) {
        const int layer = bx / 96, cc = bx % 96, l31 = lane & 31, hh = lane >> 5, col = 32 * cc + l31;
        const float* W = layer ? a.in[17] : a.in[3]; const float* cv = a.in[1];
        LAS float* SC = (LAS float*)lds;
        LAS float* red = (LAS float*)(lds + 16384);
        for (int i = tid; i < 4096; i += NTHR) SC[i] = silu(cv[i]);
        __syncthreads();
        float a0 = 0.f, a1 = 0.f, a2 = 0.f, a3 = 0.f;
        const float* wp = W + (size_t)(128 * wave + hh) * 3072 + col;
#pragma unroll 1
        for (int i0 = 0; i0 < 64; i0 += 16) { float wv[16];
#pragma unroll
            for (int i = 0; i < 16; ++i) wv[i] = wp[(size_t)(2 * (i0 + i)) * 3072];
#pragma unroll
            for (int i = 0; i < 16; ++i) { const int k = 128 * wave + 2 * (i0 + i) + hh; a0 += SC[k] * wv[i]; a1 += SC[1024 + k] * wv[i]; a2 += SC[2048 + k] * wv[i]; a3 += SC[3072 + k] * wv[i]; } }
        a0 += __shfl_xor(a0, 32); a1 += __shfl_xor(a1, 32); a2 += __shfl_xor(a2, 32); a3 += __shfl_xor(a3, 32);
        if (hh == 0) { red[(wave * 4 + 0) * 32 + l31] = a0; red[(wave * 4 + 1) * 32 + l31] = a1; red[(wave * 4 + 2) * 32 + l31] = a2; red[(wave * 4 + 3) * 32 + l31] = a3; }
        __syncthreads();
        if (tid < 128) { const int b = tid >> 5, l = tid & 31; float s = 0.f;
#pragma unroll
            for (int w = 0; w < 8; ++w) s += red[(w * 4 + b) * 32 + l];
            const float* bias = layer ? a.in[18] : a.in[4];
            ((float*)(ws + WS_MOD))[(layer * 4 + b) * 3072 + 32 * cc + l] = s + bias[32 * cc + l]; }
        __syncthreads();
    } else if (bx < 196) {
        const int gp = (bx - 192) * 512 + tid, g = gp >> 6;
        const float step = __expf(a.in[24][g]);
        const float lr = a.in[22][gp], li = a.in[23][gp];
        const float decay = __expf(lr * step);
        float rev = li * step * 0.15915494309189535f; rev -= floorf(rev);
        const float abr = decay * __builtin_amdgcn_cosf(rev), abi = decay * __builtin_amdgcn_sinf(rev);
        const float den = lr * lr + li * li;
        const float fr = ((abr - 1.f) * lr + abi * li) / den, fi = (abi * lr - (abr - 1.f) * li) / den;
        float* BB = (float*)(ws + WS_BB) + (size_t)gp * 32;
#pragma unroll
        for (int h = 0; h < 16; ++h) { const float br = a.in[25][gp * 16 + h], bi = a.in[26][gp * 16 + h]; BB[2 * h] = fr * br - fi * bi; BB[2 * h + 1] = fr * bi + fi * br; }
        float* PW = (float*)(ws + WS_PW) + ((size_t)g * 65 * 64 + (gp & 63)) * 2;
        float pr = 1.f, pi = 0.f;
        for (int t = 0; t < 64; ++t) { PW[(size_t)t * 128] = pr; PW[(size_t)t * 128 + 1] = pi; const float nr = pr * abr - pi * abi, ni = pr * abi + pi * abr; pr = nr; pi = ni; }
        PW[(size_t)64 * 128] = pr; PW[(size_t)64 * 128 + 1] = pi;
        float* ABL = (float*)(ws + WS_ABL) + gp * 2; ABL[0] = pr; ABL[1] = pi;
    }
    if (bx == 200 && tid == 0) { float gq = 0.f, gk = 0.f;
        for (int i = 0; i < 64; ++i) { gq = fmaxf(gq, fabsf(a.in[13][i])); gk = fmaxf(gk, fabsf(a.in[14][i])); }
        ((float*)(ws + WS_MOD))[2 * 4 * 3072] = 8.f * gq * gk; }
    if (bx >= 201 && bx < 217) {
        const int v = (bx - 201) * 512 + tid, ln = v & 63, s = (v >> 6) & 3, ct = (v >> 8) & 1, g = (v >> 9) & 7, gate = v >> 12, l31 = ln & 31, hh = ln >> 5;
        const float* wsrc = (gate ? a.in[10] : a.in[8]) + (size_t)g * 4096 + (16 * s + 8 * hh) * 64 + 32 * ct + l31;
        u32x4 o; o.x = pk2(wsrc[0], wsrc[64]); o.y = pk2(wsrc[128], wsrc[192]); o.z = pk2(wsrc[256], wsrc[320]); o.w = pk2(wsrc[384], wsrc[448]);
        *(u32x4*)(ws + WS_GW + (size_t)v * 16) = o; }
    LAS float* scr = (LAS float*)(lds + 16384 + wave * 8704);
    const int gw = bx * NWAVES + wave, NGW = gridDim.x * NWAVES;
    constexpr int I0 = 16 * 96, I1 = 16 * 32, I2 = 16 * 96, I3 = 8 * 32, I4 = 16 * 32;
    for (int it = gw; it < I0 + I1 + I2 + I3 + I4; it += NGW) {
        int r = it;
        if (r < I0) { transpose_item(a.in[5], 1024, 3072, (bf16*)(ws + WS_WIN0), 32 * (r % 96), scr, r / 96, r % 96, lane); continue; } r -= I0;
        if (r < I1) { transpose_item(a.in[15], 1024, 1024, (bf16*)(ws + WS_WOUT0), 32 * (r % 32), scr, r / 32, r % 32, lane); continue; } r -= I1;
        if (r < I2) { transpose_item(a.in[19], 1024, 3072, (bf16*)(ws + WS_WIN1), 32 * (r % 96), scr, r / 96, r % 96, lane); continue; } r -= I2;
        if (r < I3) { const int nb = r % 32, n0 = 32 * nb; const int nn = n0 & 511; const int dst = 256 * (nn >> 7) + (n0 >= 512 ? 128 : 0) + (nn & 127);
            transpose_item(a.in[30], 512, 1024, (bf16*)(ws + WS_WGLU), dst, scr, r / 32, nb, lane); continue; } r -= I3;
        transpose_item(a.in[32], 1024, 1024, (bf16*)(ws + WS_WOUT1), 32 * (r % 32), scr, r / 32, r % 32, lane);
    }
}

DI float wave_sum(float v) {
#pragma unroll
    for (int o = 1; o < 64; o <<= 1) v += __shfl_xor(v, o);
    return v;
}
DI void norm_rows(const float* xin, const float* gain, const float* modl, bf16* H, int gw, int NGW, int lane) {
    f32x4 gs[4], sh[4]; int curb = -1;
    for (int m = gw; m < M; m += NGW) {
        const f32x4* xr = (const f32x4*)(xin + (size_t)m * D) + lane;
        f32x4 v[4]; float s = 0.f;
#pragma unroll
        for (int j = 0; j < 4; ++j) v[j] = __builtin_nontemporal_load(xr + 64 * j);
        const int b = m >> 13;
        if (b != curb) { curb = b; const float* mb = modl + b * 3072;
#pragma unroll
            for (int j = 0; j < 4; ++j) { const int c = 4 * lane + 256 * j; gs[j] = *(const f32x4*)(gain + c) * (*(const f32x4*)(mb + 1024 + c) + 1.f); sh[j] = *(const f32x4*)(mb + c); } }
#pragma unroll
        for (int j = 0; j < 4; ++j) s += (v[j].x * v[j].x + v[j].y * v[j].y) + (v[j].z * v[j].z + v[j].w * v[j].w);
        const float rstd = rsqrtf(wave_sum(s) * (1.f / D) + 1e-6f);
        unsigned long long* o8 = (unsigned long long*)(H + (size_t)m * D) + lane;
#pragma unroll
        for (int j = 0; j < 4; ++j) { const f32x4 y = v[j] * rstd * gs[j] + sh[j];
            o8[64 * j] = (unsigned long long)pk2(y.x, y.y) | ((unsigned long long)pk2(y.z, y.w) << 32); }
    }
}

DI void s5_tables(const Args& a, LAS unsigned char* lds, int gt, int NT) {
    unsigned char* ws = a.ws;
    const float* PW = (const float*)(ws + WS_PW); const float* BB = (const float*)(ws + WS_BB);
    const float* cre = a.in[27]; const float* cim = a.in[28]; const float* dd = a.in[29];
    const bool staged = (NT == 32 * 64 * 16 * 4);
    LAS float* LB = (LAS float*)lds; LAS float* LP = LB + 2048; LAS float* LC = LP + 1024; LAS float* LI = LC + 1024;
    if (staged) { const int g = blockIdx.x >> 3, tau0 = (8 * blockIdx.x) & 63; const int t = threadIdx.x;
#pragma unroll
        for (int i = 0; i < 4; ++i) LB[t + 512 * i] = BB[(size_t)g * 2048 + t + 512 * i];
#pragma unroll
        for (int i = 0; i < 2; ++i) { LP[t + 512 * i] = PW[((size_t)(g * 65 + tau0) * 64) * 2 + t + 512 * i]; LC[t + 512 * i] = cre[g * 1024 + t + 512 * i]; LI[t + 512 * i] = cim[g * 1024 + t + 512 * i]; }
        __syncthreads(); }
    for (int v4 = gt; v4 < 32 * 64 * 16 * 4; v4 += NT) {
        const int v = v4 >> 2, pq = v4 & 3, g = v >> 10, tau = (v >> 4) & 63, h = v & 15;
        float acc[16];
#pragma unroll
        for (int e = 0; e < 16; ++e) acc[e] = 0.f;
        if (staged) {
#pragma unroll 4
            for (int pi = 0; pi < 16; ++pi) { const int p = 16 * pq + pi;
                const float cr = LC[h * 64 + p], ci = LI[h * 64 + p];
                const f32x2 pw = *(const LAS f32x2*)(LP + ((tau & 7) * 64 + p) * 2);
                const float wr = cr * pw.x - ci * pw.y, wi = cr * pw.y + ci * pw.x;
                const LAS f32x4* bb = (const LAS f32x4*)(LB + p * 32);
#pragma unroll
                for (int e2 = 0; e2 < 8; ++e2) { const f32x4 b4 = bb[e2]; acc[2 * e2] += wr * b4.x - wi * b4.y; acc[2 * e2 + 1] += wr * b4.z - wi * b4.w; }
            }
        } else {
#pragma unroll 4
        for (int pi = 0; pi < 16; ++pi) { const int p = 16 * pq + pi;
            const float cr = cre[(g * 16 + h) * 64 + p], ci = cim[(g * 16 + h) * 64 + p];
            const f32x2 pw = *(const f32x2*)(PW + ((size_t)(g * 65 + tau) * 64 + p) * 2);
            const float wr = cr * pw.x - ci * pw.y, wi = cr * pw.y + ci * pw.x;
            const f32x4* bb = (const f32x4*)(BB + (size_t)(g * 64 + p) * 32);
#pragma unroll
            for (int e2 = 0; e2 < 8; ++e2) { const f32x4 b4 = bb[e2]; acc[2 * e2] += wr * b4.x - wi * b4.y; acc[2 * e2 + 1] += wr * b4.z - wi * b4.w; }
        }
        }
#pragma unroll
        for (int e = 0; e < 16; ++e) { acc[e] += __shfl_xor(acc[e], 1); acc[e] += __shfl_xor(acc[e], 2); }
        if (pq != 0) continue;
        if (tau == 0) { const float dv = dd[g * 16 + h];
#pragma unroll
            for (int e = 0; e < 16; ++e) if (e == h) acc[e] += dv; }
        u32x4 lo, hi; lo.x = pk2(acc[0], acc[1]); lo.y = pk2(acc[2], acc[3]); lo.z = pk2(acc[4], acc[5]); lo.w = pk2(acc[6], acc[7]);
        hi.x = pk2(acc[8], acc[9]); hi.y = pk2(acc[10], acc[11]); hi.z = pk2(acc[12], acc[13]); hi.w = pk2(acc[14], acc[15]);
        unsigned char* fb = ws + WS_F + (size_t)g * 65536;
        if (tau + 1 < 64) { *(u32x4*)(fb + (size_t)((tau + 1) * 64 + h) * 16) = lo; *(u32x4*)(fb + (size_t)((tau + 1) * 64 + 32 + h) * 16) = hi; }
        *(u32x4*)(fb + (size_t)(tau * 64 + 16 + h) * 16) = lo; *(u32x4*)(fb + (size_t)(tau * 64 + 48 + h) * 16) = hi;
        if (tau == 0) { u32x4 z; z.x = 0u; z.y = 0u; z.z = 0u; z.w = 0u; *(u32x4*)(fb + (size_t)h * 16) = z; *(u32x4*)(fb + (size_t)(32 + h) * 16) = z; }
    }
    for (int vb_ = gt; vb_ < 32 * 4 * 64 * 64; vb_ += 4 * NT)
#pragma unroll
    for (int u_ = 0; u_ < 4; ++u_) { const int v = vb_ + u_ * NT; if (v >= 32 * 4 * 64 * 64) continue;
        const int g = v >> 14, rt = (v >> 12) & 3, s = (v >> 6) & 63, lane = v & 63, q = 32 * rt + (lane & 31), part = q >> 6, p = q & 63, hh = lane >> 5;
        const f32x2 pw = *(const f32x2*)(PW + ((size_t)(g * 65 + (63 - s)) * 64 + p) * 2);
        const float* bb = BB + ((size_t)(g * 64 + p) * 16 + 8 * hh) * 2;
        float o[8];
#pragma unroll
        for (int e = 0; e < 8; ++e) o[e] = part ? (pw.x * bb[2 * e + 1] + pw.y * bb[2 * e]) : (pw.x * bb[2 * e] - pw.y * bb[2 * e + 1]);
        u32x4 w; w.x = pk2(o[0], o[1]); w.y = pk2(o[2], o[3]); w.z = pk2(o[4], o[5]); w.w = pk2(o[6], o[7]);
        *(u32x4*)(ws + WS_VBIG + (size_t)v * 16) = w;
    }
    for (int vb_ = gt; vb_ < 32 * 32 * 8 * 64; vb_ += 4 * NT)
#pragma unroll
    for (int u_ = 0; u_ < 4; ++u_) { const int v = vb_ + u_ * NT; if (v >= 32 * 32 * 8 * 64) continue;
        const int g = v >> 14, R = (v >> 9) & 31, ks = (v >> 6) & 7, lane = v & 63, r = lane & 31, jj = r >> 4, h = r & 15, hh = lane >> 5, tok = 2 * R + jj, part = ks >> 2;
        float o[8];
#pragma unroll
        for (int e = 0; e < 8; ++e) { const int p = 16 * (ks & 3) + 8 * hh + e;
            const float cr = cre[(g * 16 + h) * 64 + p], ci = cim[(g * 16 + h) * 64 + p];
            const f32x2 pw = *(const f32x2*)(PW + ((size_t)(g * 65 + tok + 1) * 64 + p) * 2);
            o[e] = part ? -(cr * pw.y + ci * pw.x) : (cr * pw.x - ci * pw.y); }
        u32x4 w; w.x = pk2(o[0], o[1]); w.y = pk2(o[2], o[3]); w.z = pk2(o[4], o[5]); w.w = pk2(o[6], o[7]);
        *(u32x4*)(ws + WS_WBIG + (size_t)v * 16) = w;
    }
}
template <int PASS>
DI void lru_item(const Args& a, LAS unsigned char* lds, int item, int tid, int lane, int wave) {
    unsigned char* ws = a.ws;
    const bf16* PROJ = (const bf16*)(ws + WS_PROJ); bf16* MIX = (bf16*)(ws + WS_MIX); float* SUM = (float*)(ws + WS_LRUSUM);
    const int b = item >> 7, ch = item & 127; const size_t m0 = (size_t)b * T + 64 * ch;
    constexpr int XP = 520;
    LAS bf16* XC = (LAS bf16*)lds; LAS bf16* HB = (LAS bf16*)(lds + 66560);
    {
        LAS bf16* XR = HB;
        u32x4 xv[9];
#pragma unroll
        for (int i = 0; i < 9; ++i) { const int idx = tid + 512 * i, r = idx >> 6, c8 = idx & 63;
            xv[i].x = 0u; xv[i].y = 0u; xv[i].z = 0u; xv[i].w = 0u;
            if (idx < 67 * 64 && (ch > 0 || r >= 3)) xv[i] = *(const u32x4*)(PROJ + (m0 + r - 3) * NP + 8 * c8); }
#pragma unroll
        for (int i = 0; i < 9; ++i) { const int idx = tid + 512 * i, r = idx >> 6, c8 = idx & 63;
            if (idx < 67 * 64) *(LAS u32x4*)(XR + r * XP + 8 * c8) = xv[i]; }
        __syncthreads();
        const int c = tid; const float* cw = a.in[6];
        const float w0 = cw[c], w1 = cw[512 + c], w2 = cw[1024 + c], w3 = cw[1536 + c], cb = a.in[7][c];
        float xm3 = bf2f(XR[c]), xm2 = bf2f(XR[XP + c]), xm1 = bf2f(XR[2 * XP + c]);
#pragma unroll 4
        for (int j = 0; j < 64; ++j) { const float x0 = bf2f(XR[(j + 3) * XP + c]); const float xc = w0 * xm3 + w1 * xm2 + w2 * xm1 + w3 * x0 + cb; XC[j * XP + c] = (bf16)f2bf(xc); xm3 = xm2; xm2 = xm1; xm1 = x0; }
    }
    LAS float* CAR = (LAS float*)(lds + 136448);
    if (PASS == 2) { float h = 0.f; const float* sp2 = SUM + ((size_t)(b * 128) * 512 + tid) * 2;
#pragma unroll 16
        for (int cc = 0; cc < ch; ++cc) { const f32x2 s2 = *(const f32x2*)(sp2 + (size_t)cc * 1024); h = s2.x * h + s2.y; }
        CAR[tid] = h; }
    __syncthreads();
    const int g = wave, hh = lane >> 5, l31 = lane & 31;
    const bf16* GW = (const bf16*)(ws + WS_GW);
#pragma unroll 1
    for (int ct = 0; ct < 2; ++ct) {
        const int j = 32 * ct + l31, c = 64 * g + j;
        bf16x8 Br[4], Bi[4];
#pragma unroll
        for (int s = 0; s < 4; ++s) { Br[s] = mk8(*(const u32x4*)(GW + ((size_t)(((0 * 8 + g) * 2 + ct) * 4 + s) * 64 + lane) * 8)); Bi[s] = mk8(*(const u32x4*)(GW + ((size_t)(((1 * 8 + g) * 2 + ct) * 4 + s) * 64 + lane) * 8)); }
        f32x16 Rr[2], Ii[2];
#pragma unroll
        for (int rt = 0; rt < 2; ++rt) { Rr[rt] = zero16(); Ii[rt] = zero16();
#pragma unroll
            for (int s = 0; s < 4; ++s) { const bf16x8 A = *(const LAS bf16x8*)(XC + (32 * rt + l31) * XP + 64 * g + 16 * s + 8 * hh); Rr[rt] = MFMA32(A, Br[s], Rr[rt]); Ii[rt] = MFMA32(A, Bi[s], Ii[rt]); } }
        const float rb = a.in[9][c], ib = a.in[11][c];
        const float sp = log1pf(__expf(-a.in[12][c]));
#pragma unroll
        for (int rt = 0; rt < 2; ++rt)
#pragma unroll
            for (int i = 0; i < 16; ++i) { const int tok = 32 * rt + crow(i, hh);
                const float r = sigm(Rr[rt][i] + rb), ig = sigm(Ii[rt][i] + ib);
                const float la = -8.f * r * sp; const float av = __expf(la); const float x2 = 2.f * la;
                const float ser = -x2 * (1.f + 0.5f * x2 * (1.f + (1.f / 3.f) * x2 * (1.f + 0.25f * x2 * (1.f + 0.2f * x2 * (1.f + (1.f / 6.f) * x2)))));
                const float om = (x2 > -0.25f) ? ser : (1.f - av * av); const float mult = __builtin_amdgcn_sqrtf(om);
                const float xv = bf2f(XC[tok * XP + c]);
                Rr[rt][i] = av; Ii[rt][i] = mult * ig * xv; if ((i & 3) == 3) __builtin_amdgcn_sched_barrier(0); }
        float Ag[8], Bg[8], Ao[8], Bo[8];
#pragma unroll
        for (int rt = 0; rt < 2; ++rt)
#pragma unroll
            for (int k = 0; k < 4; ++k) { float A = 1.f, Bv = 0.f;
#pragma unroll
                for (int e = 0; e < 4; ++e) { const float av = Rr[rt][4 * k + e]; Bv = av * Bv + Ii[rt][4 * k + e]; A *= av; }
                Ag[rt * 4 + k] = A; Bg[rt * 4 + k] = Bv; }
#pragma unroll
        for (int q = 0; q < 8; ++q) { Ao[q] = __shfl_xor(Ag[q], 32); Bo[q] = __shfl_xor(Bg[q], 32); }
        float h = (PASS == 2) ? CAR[c] : 0.f;
        float hs[8]; float Atot = 1.f;
#pragma unroll
        for (int q = 0; q < 8; ++q) {
            const float A1 = hh ? Ao[q] : Ag[q], B1 = hh ? Bo[q] : Bg[q], A2 = hh ? Ag[q] : Ao[q], B2 = hh ? Bg[q] : Bo[q];
            const float h1 = A1 * h + B1; hs[q] = hh ? h1 : h; h = A2 * h1 + B2; Atot *= A1 * A2; }
        if (PASS == 1) { if (hh == 0) { f32x2 o; o.x = Atot; o.y = h; *(f32x2*)(SUM + ((size_t)(b * 128 + ch) * 512 + c) * 2) = o; } }
        else {
#pragma unroll
            for (int rt = 0; rt < 2; ++rt)
#pragma unroll
                for (int k = 0; k < 4; ++k) { float hc = hs[rt * 4 + k];
#pragma unroll
                    for (int e = 0; e < 4; ++e) { const int i = 4 * k + e; hc = Rr[rt][i] * hc + Ii[rt][i]; HB[(32 * rt + 8 * k + 4 * hh + e) * XP + c] = (bf16)f2bf(hc); } }
        }
    }
    __syncthreads();
    if (PASS == 2) {
#pragma unroll
        for (int i = 0; i < 8; ++i) { const int idx = tid + 512 * i, tok = idx >> 6, c8 = idx & 63;
            const u32x4 hv = *(const LAS u32x4*)(HB + tok * XP + 8 * c8); const u32x4 gv = *(const u32x4*)(PROJ + (m0 + tok) * NP + 512 + 8 * c8);
            u32x4 o;
#pragma unroll
            for (int e = 0; e < 4; ++e) o[e] = pk2(bflo(hv[e]) * silu(bflo(gv[e])), bfhi(hv[e]) * silu(bfhi(gv[e])));
            *(u32x4*)(MIX + (m0 + tok) * 1024 + 8 * c8) = o; }
        __syncthreads();
    }
}

template <int LAYER>
DI void prep_item(const Args& a, LAS unsigned char* lds, int item, int tid) {
    unsigned char* ws = a.ws;
    bf16* PROJ = (bf16*)(ws + WS_PROJ); bf16* VF = (bf16*)(ws + WS_VT); bf16* KF = (bf16*)(ws + WS_KF);
    constexpr int qoff = LAYER ? 0 : 1024, koff = LAYER ? 512 : 1536, voff = LAYER ? 1024 : 2048;
    const float* qg = LAYER ? a.in[20] : a.in[13]; const float* kg = LAYER ? a.in[21] : a.in[14];
    const int h = item & 7, n = (item >> 3) & 31, b = item >> 8;
    LAS bf16* VL = (LAS bf16*)lds; LAS float* RED = (LAS float*)(lds + 40960);
    const int c8 = tid & 7, r0 = tid >> 3;
    float qgv[8], kgv[8], ksum[8];
#pragma unroll
    for (int e = 0; e < 8; ++e) { qgv[e] = qg[8 * c8 + e]; kgv[e] = kg[8 * c8 + e]; ksum[e] = 0.f; }
    u32x4 lq[4], lk[4], lv[4];
#pragma unroll
    for (int i = 0; i < 4; ++i) { const bf16* base = PROJ + ((size_t)b * T + 256 * n + r0 + 64 * i) * NP + 64 * h + 8 * c8; lq[i] = *(const u32x4*)(base + qoff); lk[i] = *(const u32x4*)(base + koff); lv[i] = *(const u32x4*)(base + voff); }
#pragma unroll
    for (int i = 0; i < 4; ++i) {
        const int row = r0 + 64 * i; bf16* base = PROJ + ((size_t)b * T + 256 * n + row) * NP + 64 * h + 8 * c8;
        {   u32x4 v = lq[i]; float f[8];
#pragma unroll
            for (int e = 0; e < 4; ++e) { f[2 * e] = bflo(v[e]); f[2 * e + 1] = bfhi(v[e]); }
            float ss = 0.f;
#pragma unroll
            for (int e = 0; e < 8; ++e) ss += f[e] * f[e];
            ss += __shfl_xor(ss, 1); ss += __shfl_xor(ss, 2); ss += __shfl_xor(ss, 4);
            const float rstd = rsqrtf(ss * (1.f / 64.f) + 1e-6f);
#pragma unroll
            for (int e = 0; e < 8; ++e) f[e] = f[e] * rstd * qgv[e];
            u32x4 o; o.x = pk2(f[0], f[1]); o.y = pk2(f[2], f[3]); o.z = pk2(f[4], f[5]); o.w = pk2(f[6], f[7]); *(u32x4*)(base + qoff) = o; }
        {   u32x4 v = lk[i]; float f[8];
#pragma unroll
            for (int e = 0; e < 4; ++e) { f[2 * e] = bflo(v[e]); f[2 * e + 1] = bfhi(v[e]); }
            float ss = 0.f;
#pragma unroll
            for (int e = 0; e < 8; ++e) ss += f[e] * f[e];
            ss += __shfl_xor(ss, 1); ss += __shfl_xor(ss, 2); ss += __shfl_xor(ss, 4);
            const float rstd = rsqrtf(ss * (1.f / 64.f) + 1e-6f);
#pragma unroll
            for (int e = 0; e < 8; ++e) { f[e] = f[e] * rstd * kgv[e]; ksum[e] += f[e]; }
            u32x4 o; o.x = pk2(f[0], f[1]); o.y = pk2(f[2], f[3]); o.z = pk2(f[4], f[5]); o.w = pk2(f[6], f[7]);
            *(u32x4*)(KF + ((((size_t)(b * 8 + h) * 256 + 8 * n + (row >> 5)) * 4 + (c8 >> 1)) * 64 + (c8 & 1) * 32 + (row & 31)) * 8) = o; }
        *(LAS u32x4*)(VL + row * 72 + 8 * c8) = lv[i];
    }
    if (LAYER == 0) {
#pragma unroll
        for (int e = 0; e < 8; ++e) RED[r0 * 64 + 8 * c8 + e] = ksum[e]; }
    __syncthreads();
    if (LAYER == 0 && tid < 64) { float s = 0.f;
        for (int r = 0; r < 64; ++r) s += RED[r * 64 + tid];
        ((float*)(ws + WS_KMEAN))[((size_t)(b * 8 + h) * 32 + n) * 64 + tid] = s * (1.f / 256.f); }
#pragma unroll
    for (int i = 0; i < 4; ++i) { const int idx = tid + 512 * i, ln = idx & 63, s = (idx >> 6) & 1, dt = (idx >> 7) & 1, kt = idx >> 8, l31 = ln & 31, hh = ln >> 5;
        const LAS bf16* vp = VL + (32 * kt + 16 * s + 4 * hh) * 72 + 32 * dt + l31;
        const unsigned short e0 = vp[0], e1 = vp[72], e2 = vp[144], e3 = vp[216], e4 = vp[8 * 72], e5 = vp[9 * 72], e6 = vp[10 * 72], e7 = vp[11 * 72];
        u32x4 o; o.x = e0 | ((unsigned)e1 << 16); o.y = e2 | ((unsigned)e3 << 16); o.z = e4 | ((unsigned)e5 << 16); o.w = e6 | ((unsigned)e7 << 16);
        *(u32x4*)(VF + (((((size_t)(b * 8 + h) * 256 + 8 * n + kt) * 2 + dt) * 2 + s) * 64 + ln) * 8) = o; }
    __syncthreads();
}

DI void moba_item(const Args& a, LAS unsigned char* lds, int item, int tid, int lane, int wave) {
    unsigned char* ws = a.ws;
    const bf16* PROJ = (const bf16*)(ws + WS_PROJ); const bf16* VT = (const bf16*)(ws + WS_VT); bf16* MIX = (bf16*)(ws + WS_MIX);
    const int bh = item & 31, m = item >> 5, b = bh >> 3, h = bh & 7;
    constexpr int QP = 72, SP = 68;
    LAS bf16* QS = (LAS bf16*)lds;
    LAS bf16* SLAB = (LAS bf16*)(lds + 36864);
    LAS float* KM = (LAS float*)(lds + 36864);
    LAS float* SL = (LAS float*)(lds + 141312);
    LAS unsigned short* LISTQ = (LAS unsigned short*)(lds + 144384);
    LAS unsigned short* SELROW = (LAS unsigned short*)(lds + 145920);
    LAS int* CNT = (LAS int*)(lds + 147968);
    LAS int* OFF = (LAS int*)(lds + 148096);
    LAS unsigned short* TILES = (LAS unsigned short*)(lds + 148224);
    LAS int* NTL = (LAS int*)(lds + 148352);
    const size_t mq0 = (size_t)b * T + 256 * m;
    {   const int row = tid >> 1, half = tid & 1; const bf16* src = PROJ + (mq0 + row) * NP + 1024 + 64 * h + 32 * half;
#pragma unroll
        for (int i = 0; i < 4; ++i) { const u32x4 v = *(const u32x4*)(src + 8 * i); u32x4 o;
#pragma unroll
            for (int e = 0; e < 4; ++e) o[e] = pk2(bflo(v[e]) * (0.125f * 1.4426950408889634f), bfhi(v[e]) * (0.125f * 1.4426950408889634f));
            *(LAS u32x4*)(QS + row * QP + 32 * half + 8 * i) = o; } }
    {   const float* km = (const float*)(ws + WS_KMEAN) + (size_t)(b * 8 + h) * 2048;
        for (int i = tid; i < m * 64; i += NTHR) KM[i] = km[i]; }
    if (tid < 32) CNT[tid] = 0;
    __syncthreads();
    int i0 = 255, i1 = 255, i2 = 255, ps0 = 0, ps1 = 0, ps2 = 0;
    if (tid < 256 && m > 0) {
        float q[64];
#pragma unroll
        for (int i = 0; i < 8; ++i) { const u32x4 v = *(const LAS u32x4*)(QS + tid * QP + 8 * i);
#pragma unroll
            for (int e = 0; e < 4; ++e) { q[8 * i + 2 * e] = bflo(v[e]); q[8 * i + 2 * e + 1] = bfhi(v[e]); } }
        float v0 = -INFINITY, v1 = -INFINITY, v2 = -INFINITY;
        for (int n = 0; n < m; ++n) { float dot = 0.f;
#pragma unroll
            for (int d4 = 0; d4 < 16; ++d4) { const f32x4 kv = *(const LAS f32x4*)(KM + n * 64 + 4 * d4); dot += q[4 * d4] * kv.x + q[4 * d4 + 1] * kv.y + q[4 * d4 + 2] * kv.z + q[4 * d4 + 3] * kv.w; }
            if (dot > v0) { v2 = v1; i2 = i1; v1 = v0; i1 = i0; v0 = dot; i0 = n; }
            else if (dot > v1) { v2 = v1; i2 = i1; v1 = dot; i1 = n; }
            else if (dot > v2) { v2 = dot; i2 = n; } }
        if (i0 != 255) ps0 = __hip_atomic_fetch_add(CNT + i0, 1, __ATOMIC_RELAXED, __HIP_MEMORY_SCOPE_WORKGROUP);
        if (i1 != 255) ps1 = __hip_atomic_fetch_add(CNT + i1, 1, __ATOMIC_RELAXED, __HIP_MEMORY_SCOPE_WORKGROUP);
        if (i2 != 255) ps2 = __hip_atomic_fetch_add(CNT + i2, 1, __ATOMIC_RELAXED, __HIP_MEMORY_SCOPE_WORKGROUP);
    }
    __syncthreads();
    if (tid < 64) {
        const int c = (lane < m) ? CNT[lane] : 0, ntile = (c + 31) >> 5;
        int pc = c, ptile = ntile;
#pragma unroll
        for (int o = 1; o < 32; o <<= 1) { const int uc = __shfl_up(pc, o), ut = __shfl_up(ptile, o); if ((lane & 31) >= o) { pc += uc; ptile += ut; } }
        if (lane < 32) { OFF[lane] = pc - c; for (int qt = 0; qt < ntile; ++qt) TILES[ptile - ntile + qt] = (unsigned short)(lane | (qt << 8)); if (lane == 31) NTL[0] = ptile; }
    }
    __syncthreads();
    if (tid < 256) {
        unsigned short r0 = 0xffff, r1 = 0xffff, r2 = 0xffff;
        if (i0 != 255) { r0 = (unsigned short)(OFF[i0] + ps0); LISTQ[r0] = (unsigned short)tid; }
        if (i1 != 255) { r1 = (unsigned short)(OFF[i1] + ps1); LISTQ[r1] = (unsigned short)tid; }
        if (i2 != 255) { r2 = (unsigned short)(OFF[i2] + ps2); LISTQ[r2] = (unsigned short)tid; }
        SELROW[tid * 4] = r0; SELROW[tid * 4 + 1] = r1; SELROW[tid * 4 + 2] = r2;
    }
    __syncthreads();
    const float cb2 = ((const float*)(ws + WS_MOD))[2 * 4 * 3072] * 1.4426950408889634f;
    f32x16 sinit;
#pragma unroll
    for (int i = 0; i < 16; ++i) sinit[i] = -cb2;
    const int hh = lane >> 5, l31 = lane & 31, w = wave;
    const bf16* Kb = (const bf16*)(ws + WS_KF) + ((size_t)(b * 8 + h) * 256 * 4 * 64 + lane) * 8;
    const bf16* Vb = VT + ((size_t)(b * 8 + h) * 256 * 4 * 64 + lane) * 8;
    const int nt = NTL[0];
#define MOBA_LOADKV(AK, AV, key0) do { const size_t kt_ = (size_t)((key0) >> 5) * 2048; \
    _Pragma("unroll") for (int s = 0; s < 4; ++s) AK[s] = mk8(*(const u32x4*)(Kb + kt_ + s * 512)); \
    _Pragma("unroll") for (int dt = 0; dt < 2; ++dt) _Pragma("unroll") for (int s = 0; s < 2; ++s) AV[dt][s] = mk8(*(const u32x4*)(Vb + kt_ + (dt * 2 + s) * 512)); } while (0)
    for (int t = w; t < nt; t += 8) {
        const int tl = TILES[t], n = tl & 255, qt = tl >> 8, cnt = CNT[n], rowb = OFF[n] + 32 * qt;
        const bool valid = (32 * qt + l31) < cnt; const int qrow = valid ? (int)LISTQ[rowb + l31] : 0;
        bf16x8 bq[4];
#pragma unroll
        for (int s = 0; s < 4; ++s) bq[s] = *(const LAS bf16x8*)(QS + qrow * QP + 16 * s + 8 * hh);
        f32x16 o0 = zero16(), o1 = zero16(); f32x2 ls2; ls2.x = 0.f; ls2.y = 0.f;
        bf16x8 ak[4], av[2][2], akn[4], avn[2][2];
        MOBA_LOADKV(ak, av, 256 * n);
#define MOBA_STEP(AK, AV, AKN, AVN, knext) do { \
            MOBA_LOADKV(AKN, AVN, knext); \
            f32x16 sacc = sinit; \
            _Pragma("unroll") for (int s = 0; s < 4; ++s) sacc = MFMA32(AK[s], bq[s], sacc); \
            _Pragma("unroll") for (int i = 0; i < 16; i += 2) { f32x2 p2; p2.x = __builtin_amdgcn_exp2f(sacc[i]); p2.y = __builtin_amdgcn_exp2f(sacc[i + 1]); sacc[i] = p2.x; sacc[i + 1] = p2.y; ls2 += p2; } \
            const bf16x8 p0 = pack8(sacc[0], sacc[1], sacc[2], sacc[3], sacc[4], sacc[5], sacc[6], sacc[7]); \
            const bf16x8 p1 = pack8(sacc[8], sacc[9], sacc[10], sacc[11], sacc[12], sacc[13], sacc[14], sacc[15]); \
            o0 = MFMA32(AV[0][0], p0, o0); o0 = MFMA32(AV[0][1], p1, o0); o1 = MFMA32(AV[1][0], p0, o1); o1 = MFMA32(AV[1][1], p1, o1); } while (0)
#pragma unroll 1
        for (int ks = 0; ks < 8; ks += 2) {
            MOBA_STEP(ak, av, akn, avn, 256 * n + 32 * (ks + 1));
            MOBA_STEP(akn, avn, ak, av, 256 * n + 32 * (ks < 6 ? ks + 2 : ks + 1));
        }
        float lsum = ls2.x + ls2.y;
        lsum += __shfl_xor(lsum, 32);
        if (valid) {
            LAS bf16* sr = SLAB + (rowb + l31) * SP + 4 * hh;
#pragma unroll
            for (int k = 0; k < 4; ++k) { u32x2 wv; wv.x = pk2(o0[4 * k], o0[4 * k + 1]); wv.y = pk2(o0[4 * k + 2], o0[4 * k + 3]); *(LAS u32x2*)(sr + 8 * k) = wv;
                u32x2 wu; wu.x = pk2(o1[4 * k], o1[4 * k + 1]); wu.y = pk2(o1[4 * k + 2], o1[4 * k + 3]); *(LAS u32x2*)(sr + 32 + 8 * k) = wu; }
            if (hh == 0) SL[rowb + l31] = lsum;
        }
    }
    f32x16 o0 = zero16(), o1 = zero16(); float lsum = 0.f;
    {
        const int qrow = 32 * w + l31;
        bf16x8 bq[4];
#pragma unroll
        for (int s = 0; s < 4; ++s) bq[s] = *(const LAS bf16x8*)(QS + qrow * QP + 16 * s + 8 * hh);
        bf16x8 ak[4], av[2][2], akn[4], avn[2][2];
        MOBA_LOADKV(ak, av, 256 * m);
#pragma unroll 1
        for (int ks = 0; ks <= w; ++ks) {
            const int kn = 256 * m + 32 * (ks < w ? ks + 1 : ks);
            MOBA_LOADKV(akn, avn, kn);
            f32x16 sacc = sinit;
#pragma unroll
            for (int s = 0; s < 4; ++s) sacc = MFMA32(ak[s], bq[s], sacc);
#pragma unroll
            for (int i = 0; i < 16; ++i) { float p = __builtin_amdgcn_exp2f(sacc[i]); if (ks == w && crow(i, hh) > l31) p = 0.f; sacc[i] = p; lsum += p; }
            const bf16x8 p0 = pack8(sacc[0], sacc[1], sacc[2], sacc[3], sacc[4], sacc[5], sacc[6], sacc[7]);
            const bf16x8 p1 = pack8(sacc[8], sacc[9], sacc[10], sacc[11], sacc[12], sacc[13], sacc[14], sacc[15]);
            o0 = MFMA32(av[0][0], p0, o0); o0 = MFMA32(av[0][1], p1, o0); o1 = MFMA32(av[1][0], p0, o1); o1 = MFMA32(av[1][1], p1, o1);
#pragma unroll
            for (int s = 0; s < 4; ++s) ak[s] = akn[s];
#pragma unroll
            for (int dt = 0; dt < 2; ++dt) { av[dt][0] = avn[dt][0]; av[dt][1] = avn[dt][1]; }
        }
        lsum += __shfl_xor(lsum, 32);
    }
    __syncthreads();
    {
        const int qrow = 32 * w + l31;
#pragma unroll
        for (int j = 0; j < 3; ++j) { const int r = SELROW[qrow * 4 + j];
            if (r != 0xffff) { lsum += SL[r]; const LAS bf16* sr = SLAB + r * SP + 4 * hh;
#pragma unroll
                for (int k = 0; k < 4; ++k) { const u32x2 u0 = *(const LAS u32x2*)(sr + 8 * k), u1 = *(const LAS u32x2*)(sr + 32 + 8 * k);
                    o0[4 * k] += bflo(u0.x); o0[4 * k + 1] += bfhi(u0.x); o0[4 * k + 2] += bflo(u0.y); o0[4 * k + 3] += bfhi(u0.y);
                    o1[4 * k] += bflo(u1.x); o1[4 * k + 1] += bfhi(u1.x); o1[4 * k + 2] += bflo(u1.y); o1[4 * k + 3] += bfhi(u1.y); } } }
        const float inv = 1.f / lsum;
        LAS bf16* sl = QS + (32 * w) * QP;
#pragma unroll
        for (int dt = 0; dt < 2; ++dt)
#pragma unroll
            for (int k = 0; k < 4; ++k) { const f32x16& o = dt ? o1 : o0; u32x2 wv; wv.x = pk2(o[4 * k] * inv, o[4 * k + 1] * inv); wv.y = pk2(o[4 * k + 2] * inv, o[4 * k + 3] * inv);
                *(LAS u32x2*)(sl + l31 * QP + 32 * dt + 8 * k + 4 * hh) = wv; }
#pragma unroll
        for (int i = 0; i < 4; ++i) { const int c = lane + 64 * i, row = c >> 3, part = c & 7;
            const u32x4 ov = *(const LAS u32x4*)(sl + row * QP + 8 * part); const u32x4 gv = *(const u32x4*)(PROJ + (mq0 + 32 * w + row) * NP + 2560 + 64 * h + 8 * part);
            u32x4 wv;
#pragma unroll
            for (int e = 0; e < 4; ++e) wv[e] = pk2(bflo(ov[e]) * silu(bflo(gv[e])), bfhi(ov[e]) * silu(bfhi(gv[e])));
            *(u32x4*)(MIX + (mq0 + 32 * w + row) * 1024 + 512 + 64 * h + 8 * part) = wv; }
    }
    __syncthreads();
#undef MOBA_LOADKV
#undef MOBA_STEP
}

DI void sb_item(const Args& a, LAS unsigned char* slab, int item, int lane) {
    unsigned char* ws = a.ws;
    const bf16* PROJ = (const bf16*)(ws + WS_PROJ); const bf16* VT = (const bf16*)(ws + WS_VT); const bf16* KF = (const bf16*)(ws + WS_KF); bf16* MIX = (bf16*)(ws + WS_MIX);
    const int qt = 255 - (item >> 5), bh = item & 31, b = bh >> 3, h = bh & 7;
    const int hh = lane >> 5, l31 = lane & 31;
    const size_t mq = (size_t)b * T + 32 * qt + l31;
    bf16x8 bq[4];
#pragma unroll
    for (int s = 0; s < 4; ++s) bq[s] = mk8(*(const u32x4*)(PROJ + mq * NP + 64 * h + 16 * s + 8 * hh));
    f32x16 o0 = zero16(), o1 = zero16();
    float carry = 0.f;
    const size_t kfb = (size_t)(b * 8 + h) * 256 * 2048 + lane * 8;
#define SB_LOADKV(AK, AV, kt_) do { const size_t kb_ = kfb + (size_t)(kt_) * 2048; \
    _Pragma("unroll") for (int s = 0; s < 4; ++s) AK[s] = mk8(*(const u32x4*)(KF + kb_ + s * 512)); \
    _Pragma("unroll") for (int dt = 0; dt < 2; ++dt) _Pragma("unroll") for (int s = 0; s < 2; ++s) AV[dt][s] = mk8(*(const u32x4*)(VT + kb_ + (dt * 2 + s) * 512)); } while (0)
    bf16x8 ak[4], av[2][2], akn[4], avn[2][2];
    SB_LOADKV(ak, av, qt);
#pragma unroll 1
    for (int kt = qt; kt >= 0; --kt) {
        SB_LOADKV(akn, avn, (kt > 0 ? kt - 1 : 0));
        f32x16 z = zero16();
#pragma unroll
        for (int s = 0; s < 4; ++s) z = MFMA32(ak[s], bq[s], z);
        float kp[16], bt[16];
        if (kt == qt) {
#pragma unroll
            for (int i = 0; i < 16; ++i) { const float zz = __builtin_amdgcn_fmed3f(z[i] * 0.125f, -80.f, 80.f); const bool strict = crow(i, hh) < l31;
                const float t = __expf(-zz), r = __builtin_amdgcn_rcpf(1.f + t);
                kp[i] = strict ? t * r : 1.f; bt[i] = strict ? r : 0.f; }
        } else {
#pragma unroll
            for (int i = 0; i < 16; ++i) { const float zz = __builtin_amdgcn_fmed3f(z[i] * 0.125f, -80.f, 80.f);
                const float t = __expf(-zz), r = __builtin_amdgcn_rcpf(1.f + t);
                kp[i] = t * r; bt[i] = r; }
        }
        float gs[4], go[4];
#pragma unroll
        for (int k = 0; k < 4; ++k) { gs[k] = (kp[4 * k] * kp[4 * k + 1]) * (kp[4 * k + 2] * kp[4 * k + 3]); go[k] = __shfl_xor(gs[k], 32); }
        float after[4]; float run = 1.f;
#pragma unroll
        for (int k = 3; k >= 0; --k) { after[k] = hh ? run : run * go[k]; run *= gs[k] * go[k]; }
        const float base = __expf(carry);
        float wv[16];
#pragma unroll
        for (int k = 0; k < 4; ++k) { float suf = base * after[k];
#pragma unroll
            for (int e = 3; e >= 0; --e) { wv[4 * k + e] = bt[4 * k + e] * suf; suf *= kp[4 * k + e]; } }
        carry += __logf(run);
        const bf16x8 p0 = pack8(wv[0], wv[1], wv[2], wv[3], wv[4], wv[5], wv[6], wv[7]);
        const bf16x8 p1 = pack8(wv[8], wv[9], wv[10], wv[11], wv[12], wv[13], wv[14], wv[15]);
        o0 = MFMA32(av[0][0], p0, o0); o0 = MFMA32(av[0][1], p1, o0);
        o1 = MFMA32(av[1][0], p0, o1); o1 = MFMA32(av[1][1], p1, o1);
        if (__all(carry < -104.f)) break;
#pragma unroll
        for (int s = 0; s < 4; ++s) ak[s] = akn[s];
#pragma unroll
        for (int dt = 0; dt < 2; ++dt) { av[dt][0] = avn[dt][0]; av[dt][1] = avn[dt][1]; }
    }
#undef SB_LOADKV
    {
        LAS bf16* sl = (LAS bf16*)slab;
#pragma unroll
        for (int dt = 0; dt < 2; ++dt)
#pragma unroll
            for (int k = 0; k < 4; ++k) { const f32x16& o = dt ? o1 : o0; u32x2 w; w.x = pk2(o[4 * k], o[4 * k + 1]); w.y = pk2(o[4 * k + 2], o[4 * k + 3]);
                *(LAS u32x2*)(sl + l31 * 72 + 32 * dt + 8 * k + 4 * hh) = w; }
        const size_t mb = (size_t)b * T + 32 * qt;
#pragma unroll
        for (int i = 0; i < 4; ++i) { const int c = lane + 64 * i, row = c >> 3, part = c & 7;
            const u32x4 ov = *(const LAS u32x4*)(sl + row * 72 + 8 * part); const u32x4 gv = *(const u32x4*)(PROJ + (mb + row) * NP + 1536 + 64 * h + 8 * part);
            u32x4 w;
#pragma unroll
            for (int e = 0; e < 4; ++e) w[e] = pk2(bflo(ov[e]) * silu(bflo(gv[e])), bfhi(ov[e]) * silu(bfhi(gv[e])));
            *(u32x4*)(MIX + (mb + row) * 1024 + 64 * h + 8 * part) = w; }
    }
}

DI void s5_pass1(const Args& a, LAS unsigned char* lds, int item, int tid, int lane, int wave) {
    unsigned char* ws = a.ws;
    const bf16* PROJ = (const bf16*)(ws + WS_PROJ); float* S5S = (float*)(ws + WS_S5S);
    const int g = item & 31, b = (item >> 5) & 3, ct = item >> 7;
    const int rt = wave & 3, kh = wave >> 2, hh = lane >> 5, l31 = lane & 31;
    constexpr int UP = 2064;
    LAS unsigned char* UL = lds + 16384;
#pragma unroll
    for (int i = 0; i < 8; ++i) { const int idx = tid + 512 * i, tok = idx >> 1, hf = idx & 1;
        const u32x4 v = *(const u32x4*)(PROJ + ((size_t)b * T + 2048 * ct + tok) * NP + 2048 + 16 * g + 8 * hf);
        *(LAS u32x4*)(UL + (tok >> 6) * UP + (tok & 63) * 32 + 16 * hf) = v; }
    __syncthreads();
    const unsigned char* vb = ws + WS_VBIG + ((size_t)((g * 4 + rt) * 64) * 64 + lane) * 16;
    f32x16 acc = zero16();
#pragma unroll 4
    for (int s = 32 * kh; s < 32 * kh + 32; ++s) { const bf16x8 A = mk8(*(const u32x4*)(vb + (size_t)s * 1024)); const bf16x8 Bf = *(const LAS bf16x8*)(UL + l31 * UP + s * 32 + 16 * hh); acc = MFMA32(A, Bf, acc); }
    LAS float* red = (LAS float*)lds;
    if (kh == 1) {
#pragma unroll
        for (int i = 0; i < 16; ++i) red[(rt * 16 + i) * 64 + lane] = acc[i]; }
    __syncthreads();
    if (kh == 0) {
        float* dst = S5S + ((size_t)((b * 32 + g) * 128 + 32 * ct + l31)) * 128 + 32 * rt;
#pragma unroll
        for (int k = 0; k < 4; ++k) { f32x4 o;
#pragma unroll
            for (int e = 0; e < 4; ++e) o[e] = acc[4 * k + e] + red[(rt * 16 + 4 * k + e) * 64 + lane];
            *(f32x4*)(dst + 8 * k + 4 * hh) = o; } }
    __syncthreads();
}
DI void s5_pass2(const Args& a, LAS unsigned char* lds, int item, int tid, int lane, int wave) {
    unsigned char* ws = a.ws;
    const bf16* PROJ = (const bf16*)(ws + WS_PROJ); const float* S5S = (const float*)(ws + WS_S5S); bf16* S5Y = (bf16*)(ws + WS_H);
    const int g = item & 31, b = (item >> 5) & 3, ct = item >> 7;
    constexpr int UP = 2064, XPP = 136;
    LAS unsigned char* FL = lds;
    LAS unsigned char* UL = lds + 65536;
    LAS bf16* XPl = (LAS bf16*)(lds + 65536 + 66048);
    {   const unsigned char* fsrc = ws + WS_F + (size_t)g * 65536;
#pragma unroll
        for (int i = 0; i < 8; ++i) { const int idx = tid + 512 * i; *(LAS u32x4*)(FL + idx * 16) = *(const u32x4*)(fsrc + (size_t)idx * 16); }
#pragma unroll
        for (int i = 0; i < 8; ++i) { const int idx = tid + 512 * i, tok = idx >> 1, half = idx & 1;
            const u32x4 v = *(const u32x4*)(PROJ + ((size_t)b * T + 2048 * ct + tok) * NP + 2048 + 16 * g + 8 * half);
            *(LAS u32x4*)(UL + (tok >> 6) * UP + (tok & 63) * 32 + 16 * half) = v; } }
    {
        const int p = lane; const float ar = ((const float*)(ws + WS_ABL))[(g * 64 + p) * 2], ai = ((const float*)(ws + WS_ABL))[(g * 64 + p) * 2 + 1];
        const float* Sp = S5S + (size_t)((b * 32 + g) * 128) * 128;
        LAS float* SEG = (LAS float*)(lds + 65536 + 66048 + 8704);
        const int seg = 4 * ct;
        {   float xr = 0.f, xi = 0.f, qr = 1.f, qi = 0.f;
            for (int c = wave * seg; c < (wave + 1) * seg; ++c) { const float sr = Sp[c * 128 + p], si = Sp[c * 128 + 64 + p];
                const float nr = ar * xr - ai * xi + sr, ni = ar * xi + ai * xr + si; xr = nr; xi = ni; const float tr = qr * ar - qi * ai, ti = qr * ai + qi * ar; qr = tr; qi = ti; }
            SEG[(wave * 4 + 0) * 64 + p] = xr; SEG[(wave * 4 + 1) * 64 + p] = xi; SEG[(wave * 4 + 2) * 64 + p] = qr; SEG[(wave * 4 + 3) * 64 + p] = qi; }
        __syncthreads();
        if (wave == 0) {
            float xr = 0.f, xi = 0.f;
#pragma unroll
            for (int w = 0; w < 8; ++w) { const float sr = SEG[(w * 4 + 0) * 64 + p], si = SEG[(w * 4 + 1) * 64 + p], qr = SEG[(w * 4 + 2) * 64 + p], qi = SEG[(w * 4 + 3) * 64 + p];
                const float nr = qr * xr - qi * xi + sr, ni = qr * xi + qi * xr + si; xr = nr; xi = ni; }
#pragma unroll 8
            for (int n = 0; n < 32; ++n) { XPl[n * XPP + p] = (bf16)f2bf(xr); XPl[n * XPP + 64 + p] = (bf16)f2bf(xi);
                const int c = 32 * ct + n; const float sr = Sp[c * 128 + p], si = Sp[c * 128 + 64 + p]; const float nr = ar * xr - ai * xi + sr, ni = ar * xi + ai * xr + si; xr = nr; xi = ni; }
        }
    }
    __syncthreads();
    const int hh = lane >> 5, l31 = lane & 31;
    f32x16 acc[4];
#pragma unroll
    for (int i = 0; i < 4; ++i) acc[i] = zero16();
#define S5_SEG(I0, SLO, SHI) do { _Pragma("unroll 2") for (int s = (SLO); s <= (SHI); ++s) { \
        const bf16x8 Bf = *(const LAS bf16x8*)(UL + l31 * UP + s * 32 + 16 * hh); bf16x8 Af[4]; \
        _Pragma("unroll") for (int i = (I0); i < 4; ++i) Af[i] = *(const LAS bf16x8*)(FL + (2 * (wave + 8 * i) - s + 1) * 1024 + lane * 16); \
        _Pragma("unroll") for (int i = (I0); i < 4; ++i) acc[i] = MFMA32(Af[i], Bf, acc[i]); } } while (0)
    S5_SEG(0, 0, 2 * wave + 1);
    S5_SEG(1, 2 * wave + 2, 2 * wave + 17);
    S5_SEG(2, 2 * wave + 18, 2 * wave + 33);
    S5_SEG(3, 2 * wave + 34, 2 * wave + 49);
#undef S5_SEG
#pragma unroll
    for (int ks = 0; ks < 8; ++ks) { const bf16x8 Bf = *(const LAS bf16x8*)(XPl + l31 * XPP + 16 * ks + 8 * hh);
#pragma unroll
        for (int i = 0; i < 4; ++i) { const int R = wave + 8 * i;
            const bf16x8 A = mk8(*(const u32x4*)(ws + WS_WBIG + ((size_t)((g * 32 + R) * 8 + ks) * 64 + lane) * 16)); acc[i] = MFMA32(A, Bf, acc[i]); } }
#pragma unroll
    for (int i = 0; i < 4; ++i) { const int R = wave + 8 * i;
#pragma unroll
        for (int k = 0; k < 4; ++k) { const int jj = k >> 1; const size_t tok = (size_t)b * T + 2048 * ct + 64 * l31 + 2 * R + jj;
            u32x2 w; w.x = pk2(acc[i][4 * k], acc[i][4 * k + 1]); w.y = pk2(acc[i][4 * k + 2], acc[i][4 * k + 3]);
            *(u32x2*)(S5Y + tok * 512 + 16 * g + 8 * (k & 1) + 4 * hh) = w; } }
    __syncthreads();
}

__global__ void __launch_bounds__(NTHR, 2) hybrid_fwd(Args a) {
    extern __shared__ __attribute__((aligned(16))) unsigned char lds_raw[];
    LAS unsigned char* lds = (LAS unsigned char*)lds_raw;
    cg::grid_group grid = cg::this_grid();
    const int tid = threadIdx.x, lane = tid & 63, wave = __builtin_amdgcn_readfirstlane(tid >> 6);
    const int bx = blockIdx.x, G = gridDim.x, gw = bx * NWAVES + wave, NGW = G * NWAVES;
    unsigned char* ws = a.ws;
    const float* MOD = (const float*)(ws + WS_MOD);
    bf16* H = (bf16*)(ws + WS_H); bf16* PROJ = (bf16*)(ws + WS_PROJ); bf16* MIX = (bf16*)(ws + WS_MIX);

    if (tid < 4) ((LAS unsigned*)(lds + LDS_BYTES - 16))[tid] = 0u;
    __syncthreads();
    XcdBarrier xbar = xcd_barrier_post((unsigned*)ws, (volatile LAS unsigned*)(lds + LDS_BYTES - 16));
    phase0(a, lds, tid, lane, wave);
    xcd_barrier(xbar);
    norm_rows(a.in[0], a.in[2], MOD, H, gw, NGW, lane);
    __syncthreads();
    s5_tables(a, lds, bx * NTHR + tid, G * NTHR);
    {
        const bf16* WT = (const bf16*)(ws + WS_WIN1); float* SHW = (float*)(ws + WS_SHW);
        for (int col = gw; col < NP; col += NGW) {
            const u32x4 w0 = *(const u32x4*)(WT + (size_t)col * D + 16 * lane), w1 = *(const u32x4*)(WT + (size_t)col * D + 16 * lane + 8);
            float wf[16];
#pragma unroll
            for (int e = 0; e < 4; ++e) { wf[2 * e] = bflo(w0[e]); wf[2 * e + 1] = bfhi(w0[e]); wf[8 + 2 * e] = bflo(w1[e]); wf[8 + 2 * e + 1] = bfhi(w1[e]); }
#pragma unroll
            for (int b = 0; b < 4; ++b) { const float* sh = MOD + (4 + b) * 3072 + 16 * lane; float s = 0.f;
#pragma unroll
                for (int e = 0; e < 16; ++e) s += sh[e] * wf[e];
                s = wave_sum(s); if (lane == 0) SHW[b * 3072 + col] = s; } } }
    xcd_barrier(xbar);
    {   pg8::Gemm g{H, (const bf16*)(ws + WS_WIN0), M, NP, D}; pg8::StaticOrder S; S.init(M, NP, G, bx); pg8::EpiStore E{PROJ, NP};
        pg8::gemm_phase<pg8::EpiStore, pg8::StaticOrder, true, true>(lds, g, S, E); }
    xcd_barrier(xbar);
    for (int it = bx; it < 1024; it += G) prep_item<0>(a, lds, it, tid);
    for (int it = bx; it < 512; it += G) lru_item<1>(a, lds, it, tid, lane, wave);
    {
        const bf16* WT = (const bf16*)(ws + WS_WIN1); bf16* W1S = (bf16*)(ws + WS_W1S); const float* gain = a.in[16];
        for (int c = bx * NTHR + tid; c < 4 * 3072 * 128; c += G * NTHR) { const int b = c / (3072 * 128), rem = c % (3072 * 128), k8 = (rem & 127) * 8;
            const u32x4 wv = *(const u32x4*)(WT + (size_t)rem * 8); const float* sc = MOD + (4 + b) * 3072 + 1024 + k8; u32x4 o;
#pragma unroll
            for (int e = 0; e < 4; ++e) o[e] = pk2(bflo(wv[e]) * gain[k8 + 2 * e] * (1.f + sc[2 * e]), bfhi(wv[e]) * gain[k8 + 2 * e + 1] * (1.f + sc[2 * e + 1]));
            *(u32x4*)(W1S + (size_t)c * 8) = o; } }
    xcd_barrier(xbar);
    if (G == 256) {
        const int xcd = bx & 7, j = bx >> 3;
#pragma unroll 1
        for (int r = 0; r < 4; ++r) { const int bh = 4 * xcd + r, m = (r & 1) ? 31 - j : j; moba_item(a, lds, m * 32 + bh, tid, lane, wave); }
    } else {
#pragma unroll 1
        for (int it = bx; it < 1024; it += G) moba_item(a, lds, 1023 - it, tid, lane, wave);
    }
    for (int it = bx; it < 512; it += G) lru_item<2>(a, lds, it, tid, lane, wave);
    xcd_barrier(xbar);
    {   pg8::Gemm g{MIX, (const bf16*)(ws + WS_WOUT0), M, D, D}; pg8::StaticOrder S; S.init(M, D, G, bx);
        pg8::EpiRes1 E{a.in[0], MOD + 2048, (bf16*)(ws + WS_X1B), (float*)(ws + WS_SS)};
        pg8::gemm_phase<pg8::EpiRes1, pg8::StaticOrder, true, true>(lds, g, S, E); }
    xcd_barrier(xbar);
    {   pg8::Gemm g{(const bf16*)(ws + WS_X1B), (const bf16*)(ws + WS_W1S), M, NP, D, (size_t)3072 * 1024 * 2}; pg8::StaticOrder S; S.init(M, NP, G, bx); pg8::EpiStoreN E{PROJ, NP, (const float*)(ws + WS_SS), (const float*)(ws + WS_SHW)};
        pg8::gemm_phase<pg8::EpiStoreN, pg8::StaticOrder, true, true>(lds, g, S, E); }
    xcd_barrier(xbar);
    for (int it = bx; it < 1024; it += G) prep_item<1>(a, lds, it, tid);
    for (int it = bx; it < 512; it += G) s5_pass1(a, lds, it, tid, lane, wave);
    xcd_barrier(xbar);
    for (int it = bx; it < 512; it += G) s5_pass2(a, lds, it, tid, lane, wave);
    if (G == 256) {
#pragma unroll 1
        for (int k = 0; k < 4; ++k) { const int bh = (bx & 7) + 8 * k, qi = 8 * (bx >> 3) + wave; sb_item(a, lds + wave * 4608, (qi << 5) | bh, lane); }
    } else {
        for (int it = gw; it < 8192; it += NGW) sb_item(a, lds + wave * 4608, it, lane);
    }
    xcd_barrier(xbar);
    {   pg8::Gemm g{H, (const bf16*)(ws + WS_WGLU), M, 1024, 512}; pg8::StaticOrder S; S.init(M, 1024, G, bx); pg8::EpiGlu E{a.in[31], PROJ, MIX};
        pg8::gemm_phase<pg8::EpiGlu, pg8::StaticOrder, true, true>(lds, g, S, E); }
    xcd_barrier(xbar);
    {   pg8::Gemm g{MIX, (const bf16*)(ws + WS_WOUT1), M, D, D}; pg8::StaticOrder S; S.init(M, D, G, bx); pg8::EpiRes2 E{(const bf16*)(ws + WS_X1B), a.out, MOD + 4 * 3072 + 2048};
        pg8::gemm_phase<pg8::EpiRes2, pg8::StaticOrder, true, true>(lds, g, S, E); }
    if (gridDim.y == 0x7fffu) grid.sync();
}

extern "C" void kernel_launch(void* const* d_in, const int* in_sizes, int n_in, void* d_out, int out_size, void* d_ws, size_t ws_size, hipStream_t stream) {
    static int grid = 0;
    if (grid == 0) {
        if (n_in != 33 || out_size != M * D || ws_size < WS_END) { fprintf(stderr, "kernel_launch: unexpected shapes (n_in %d out %d ws %zu)\n", n_in, out_size, ws_size); grid = -1; return; }
        int dev = 0, cus = 0, per_cu = 0;
        hipGetDevice(&dev); hipDeviceGetAttribute(&cus, hipDeviceAttributeMultiprocessorCount, dev);
        hipFuncSetAttribute((const void*)hybrid_fwd, hipFuncAttributeMaxDynamicSharedMemorySize, LDS_BYTES);
        hipOccupancyMaxActiveBlocksPerMultiprocessor(&per_cu, (const void*)hybrid_fwd, NTHR, LDS_BYTES);
        if (per_cu < 1) per_cu = 1;
        grid = cus * per_cu; if (grid > 256) grid = 256;
        (void)hipGetLastError();
    }
    if (grid < 0) return;
    if (hipMemsetAsync(d_ws, 0, 262144, stream) != hipSuccess) { fprintf(stderr, "kernel_launch: memset failed\n"); return; }
    Args a{};
    for (int i = 0; i < 33; ++i) a.in[i] = (const float*)d_in[i];
    a.out = (float*)d_out; a.ws = (unsigned char*)d_ws;
    void* args[] = {&a};
    hipError_t e = hipLaunchCooperativeKernel((const void*)hybrid_fwd, dim3(grid), dim3(NTHR), args, LDS_BYTES, stream);
    if (e != hipSuccess) fprintf(stderr, "cooperative launch failed: %s (grid %d)\n", hipGetErrorString(e), grid);
}
```

```cpp
#include <hip/hip_runtime.h>
#include <hip/hip_cooperative_groups.h>
#include <cstdio>
#include <cstdint>
namespace cg = cooperative_groups;
namespace pg8 {
#define PG8_LAS __attribute__((address_space(3)))
typedef unsigned short bf16_t;
typedef short bf16x8 __attribute__((ext_vector_type(8)));
typedef float f32x4 __attribute__((ext_vector_type(4)));
typedef unsigned u32x4 __attribute__((ext_vector_type(4)));
constexpr int BM = 256, BK = 64, HALF = 128, HTB = HALF * BK * 2  , STAGE_BYTES = 8 * HTB, NXCD = 8, WGM = 8;

__host__ __device__ __forceinline__ int lds_byte(int r, int c) { const int st = (r >> 4) * 2 + (c >> 5), rr = r & 15, cc = c & 31, ob = rr * 64 + cc * 2; return st * 1024 + (ob ^ (((ob >> 9) & 1) << 5)); }
__host__ __device__ __forceinline__ void stage_rc(int b, int& R, int& C) { const int st = b / 1024, sb = b % 1024, swz = sb ^ (((sb >> 9) & 1) << 5); R = (st >> 1) * 16 + swz / 64; C = (st & 1) * 32 + (swz % 64) / 2; }
__host__ __device__ __forceinline__ int perm32(int rho) { const int n = rho >> 4, i = rho & 15; return 8 * (i >> 2) + 4 * n + (i & 3); }

struct Unit { int pm, pn; };
struct Gemm { const bf16_t* A; const bf16_t* Bt; int M, N, K; size_t bstride; };

struct StaticOrder {
    int nM, nN, nwg, G, c;
    __host__ __device__ void init(int M, int N, int G_, int c_) { nM = M / BM; nN = N / BM; nwg = nM * nN; G = G_; c = c_; }
    __host__ __device__ bool next(int i, Unit& u) const {
        const long L = (long)i * G + c; if (L >= nwg) return false;
        int wgid = (int)L; { const int q = nwg / NXCD, r = nwg % NXCD, xcd = wgid % NXCD, off = wgid / NXCD; wgid = (xcd < r ? xcd * (q + 1) : r * (q + 1) + (xcd - r) * q) + off; }
        const int nig = WGM * nN, gid = wgid / nig, fm = gid * WGM, gsz = (nM - fm) < WGM ? (nM - fm) : WGM;
        u.pm = fm + ((wgid % nig) % gsz); u.pn = (wgid % nig) / gsz; return true;
    }
    __device__ __forceinline__ void a_ready(const Unit&) const {}
    __device__ __forceinline__ void done(const Unit&) const {}
};

typedef __bf16 hwbf2 __attribute__((ext_vector_type(2)));
typedef float f32x2p __attribute__((ext_vector_type(2)));
__device__ __forceinline__ unsigned pk2f(float lo, float hi) { f32x2p v; v.x = lo; v.y = hi; return __builtin_bit_cast(unsigned, __builtin_convertvector(v, hwbf2)); }
__device__ __forceinline__ float bflo(unsigned w) { return __builtin_bit_cast(float, w << 16); }
__device__ __forceinline__ float bfhi(unsigned w) { return __builtin_bit_cast(float, w & 0xffff0000u); }
struct EpiStore {
    static constexpr bool PERM = true, AFTER_DRAIN = false;
    bf16_t* O; int ldc;
    __device__ __forceinline__ void operator()(const f32x4 (&acc)[2][2][4][2], const Unit& u, int wr, int wc, int fr, int fq) const {
        const int row0 = u.pm * BM + wr * 64 + fr, col0 = u.pn * BM + wc * 32 + 8 * fq;
#pragma unroll
        for (int ai = 0; ai < 2; ++ai)
#pragma unroll
            for (int m = 0; m < 4; ++m) { bf16_t* rowp = O + (size_t)(row0 + ai * HALF + m * 16) * ldc + col0;
#pragma unroll
                for (int bj = 0; bj < 2; ++bj) { const f32x4 v0 = acc[ai][bj][m][0], v1 = acc[ai][bj][m][1];
                    u32x4 w; w.x = pk2f(v0[0], v0[1]); w.y = pk2f(v0[2], v0[3]); w.z = pk2f(v1[0], v1[1]); w.w = pk2f(v1[2], v1[3]);
                    *(u32x4*)(rowp + bj * HALF) = w; } }
    }
};
struct EpiRes {
    static constexpr bool PERM = false, AFTER_DRAIN = false;
    const float* X; float* O; const float* gate;
    __device__ __forceinline__ void operator()(const f32x4 (&acc)[2][2][4][2], const Unit& u, int wr, int wc, int fr, int fq) const {
        const int row0 = u.pm * BM + wr * 64 + fr, col0 = u.pn * BM + wc * 32 + 4 * fq, b = (u.pm * BM) >> 13;
        f32x4 gv[2][2];
#pragma unroll
        for (int bj = 0; bj < 2; ++bj)
#pragma unroll
            for (int n = 0; n < 2; ++n) gv[bj][n] = *(const f32x4*)(gate + b * 3072 + col0 + bj * HALF + n * 16);
#pragma unroll
        for (int ai = 0; ai < 2; ++ai)
#pragma unroll
            for (int m = 0; m < 4; ++m) { const size_t ro = (size_t)(row0 + ai * HALF + m * 16) * 1024 + col0;
#pragma unroll
                for (int bj = 0; bj < 2; ++bj)
#pragma unroll
                    for (int n = 0; n < 2; ++n) { const size_t idx = ro + bj * HALF + n * 16; const f32x4 xv = *(const f32x4*)(X + idx); *(f32x4*)(O + idx) = xv + gv[bj][n] * acc[ai][bj][m][n]; } }
    }
};
struct EpiRes1 {
    static constexpr bool PERM = true, AFTER_DRAIN = false;
    const float* X; const float* gate; bf16_t* X1B; float* SS;
    __device__ __forceinline__ void operator()(const f32x4 (&acc)[2][2][4][2], const Unit& u, int wr, int wc, int fr, int fq) const {
        const int row0 = u.pm * BM + wr * 64 + fr, col0 = u.pn * BM + wc * 32 + 8 * fq, b = (u.pm * BM) >> 13;
        f32x4 gv[2][2];
#pragma unroll
        for (int bj = 0; bj < 2; ++bj)
#pragma unroll
            for (int n = 0; n < 2; ++n) gv[bj][n] = *(const f32x4*)(gate + b * 3072 + col0 + bj * HALF + n * 4);
#pragma unroll
        for (int ai = 0; ai < 2; ++ai)
#pragma unroll
        for (int mh = 0; mh < 2; ++mh) {
            f32x4 xv[2][2][2];
#pragma unroll
            for (int mm = 0; mm < 2; ++mm)
#pragma unroll
                for (int bj = 0; bj < 2; ++bj) { const size_t idx = (size_t)(row0 + ai * HALF + (2 * mh + mm) * 16) * 1024 + col0 + bj * HALF; xv[mm][bj][0] = __builtin_nontemporal_load((const f32x4*)(X + idx)); xv[mm][bj][1] = __builtin_nontemporal_load((const f32x4*)(X + idx + 4)); }
#pragma unroll
            for (int mm = 0; mm < 2; ++mm) { const int m = 2 * mh + mm; const int row = row0 + ai * HALF + m * 16; const size_t ro = (size_t)row * 1024 + col0; float s = 0.f;
#pragma unroll
                for (int bj = 0; bj < 2; ++bj) { const size_t idx = ro + bj * HALF;
                    const f32x4 y0 = xv[mm][bj][0] + gv[bj][0] * acc[ai][bj][m][0], y1 = xv[mm][bj][1] + gv[bj][1] * acc[ai][bj][m][1];
                    s += ((y0[0] * y0[0] + y0[1] * y0[1]) + (y0[2] * y0[2] + y0[3] * y0[3])) + ((y1[0] * y1[0] + y1[1] * y1[1]) + (y1[2] * y1[2] + y1[3] * y1[3]));
                    u32x4 w; w.x = pk2f(y0[0], y0[1]); w.y = pk2f(y0[2], y0[3]); w.z = pk2f(y1[0], y1[1]); w.w = pk2f(y1[2], y1[3]); *(u32x4*)(X1B + idx) = w; }
                s += __shfl_xor(s, 16); s += __shfl_xor(s, 32);
                if (fq == 0) __hip_atomic_fetch_add(SS + row, s, __ATOMIC_RELAXED, __HIP_MEMORY_SCOPE_AGENT); }
        }
    }
};
struct EpiRes2 {
    static constexpr bool PERM = true, AFTER_DRAIN = false;
    const bf16_t* X1B; float* O; const float* gate;
    __device__ __forceinline__ void operator()(const f32x4 (&acc)[2][2][4][2], const Unit& u, int wr, int wc, int fr, int fq) const {
        const int row0 = u.pm * BM + wr * 64 + fr, col0 = u.pn * BM + wc * 32 + 8 * fq, b = (u.pm * BM) >> 13;
        f32x4 gv[2][2];
#pragma unroll
        for (int bj = 0; bj < 2; ++bj)
#pragma unroll
            for (int n = 0; n < 2; ++n) gv[bj][n] = *(const f32x4*)(gate + b * 3072 + col0 + bj * HALF + n * 4);
#pragma unroll
        for (int ai = 0; ai < 2; ++ai) {
            u32x4 xw[4][2];
#pragma unroll
            for (int m = 0; m < 4; ++m)
#pragma unroll
                for (int bj = 0; bj < 2; ++bj) xw[m][bj] = *(const u32x4*)(X1B + (size_t)(row0 + ai * HALF + m * 16) * 1024 + col0 + bj * HALF);
#pragma unroll
            for (int m = 0; m < 4; ++m) { const size_t ro = (size_t)(row0 + ai * HALF + m * 16) * 1024 + col0;
#pragma unroll
                for (int bj = 0; bj < 2; ++bj) { const size_t idx = ro + bj * HALF; const u32x4 q = xw[m][bj];
                    f32x4 x0, x1; x0[0] = bflo(q.x); x0[1] = bfhi(q.x); x0[2] = bflo(q.y); x0[3] = bfhi(q.y); x1[0] = bflo(q.z); x1[1] = bfhi(q.z); x1[2] = bflo(q.w); x1[3] = bfhi(q.w);
                    *(f32x4*)(O + idx) = x0 + gv[bj][0] * acc[ai][bj][m][0]; *(f32x4*)(O + idx + 4) = x1 + gv[bj][1] * acc[ai][bj][m][1]; } }
        }
    }
};
struct EpiStoreN {
    static constexpr bool PERM = true, AFTER_DRAIN = false;
    bf16_t* O; int ldc; const float* SS; const float* shw;
    __device__ __forceinline__ void operator()(const f32x4 (&acc)[2][2][4][2], const Unit& u, int wr, int wc, int fr, int fq) const {
        const int row0 = u.pm * BM + wr * 64 + fr, col0 = u.pn * BM + wc * 32 + 8 * fq, b = (u.pm * BM) >> 13;
        f32x4 sw[2][2];
#pragma unroll
        for (int bj = 0; bj < 2; ++bj) { sw[bj][0] = *(const f32x4*)(shw + b * 3072 + col0 + bj * HALF); sw[bj][1] = *(const f32x4*)(shw + b * 3072 + col0 + bj * HALF + 4); }
        float ssv[2][4];
#pragma unroll
        for (int ai = 0; ai < 2; ++ai)
#pragma unroll
            for (int m = 0; m < 4; ++m) ssv[ai][m] = SS[row0 + ai * HALF + m * 16];
#pragma unroll
        for (int ai = 0; ai < 2; ++ai)
#pragma unroll
            for (int m = 0; m < 4; ++m) { const int row = row0 + ai * HALF + m * 16; bf16_t* rowp = O + (size_t)row * ldc + col0;
                const float rstd = __builtin_amdgcn_rsqf(ssv[ai][m] * (1.f / 1024.f) + 1e-6f);
#pragma unroll
                for (int bj = 0; bj < 2; ++bj) { const f32x4 v0 = acc[ai][bj][m][0] * rstd + sw[bj][0], v1 = acc[ai][bj][m][1] * rstd + sw[bj][1];
                    u32x4 w; w.x = pk2f(v0[0], v0[1]); w.y = pk2f(v0[2], v0[3]); w.z = pk2f(v1[0], v1[1]); w.w = pk2f(v1[2], v1[3]);
                    *(u32x4*)(rowp + bj * HALF) = w; } }
    }
};
struct EpiGlu {
    static constexpr bool PERM = true, AFTER_DRAIN = false;
    const float* bias; const bf16_t* proj; bf16_t* mix;
    __device__ __forceinline__ void operator()(const f32x4 (&acc)[2][2][4][2], const Unit& u, int wr, int wc, int fr, int fq) const {
        const int row0 = u.pm * BM + wr * 64 + fr, colv = u.pn * 128 + wc * 32 + 8 * fq;
        const f32x4 bv0 = *(const f32x4*)(bias + colv), bv1 = *(const f32x4*)(bias + colv + 4), bg0 = *(const f32x4*)(bias + 512 + colv), bg1 = *(const f32x4*)(bias + 512 + colv + 4);
        u32x4 gsv[2][4];
#pragma unroll
        for (int ai = 0; ai < 2; ++ai)
#pragma unroll
            for (int m = 0; m < 4; ++m) gsv[ai][m] = *(const u32x4*)(proj + (size_t)(row0 + ai * HALF + m * 16) * 3072 + 2560 + colv);
#pragma unroll
        for (int ai = 0; ai < 2; ++ai)
#pragma unroll
            for (int m = 0; m < 4; ++m) { const size_t row = (size_t)(row0 + ai * HALF + m * 16);
                const u32x4 gs = gsv[ai][m];
                const f32x4 va = acc[ai][0][m][0] + bv0, vb = acc[ai][0][m][1] + bv1, ga = acc[ai][1][m][0] + bg0, gb = acc[ai][1][m][1] + bg1;
                float y[8];
#pragma unroll
                for (int e = 0; e < 4; ++e) { const float g0 = (e & 1) ? bfhi(gs[e >> 1]) : bflo(gs[e >> 1]); const float g1 = (e & 1) ? bfhi(gs[2 + (e >> 1)]) : bflo(gs[2 + (e >> 1)]);
                    y[e] = va[e] * __builtin_amdgcn_rcpf(1.f + __expf(-ga[e])) * (g0 * __builtin_amdgcn_rcpf(1.f + __expf(-g0))); y[4 + e] = vb[e] * __builtin_amdgcn_rcpf(1.f + __expf(-gb[e])) * (g1 * __builtin_amdgcn_rcpf(1.f + __expf(-g1))); }
                u32x4 w; w.x = pk2f(y[0], y[1]); w.y = pk2f(y[2], y[3]); w.z = pk2f(y[4], y[5]); w.w = pk2f(y[6], y[7]);
                *(u32x4*)(mix + row * 1024 + 512 + colv) = w; }
    }
};
template <class Epi, class Sched, bool ALIGN_EPI = false, bool SP2 = false>
__device__ __forceinline__ void gemm_phase(PG8_LAS unsigned char* lds, const Gemm g, const Sched& S, const Epi& E) {
    int tid_ = threadIdx.x; asm volatile("" : "+v"(tid_));
    const int tid = tid_, wid = __builtin_amdgcn_readfirstlane(tid >> 6), lane = tid & 63, wr = wid >> 2, wc = wid & 3, fr = lane & 15, fq = lane >> 4;
    const int K = g.K, nt = K / BK;
    unsigned voffA[2], voffB[2];
#pragma unroll
    for (int i = 0; i < 2; ++i) { int R, C; stage_rc(tid * 16 + i * 8192, R, C); const int Rb = Epi::PERM ? ((R & ~31) + perm32(R & 31)) : R;
        voffA[i] = (unsigned)(R * K + C) * 2u; voffB[i] = (unsigned)(Rb * K + C) * 2u; }
    const size_t kstep = (size_t)(BK * 2);
    const size_t hstep = (size_t)HALF * K * 2;
    const size_t tstep = 2 * hstep;
    const unsigned ldsw = (unsigned)wid * 1024u;
    const int aoff = lds_byte(wr * 64 + fr, fq * 8), boff = lds_byte(wc * 32 + fr, fq * 8);
#define PG8_SA(b, h) (((b) * 2 + (h)) * HTB)
#define PG8_SB(b, h) ((4 + (b) * 2 + (h)) * HTB)
#define PG8_STAGE(bufoff, gbase, voff) do { _Pragma("unroll") for (int _i = 0; _i < 2; ++_i) \
        __builtin_amdgcn_global_load_lds((const unsigned*)((const char*)(gbase) + (voff)[_i]), (PG8_LAS unsigned*)(lds + (bufoff) + ldsw + _i * 8192), 16, 0, 0); } while (0)
#define PG8_LDA(dst, b, h) do { _Pragma("unroll") for (int m = 0; m < 4; ++m) _Pragma("unroll") for (int k = 0; k < 2; ++k) dst[m][k] = *(const PG8_LAS bf16x8*)(lds + PG8_SA(b, h) + aoff + m * 2048 + k * 1024); } while (0)
#define PG8_LDB(dst, b, h) do { _Pragma("unroll") for (int n = 0; n < 2; ++n) _Pragma("unroll") for (int k = 0; k < 2; ++k) dst[n][k] = *(const PG8_LAS bf16x8*)(lds + PG8_SB(b, h) + boff + n * 2048 + k * 1024); } while (0)
#define PG8_MMA(ai, bj, At, Bt) do { __builtin_amdgcn_s_setprio(1); _Pragma("unroll") for (int m = 0; m < 4; ++m) _Pragma("unroll") for (int n = 0; n < 2; ++n) _Pragma("unroll") for (int k = 0; k < 2; ++k) \
        acc[ai][bj][m][n] = __builtin_amdgcn_mfma_f32_16x16x32_bf16(Bt[n][k], At[m][k], acc[ai][bj][m][n], 0, 0, 0); __builtin_amdgcn_s_setprio(0); } while (0)
#define PG8_WAIT_V(n) asm volatile("s_waitcnt vmcnt(" #n ")" ::: "memory")
#define PG8_WAIT_L(n) asm volatile("s_waitcnt lgkmcnt(" #n ")" ::: "memory")
#define PG8_BAR __builtin_amdgcn_s_barrier()
#define PG8_SCHED __builtin_amdgcn_sched_barrier(0)
    Unit cur, nxt; int ui = 0;
    if (!S.next(0, cur)) return;
    f32x4 acc[2][2][4][2];
#pragma unroll
    for (int a = 0; a < 2; ++a)
#pragma unroll
        for (int b = 0; b < 2; ++b)
#pragma unroll
            for (int m = 0; m < 4; ++m)
#pragma unroll
                for (int n = 0; n < 2; ++n) acc[a][b][m][n] = (f32x4){0.f, 0.f, 0.f, 0.f};
    bf16x8 At[4][2], B0[2][2], B1[2][2];
    const char* cA = (const char*)g.A + (size_t)cur.pm * tstep; const char* cB = (const char*)g.Bt + (size_t)cur.pn * tstep + (size_t)(cur.pm >> 5) * g.bstride;
    S.a_ready(cur);
    if constexpr (SP2) {
        PG8_STAGE(PG8_SB(0, 0), cB, voffB); PG8_STAGE(PG8_SB(0, 1), cB + hstep, voffB); PG8_STAGE(PG8_SA(0, 0), cA, voffA); PG8_STAGE(PG8_SA(0, 1), cA + hstep, voffA);
        if (wr == 1) PG8_BAR;
        PG8_WAIT_V(2); PG8_BAR;
        PG8_STAGE(PG8_SB(1, 0), cB + kstep, voffB); PG8_STAGE(PG8_SA(1, 0), cA + kstep, voffA); PG8_STAGE(PG8_SB(1, 1), cB + hstep + kstep, voffB);
        PG8_WAIT_V(6); PG8_BAR;
    } else {
        PG8_STAGE(PG8_SB(0, 0), cB, voffB); PG8_STAGE(PG8_SA(0, 0), cA, voffA); PG8_STAGE(PG8_SB(0, 1), cB + hstep, voffB); PG8_STAGE(PG8_SA(0, 1), cA + hstep, voffA);
        if (wr == 1) PG8_BAR;
        PG8_WAIT_V(4); PG8_BAR;
        PG8_STAGE(PG8_SB(1, 0), cB + kstep, voffB); PG8_STAGE(PG8_SA(1, 0), cA + kstep, voffA); PG8_STAGE(PG8_SB(1, 1), cB + hstep + kstep, voffB);
        PG8_WAIT_V(6); PG8_BAR;
    }
    for (;;) {
        const bool has_next = S.next(ui + 1, nxt);
        const char* nA = has_next ? (const char*)g.A + (size_t)nxt.pm * tstep : cA; const char* nB = has_next ? (const char*)g.Bt + (size_t)nxt.pn * tstep + (size_t)(nxt.pm >> 5) * g.bstride : cB;
        for (int t = 0; t < nt; t += 2) {
            const bool last = (t == nt - 2);
            const char* a1 = cA + (size_t)(t + 1) * kstep;
            const char* a2 = last ? nA : cA + (size_t)(t + 2) * kstep; const char* b2 = last ? nB : cB + (size_t)(t + 2) * kstep;
            const char* a3 = a2 + kstep; const char* b3 = b2 + kstep;
            if (last && has_next) S.a_ready(nxt);
            if constexpr (SP2) {
            PG8_LDB(B0, 0, 0); PG8_LDB(B1, 0, 1); PG8_SCHED; PG8_LDA(At, 0, 0); PG8_STAGE(PG8_SA(1, 1), a1 + hstep, voffA);
            PG8_WAIT_V(8); PG8_WAIT_L(0); PG8_BAR; PG8_MMA(0, 0, At, B0); PG8_MMA(0, 1, At, B1); PG8_BAR; PG8_SCHED;
            PG8_LDA(At, 0, 1); PG8_STAGE(PG8_SB(0, 0), b2, voffB); PG8_STAGE(PG8_SB(0, 1), b2 + hstep, voffB); PG8_STAGE(PG8_SA(0, 0), a2, voffA);
            PG8_WAIT_V(8); PG8_WAIT_L(0); PG8_BAR; PG8_MMA(1, 0, At, B0); PG8_MMA(1, 1, At, B1); PG8_BAR; PG8_SCHED;
            PG8_LDB(B0, 1, 0); PG8_LDB(B1, 1, 1); PG8_SCHED; PG8_LDA(At, 1, 0); PG8_STAGE(PG8_SA(0, 1), a2 + hstep, voffA);
            PG8_WAIT_V(8); PG8_WAIT_L(0); PG8_BAR; PG8_MMA(0, 0, At, B0); PG8_MMA(0, 1, At, B1); PG8_BAR; PG8_SCHED;
            PG8_LDA(At, 1, 1); PG8_STAGE(PG8_SB(1, 0), b3, voffB); PG8_STAGE(PG8_SB(1, 1), b3 + hstep, voffB); PG8_STAGE(PG8_SA(1, 0), a3, voffA);
            PG8_WAIT_V(8); PG8_WAIT_L(0); PG8_BAR; PG8_MMA(1, 0, At, B0); PG8_MMA(1, 1, At, B1); PG8_BAR; PG8_SCHED;
            } else {
            PG8_LDB(B0, 0, 0); PG8_SCHED; PG8_LDA(At, 0, 0); PG8_STAGE(PG8_SA(1, 1), a1 + hstep, voffA);
            PG8_WAIT_L(8); PG8_BAR; PG8_WAIT_L(0); PG8_MMA(0, 0, At, B0); PG8_BAR; PG8_SCHED;
            PG8_LDB(B1, 0, 1); PG8_STAGE(PG8_SB(0, 0), b2, voffB);
            PG8_BAR; PG8_WAIT_L(0); PG8_MMA(0, 1, At, B1); PG8_BAR;
            PG8_LDA(At, 0, 1); PG8_STAGE(PG8_SA(0, 0), a2, voffA);
            PG8_BAR; PG8_WAIT_L(0); PG8_MMA(1, 0, At, B0); PG8_BAR; PG8_SCHED;
            PG8_STAGE(PG8_SB(0, 1), b2 + hstep, voffB);
            PG8_WAIT_V(6); PG8_BAR; PG8_MMA(1, 1, At, B1); PG8_BAR;
            PG8_LDB(B0, 1, 0); PG8_SCHED; PG8_LDA(At, 1, 0); PG8_STAGE(PG8_SA(0, 1), a2 + hstep, voffA);
            PG8_WAIT_L(8); PG8_BAR; PG8_WAIT_L(0); PG8_MMA(0, 0, At, B0); PG8_BAR; PG8_SCHED;
            PG8_LDB(B1, 1, 1); PG8_STAGE(PG8_SB(1, 0), b3, voffB);
            PG8_BAR; PG8_WAIT_L(0); PG8_MMA(0, 1, At, B1); PG8_BAR;
            PG8_LDA(At, 1, 1); PG8_STAGE(PG8_SA(1, 0), a3, voffA);
            PG8_BAR; PG8_WAIT_L(0); PG8_MMA(1, 0, At, B0); PG8_BAR; PG8_SCHED;
            PG8_STAGE(PG8_SB(1, 1), b3 + hstep, voffB);
            PG8_WAIT_V(6); PG8_BAR; PG8_MMA(1, 1, At, B1); PG8_BAR;
            }
        }
        if constexpr (ALIGN_EPI) { if (wr == 0) PG8_BAR; }
        if constexpr (!Epi::AFTER_DRAIN) { E(acc, cur, wr, wc, fr, fq); S.done(cur); }
        if (!has_next) break;
#pragma unroll
        for (int a = 0; a < 2; ++a)
#pragma unroll
            for (int b = 0; b < 2; ++b)
#pragma unroll
                for (int m = 0; m < 4; ++m)
#pragma unroll
                    for (int n = 0; n < 2; ++n) acc[a][b][m][n] = (f32x4){0.f, 0.f, 0.f, 0.f};
        cur = nxt; cA = nA; cB = nB; ++ui;
        if constexpr (ALIGN_EPI) { if (wr == 1) PG8_BAR; }
    }
    PG8_WAIT_V(0);
    if constexpr (!ALIGN_EPI) { if (wr == 0) PG8_BAR; }
    PG8_BAR;
    if constexpr (Epi::AFTER_DRAIN) { E.fused(acc, cur, wr, wc, fr, fq, lds, wid, lane); S.done(cur); }
#undef PG8_SA
#undef PG8_SB
#undef PG8_STAGE
#undef PG8_LDA
#undef PG8_LDB
#undef PG8_MMA
#undef PG8_WAIT_V
#undef PG8_WAIT_L
#undef PG8_BAR
#undef PG8_SCHED
}
}
#define DI __device__ __forceinline__
#define LAS __attribute__((address_space(3)))
typedef unsigned short bf16;
typedef short bf16x8 __attribute__((ext_vector_type(8)));
typedef float f32x4 __attribute__((ext_vector_type(4)));
typedef float f32x2 __attribute__((ext_vector_type(2)));
typedef float f32x16 __attribute__((ext_vector_type(16)));
typedef unsigned u32x4 __attribute__((ext_vector_type(4)));
typedef unsigned u32x2 __attribute__((ext_vector_type(2)));
#define MFMA32(a, b, c) __builtin_amdgcn_mfma_f32_32x32x16_bf16((a), (b), (c), 0, 0, 0)

constexpr int NB = 4, T = 8192, D = 1024, M = NB * T, NP = 3072;
constexpr int NWAVES = 8, NTHR = 512;
constexpr int LDS_BYTES = 155648;
constexpr size_t MiB = 1u << 20;
constexpr size_t WS_MOD = 1 * MiB;
constexpr size_t WS_SS = 128 * 1024;
constexpr size_t WS_SHW = 1 * MiB + 256 * 1024;
constexpr size_t WS_GW = 1 * MiB + 512 * 1024;
constexpr size_t WS_ABL = 2 * MiB;
constexpr size_t WS_BB = 2 * MiB + 65536;
constexpr size_t WS_PW = 3 * MiB;
constexpr size_t WS_F = 5 * MiB;
constexpr size_t WS_VBIG = 8 * MiB;
constexpr size_t WS_WBIG = 16 * MiB;
constexpr size_t WS_WIN0 = 24 * MiB, WS_WOUT0 = 30 * MiB, WS_WIN1 = 32 * MiB, WS_WGLU = 38 * MiB, WS_WOUT1 = 39 * MiB;
constexpr size_t WS_KMEAN = 41 * MiB;
constexpr size_t WS_LRUSUM = 42 * MiB;
constexpr size_t WS_S5S = 44 * MiB;
constexpr size_t WS_VT = 52 * MiB;
constexpr size_t WS_H = 84 * MiB;
constexpr size_t WS_MIX = 148 * MiB;
constexpr size_t WS_PROJ = 212 * MiB;
constexpr size_t WS_KF = 404 * MiB;
constexpr size_t WS_X1B = 436 * MiB;
constexpr size_t WS_W1S = 116 * MiB;
constexpr size_t WS_END = 500 * MiB;

struct Args { const float* in[33]; float* out; unsigned char* ws; };

DI unsigned f2bf(float f) { unsigned u = __builtin_bit_cast(unsigned, f); return (u + 0x7fffu + ((u >> 16) & 1u)) >> 16; }
DI unsigned pk2(float lo, float hi) { return pg8::pk2f(lo, hi); }
DI float bf2f(unsigned short b) { return __builtin_bit_cast(float, (unsigned)b << 16); }
DI float bflo(unsigned w) { return __builtin_bit_cast(float, w << 16); }
DI float bfhi(unsigned w) { return __builtin_bit_cast(float, w & 0xffff0000u); }
DI int crow(int reg, int h) { return (reg & 3) + 8 * (reg >> 2) + 4 * h; }
DI float sigm(float x) { return __builtin_amdgcn_rcpf(1.f + __expf(-x)); }
DI float silu(float x) { return x * __builtin_amdgcn_rcpf(1.f + __expf(-x)); }
DI bf16x8 mk8(u32x4 v) { return __builtin_bit_cast(bf16x8, v); }
DI bf16x8 pack8(float a0, float a1, float a2, float a3, float a4, float a5, float a6, float a7) { u32x4 v; v.x = pk2(a0, a1); v.y = pk2(a2, a3); v.z = pk2(a4, a5); v.w = pk2(a6, a7); return __builtin_bit_cast(bf16x8, v); }
DI f32x16 zero16() { f32x16 z;
#pragma unroll
  for (int i = 0; i < 16; ++i) z[i] = 0.f; return z; }

#define XB_TMO      128
#define XB_XCNT(j)  (256  + 64 * (j))
#define XB_XSUB(j)  (1280 + 64 * (j))
#define XB_XGEN(j)  (2304 + 64 * (j))
#define XB_TOP      3328
#define XB_TOPGEN   3392
#define XCD_BAR_WORDS 3456
#define XB_SPIN_CAP (1u << 18)

__device__ __forceinline__ unsigned xb_ld(unsigned* p)              { return __hip_atomic_load(p, __ATOMIC_RELAXED, __HIP_MEMORY_SCOPE_AGENT); }
__device__ __forceinline__ unsigned xb_add(unsigned* p, unsigned v) { return __hip_atomic_fetch_add(p, v, __ATOMIC_RELAXED, __HIP_MEMORY_SCOPE_AGENT); }
__device__ __forceinline__ unsigned xb_xcc_id() { return (unsigned)__builtin_amdgcn_s_getreg((3 << 11) | 20) & 0xFu; }
#define XB_SPIN(cond, bar) do { unsigned _sp = 0; while (cond) { __builtin_amdgcn_s_sleep(1); \
    if ((++_sp & 255u) == 0u) { if (xb_ld(&(bar)[XB_TMO])) break; if (_sp > XB_SPIN_CAP) { atomicAdd(&(bar)[XB_TMO], 1u); break; } } } } while (0)

struct XcdBarrier {
    unsigned* bar; unsigned x;
    volatile LAS unsigned* st;
};

__device__ __forceinline__ XcdBarrier xcd_barrier_post(unsigned* bar, volatile LAS unsigned* st) {
    XcdBarrier b; b.bar = bar; b.x = xb_xcc_id(); b.st = st;
    if (threadIdx.x == 0) (void)xb_add(&bar[XB_XCNT(b.x)], 1u);
    return b;
}
__device__ __forceinline__ void xcd_barrier_complete(unsigned* bar, unsigned x, unsigned& nloc, unsigned& nx) {
    const unsigned G = gridDim.x * gridDim.y * gridDim.z;
    unsigned sum, cnt, mine, sp = 0u;
    for (;;) {
        sum = 0u; cnt = 0u; mine = 0u;
#pragma unroll
        for (unsigned j = 0; j < 16; ++j) { const unsigned c = xb_ld(&bar[XB_XCNT(j)]); sum += c; cnt += (c > 0u) ? 1u : 0u; mine = (j == x) ? c : mine; }
        if (sum == G) break;
        __builtin_amdgcn_s_sleep(1);
        if ((++sp & 255u) == 0u) { if (xb_ld(&bar[XB_TMO])) break; if (sp > XB_SPIN_CAP) { atomicAdd(&bar[XB_TMO], 1u); break; } }
    }
    nloc = mine > 0u ? mine : 1u; nx = cnt > 0u ? cnt : 1u;
}

__device__ __forceinline__ void xcd_barrier(const XcdBarrier& b) {
    asm volatile("s_waitcnt vmcnt(0)" ::: "memory");
    __syncthreads();
    if (threadIdx.x == 0) {
        unsigned* bar = b.bar;
        __builtin_amdgcn_s_waitcnt(0);
        unsigned nloc = b.st[0], nx = b.st[1];
        if (nloc == 0u) { xcd_barrier_complete(bar, b.x, nloc, nx); b.st[0] = nloc; b.st[1] = nx; }
        const unsigned old = xb_add(&bar[XB_XSUB(b.x)], 1u);
        const unsigned gen = old / nloc;
        if (old + 1u == (gen + 1u) * nloc) {
            __builtin_amdgcn_fence(__ATOMIC_RELEASE, "agent");
            asm volatile("s_waitcnt vmcnt(0)" ::: "memory");
            const unsigned og = xb_add(&bar[XB_TOP], 1u);
            const unsigned tg = og / nx;
            if (og + 1u == (tg + 1u) * nx) xb_add(&bar[XB_TOPGEN], 1u);
            else XB_SPIN(xb_ld(&bar[XB_TOPGEN]) == tg, bar);
            __builtin_amdgcn_fence(__ATOMIC_ACQUIRE, "agent");
            xb_add(&bar[XB_XGEN(b.x)], 1u);
            asm volatile("s_waitcnt vmcnt(0)" ::: "memory");
        } else {
            XB_SPIN(xb_ld(&bar[XB_XGEN(b.x)]) == gen, bar);
            __builtin_amdgcn_fence(__ATOMIC_ACQUIRE, "agent");
            asm volatile("s_waitcnt vmcnt(0)" ::: "memory");
        }
    }
    __syncthreads();
}

DI void transpose_item(const float* W, int K, int N, bf16* WT, int dst_row0, LAS float* scr, int kb, int nb, int lane) {
    const int k0 = 64 * kb, n0 = 32 * nb;
#pragma unroll 8
    for (int i = 0; i < 32; ++i) { const int kk = 2 * i + (lane >> 5); scr[kk * 33 + (lane & 31)] = __builtin_nontemporal_load(W + (size_t)(k0 + kk) * N + n0 + (lane & 31)); }
    asm volatile("s_waitcnt lgkmcnt(0)" ::: "memory");
    const int c = lane & 7;
#pragma unroll
    for (int j = 0; j < 4; ++j) { const int n = (lane >> 3) + 8 * j; const LAS float* s = scr + (8 * c) * 33 + n;
        u32x4 o; o.x = pk2(s[0 * 33], s[1 * 33]); o.y = pk2(s[2 * 33], s[3 * 33]); o.z = pk2(s[4 * 33], s[5 * 33]); o.w = pk2(s[6 * 33], s[7 * 33]);
        *(u32x4*)(WT + (size_t)(dst_row0 + n) * K + k0 + 8 * c) = o; }
    asm volatile("s_waitcnt lgkmcnt(0)" ::: "memory");
}

DI void phase0(const Args& a, LAS unsigned char* lds, int tid, int lane, int wave) {
    unsigned char* ws = a.ws;
    const int bx = blockIdx.x;
    if (bx < 192) {
        const int layer = bx / 96, cc = bx % 96, l31 = lane & 31, hh = lane >> 5, col = 32 * cc + l31;
        const float* W = layer ? a.in[17] : a.in[3]; const float* cv = a.in[1];
        LAS float* SC = (LAS float*)lds;
        LAS float* red = (LAS float*)(lds + 16384);
        for (int i = tid; i < 4096; i += NTHR) SC[i] = silu(cv[i]);
        __syncthreads();
        float a0 = 0.f, a1 = 0.f, a2 = 0.f, a3 = 0.f;
        const float* wp = W + (size_t)(128 * wave + hh) * 3072 + col;
#pragma unroll 1
        for (int i0 = 0; i0 < 64; i0 += 16) { float wv[16];
#pragma unroll
            for (int i = 0; i < 16; ++i) wv[i] = __builtin_nontemporal_load(wp + (size_t)(2 * (i0 + i)) * 3072);
#pragma unroll
            for (int i = 0; i < 16; ++i) { const int k = 128 * wave + 2 * (i0 + i) + hh; a0 += SC[k] * wv[i]; a1 += SC[1024 + k] * wv[i]; a2 += SC[2048 + k] * wv[i]; a3 += SC[3072 + k] * wv[i]; } }
        a0 += __shfl_xor(a0, 32); a1 += __shfl_xor(a1, 32); a2 += __shfl_xor(a2, 32); a3 += __shfl_xor(a3, 32);
        if (hh == 0) { red[(wave * 4 + 0) * 32 + l31] = a0; red[(wave * 4 + 1) * 32 + l31] = a1; red[(wave * 4 + 2) * 32 + l31] = a2; red[(wave * 4 + 3) * 32 + l31] = a3; }
        __syncthreads();
        if (tid < 128) { const int b = tid >> 5, l = tid & 31; float s = 0.f;
#pragma unroll
            for (int w = 0; w < 8; ++w) s += red[(w * 4 + b) * 32 + l];
            const float* bias = layer ? a.in[18] : a.in[4];
            ((float*)(ws + WS_MOD))[(layer * 4 + b) * 3072 + 32 * cc + l] = s + bias[32 * cc + l]; }
        __syncthreads();
    } else if (bx < 196) {
        const int gp = (bx - 192) * 512 + tid, g = gp >> 6;
        const float step = __expf(a.in[24][g]);
        const float lr = a.in[22][gp], li = a.in[23][gp];
        const float decay = __expf(lr * step);
        float rev = li * step * 0.15915494309189535f; rev -= floorf(rev);
        const float abr = decay * __builtin_amdgcn_cosf(rev), abi = decay * __builtin_amdgcn_sinf(rev);
        const float den = lr * lr + li * li;
        const float fr = ((abr - 1.f) * lr + abi * li) / den, fi = (abi * lr - (abr - 1.f) * li) / den;
        float* BB = (float*)(ws + WS_BB) + (size_t)gp * 32;
#pragma unroll
        for (int h = 0; h < 16; ++h) { const float br = a.in[25][gp * 16 + h], bi = a.in[26][gp * 16 + h]; BB[2 * h] = fr * br - fi * bi; BB[2 * h + 1] = fr * bi + fi * br; }
        float* PW = (float*)(ws + WS_PW) + ((size_t)g * 65 * 64 + (gp & 63)) * 2;
        float pr = 1.f, pi = 0.f;
        for (int t = 0; t < 64; ++t) { PW[(size_t)t * 128] = pr; PW[(size_t)t * 128 + 1] = pi; const float nr = pr * abr - pi * abi, ni = pr * abi + pi * abr; pr = nr; pi = ni; }
        PW[(size_t)64 * 128] = pr; PW[(size_t)64 * 128 + 1] = pi;
        float* ABL = (float*)(ws + WS_ABL) + gp * 2; ABL[0] = pr; ABL[1] = pi;
    }
    if (bx == 200 && tid == 0) { float gq = 0.f, gk = 0.f;
        for (int i = 0; i < 64; ++i) { gq = fmaxf(gq, fabsf(a.in[13][i])); gk = fmaxf(gk, fabsf(a.in[14][i])); }
        ((float*)(ws + WS_MOD))[2 * 4 * 3072] = 8.f * gq * gk; }
    if (bx >= 201 && bx < 217) {
        const int v = (bx - 201) * 512 + tid, ln = v & 63, s = (v >> 6) & 3, ct = (v >> 8) & 1, g = (v >> 9) & 7, gate = v >> 12, l31 = ln & 31, hh = ln >> 5;
        const float* wsrc = (gate ? a.in[10] : a.in[8]) + (size_t)g * 4096 + (16 * s + 8 * hh) * 64 + 32 * ct + l31;
        u32x4 o; o.x = pk2(wsrc[0], wsrc[64]); o.y = pk2(wsrc[128], wsrc[192]); o.z = pk2(wsrc[256], wsrc[320]); o.w = pk2(wsrc[384], wsrc[448]);
        *(u32x4*)(ws + WS_GW + (size_t)v * 16) = o; }
    LAS float* scr = (LAS float*)(lds + 16384 + wave * 8704);
    const int gw = bx * NWAVES + wave, NGW = gridDim.x * NWAVES;
    constexpr int I0 = 16 * 96, I1 = 16 * 32, I2 = 16 * 96, I3 = 8 * 32, I4 = 16 * 32;
    for (int it = gw; it < I0 + I1 + I2 + I3 + I4; it += NGW) {
        int r = it;
        if (r < I0) { transpose_item(a.in[5], 1024, 3072, (bf16*)(ws + WS_WIN0), 32 * (r % 96), scr, r / 96, r % 96, lane); continue; } r -= I0;
        if (r < I1) { transpose_item(a.in[15], 1024, 1024, (bf16*)(ws + WS_WOUT0), 32 * (r % 32), scr, r / 32, r % 32, lane); continue; } r -= I1;
        if (r < I2) { transpose_item(a.in[19], 1024, 3072, (bf16*)(ws + WS_WIN1), 32 * (r % 96), scr, r / 96, r % 96, lane); continue; } r -= I2;
        if (r < I3) { const int nb = r % 32, n0 = 32 * nb; const int nn = n0 & 511; const int dst = 256 * (nn >> 7) + (n0 >= 512 ? 128 : 0) + (nn & 127);
            transpose_item(a.in[30], 512, 1024, (bf16*)(ws + WS_WGLU), dst, scr, r / 32, nb, lane); continue; } r -= I3;
        transpose_item(a.in[32], 1024, 1024, (bf16*)(ws + WS_WOUT1), 32 * (r % 32), scr, r / 32, r % 32, lane);
    }
}

DI float wave_sum(float v) {
#pragma unroll
    for (int o = 1; o < 64; o <<= 1) v += __shfl_xor(v, o);
    return v;
}
DI void norm_rows(const float* xin, const float* gain, const float* modl, bf16* H, int gw, int NGW, int lane) {
    f32x4 gs[4], sh[4]; int curb = -1;
    for (int m = gw; m < M; m += NGW) {
        const f32x4* xr = (const f32x4*)(xin + (size_t)m * D) + lane;
        f32x4 v[4]; float s = 0.f;
#pragma unroll
        for (int j = 0; j < 4; ++j) v[j] = __builtin_nontemporal_load(xr + 64 * j);
        const int b = m >> 13;
        if (b != curb) { curb = b; const float* mb = modl + b * 3072;
#pragma unroll
            for (int j = 0; j < 4; ++j) { const int c = 4 * lane + 256 * j; gs[j] = *(const f32x4*)(gain + c) * (*(const f32x4*)(mb + 1024 + c) + 1.f); sh[j] = *(const f32x4*)(mb + c); } }
#pragma unroll
        for (int j = 0; j < 4; ++j) s += (v[j].x * v[j].x + v[j].y * v[j].y) + (v[j].z * v[j].z + v[j].w * v[j].w);
        const float rstd = rsqrtf(wave_sum(s) * (1.f / D) + 1e-6f);
        unsigned long long* o8 = (unsigned long long*)(H + (size_t)m * D) + lane;
#pragma unroll
        for (int j = 0; j < 4; ++j) { const f32x4 y = v[j] * rstd * gs[j] + sh[j];
            o8[64 * j] = (unsigned long long)pk2(y.x, y.y) | ((unsigned long long)pk2(y.z, y.w) << 32); }
    }
}

DI void s5_tables(const Args& a, LAS unsigned char* lds, int gt, int NT) {
    unsigned char* ws = a.ws;
    const float* PW = (const float*)(ws + WS_PW); const float* BB = (const float*)(ws + WS_BB);
    const float* cre = a.in[27]; const float* cim = a.in[28]; const float* dd = a.in[29];
    const bool staged = (NT == 32 * 64 * 16 * 4);
    LAS float* LB = (LAS float*)lds; LAS float* LP = LB + 2048; LAS float* LC = LP + 1024; LAS float* LI = LC + 1024;
    if (staged) { const int g = blockIdx.x >> 3, tau0 = (8 * blockIdx.x) & 63; const int t = threadIdx.x;
#pragma unroll
        for (int i = 0; i < 4; ++i) LB[t + 512 * i] = BB[(size_t)g * 2048 + t + 512 * i];
#pragma unroll
        for (int i = 0; i < 2; ++i) { LP[t + 512 * i] = PW[((size_t)(g * 65 + tau0) * 64) * 2 + t + 512 * i]; LC[t + 512 * i] = cre[g * 1024 + t + 512 * i]; LI[t + 512 * i] = cim[g * 1024 + t + 512 * i]; }
        __syncthreads(); }
    for (int v4 = gt; v4 < 32 * 64 * 16 * 4; v4 += NT) {
        const int v = v4 >> 2, pq = v4 & 3, g = v >> 10, tau = (v >> 4) & 63, h = v & 15;
        float acc[16];
#pragma unroll
        for (int e = 0; e < 16; ++e) acc[e] = 0.f;
        if (staged) {
#pragma unroll 4
            for (int pi = 0; pi < 16; ++pi) { const int p = 16 * pq + pi;
                const float cr = LC[h * 64 + p], ci = LI[h * 64 + p];
                const f32x2 pw = *(const LAS f32x2*)(LP + ((tau & 7) * 64 + p) * 2);
                const float wr = cr * pw.x - ci * pw.y, wi = cr * pw.y + ci * pw.x;
                const LAS f32x4* bb = (const LAS f32x4*)(LB + p * 32);
#pragma unroll
                for (int e2 = 0; e2 < 8; ++e2) { const f32x4 b4 = bb[e2]; acc[2 * e2] += wr * b4.x - wi * b4.y; acc[2 * e2 + 1] += wr * b4.z - wi * b4.w; }
            }
        } else {
#pragma unroll 4
        for (int pi = 0; pi < 16; ++pi) { const int p = 16 * pq + pi;
            const float cr = cre[(g * 16 + h) * 64 + p], ci = cim[(g * 16 + h) * 64 + p];
            const f32x2 pw = *(const f32x2*)(PW + ((size_t)(g * 65 + tau) * 64 + p) * 2);
            const float wr = cr * pw.x - ci * pw.y, wi = cr * pw.y + ci * pw.x;
            const f32x4* bb = (const f32x4*)(BB + (size_t)(g * 64 + p) * 32);
#pragma unroll
            for (int e2 = 0; e2 < 8; ++e2) { const f32x4 b4 = bb[e2]; acc[2 * e2] += wr * b4.x - wi * b4.y; acc[2 * e2 + 1] += wr * b4.z - wi * b4.w; }
        }
        }
#pragma unroll
        for (int e = 0; e < 16; ++e) { acc[e] += __shfl_xor(acc[e], 1); acc[e] += __shfl_xor(acc[e], 2); }
        if (pq != 0) continue;
        if (tau == 0) { const float dv = dd[g * 16 + h];
#pragma unroll
            for (int e = 0; e < 16; ++e) if (e == h) acc[e] += dv; }
        u32x4 lo, hi; lo.x = pk2(acc[0], acc[1]); lo.y = pk2(acc[2], acc[3]); lo.z = pk2(acc[4], acc[5]); lo.w = pk2(acc[6], acc[7]);
        hi.x = pk2(acc[8], acc[9]); hi.y = pk2(acc[10], acc[11]); hi.z = pk2(acc[12], acc[13]); hi.w = pk2(acc[14], acc[15]);
        unsigned char* fb = ws + WS_F + (size_t)g * 65536;
        if (tau + 1 < 64) { *(u32x4*)(fb + (size_t)((tau + 1) * 64 + h) * 16) = lo; *(u32x4*)(fb + (size_t)((tau + 1) * 64 + 32 + h) * 16) = hi; }
        *(u32x4*)(fb + (size_t)(tau * 64 + 16 + h) * 16) = lo; *(u32x4*)(fb + (size_t)(tau * 64 + 48 + h) * 16) = hi;
        if (tau == 0) { u32x4 z; z.x = 0u; z.y = 0u; z.z = 0u; z.w = 0u; *(u32x4*)(fb + (size_t)h * 16) = z; *(u32x4*)(fb + (size_t)(32 + h) * 16) = z; }
    }
    for (int vb_ = gt; vb_ < 32 * 4 * 64 * 64; vb_ += 4 * NT)
#pragma unroll
    for (int u_ = 0; u_ < 4; ++u_) { const int v = vb_ + u_ * NT; if (v >= 32 * 4 * 64 * 64) continue;
        const int g = v >> 14, rt = (v >> 12) & 3, s = (v >> 6) & 63, lane = v & 63, q = 32 * rt + (lane & 31), part = q >> 6, p = q & 63, hh = lane >> 5;
        const f32x2 pw = *(const f32x2*)(PW + ((size_t)(g * 65 + (63 - s)) * 64 + p) * 2);
        const float* bb = BB + ((size_t)(g * 64 + p) * 16 + 8 * hh) * 2;
        float o[8];
#pragma unroll
        for (int e = 0; e < 8; ++e) o[e] = part ? (pw.x * bb[2 * e + 1] + pw.y * bb[2 * e]) : (pw.x * bb[2 * e] - pw.y * bb[2 * e + 1]);
        u32x4 w; w.x = pk2(o[0], o[1]); w.y = pk2(o[2], o[3]); w.z = pk2(o[4], o[5]); w.w = pk2(o[6], o[7]);
        *(u32x4*)(ws + WS_VBIG + (size_t)v * 16) = w;
    }
    for (int vb_ = gt; vb_ < 32 * 32 * 8 * 64; vb_ += 4 * NT)
#pragma unroll
    for (int u_ = 0; u_ < 4; ++u_) { const int v = vb_ + u_ * NT; if (v >= 32 * 32 * 8 * 64) continue;
        const int g = v >> 14, R = (v >> 9) & 31, ks = (v >> 6) & 7, lane = v & 63, r = lane & 31, jj = r >> 4, h = r & 15, hh = lane >> 5, tok = 2 * R + jj, part = ks >> 2;
        float o[8];
#pragma unroll
        for (int e = 0; e < 8; ++e) { const int p = 16 * (ks & 3) + 8 * hh + e;
            const float cr = cre[(g * 16 + h) * 64 + p], ci = cim[(g * 16 + h) * 64 + p];
            const f32x2 pw = *(const f32x2*)(PW + ((size_t)(g * 65 + tok + 1) * 64 + p) * 2);
            o[e] = part ? -(cr * pw.y + ci * pw.x) : (cr * pw.x - ci * pw.y); }
        u32x4 w; w.x = pk2(o[0], o[1]); w.y = pk2(o[2], o[3]); w.z = pk2(o[4], o[5]); w.w = pk2(o[6], o[7]);
        *(u32x4*)(ws + WS_WBIG + (size_t)v * 16) = w;
    }
}
template <int PASS>
DI void lru_item(const Args& a, LAS unsigned char* lds, int item, int tid, int lane, int wave) {
    unsigned char* ws = a.ws;
    const bf16* PROJ = (const bf16*)(ws + WS_PROJ); bf16* MIX = (bf16*)(ws + WS_MIX); float* SUM = (float*)(ws + WS_LRUSUM);
    const int b = item >> 7, ch = item & 127; const size_t m0 = (size_t)b * T + 64 * ch;
    constexpr int XP = 520;
    LAS bf16* XC = (LAS bf16*)lds; LAS bf16* HB = (LAS bf16*)(lds + 66560);
    {
        LAS bf16* XR = HB;
        u32x4 xv[9];
#pragma unroll
        for (int i = 0; i < 9; ++i) { const int idx = tid + 512 * i, r = idx >> 6, c8 = idx & 63;
            xv[i].x = 0u; xv[i].y = 0u; xv[i].z = 0u; xv[i].w = 0u;
            if (idx < 67 * 64 && (ch > 0 || r >= 3)) xv[i] = (PASS == 2) ? __builtin_nontemporal_load((const u32x4*)(PROJ + (m0 + r - 3) * NP + 8 * c8)) : *(const u32x4*)(PROJ + (m0 + r - 3) * NP + 8 * c8); }
#pragma unroll
        for (int i = 0; i < 9; ++i) { const int idx = tid + 512 * i, r = idx >> 6, c8 = idx & 63;
            if (idx < 67 * 64) *(LAS u32x4*)(XR + r * XP + 8 * c8) = xv[i]; }
        __syncthreads();
        const int c = tid; const float* cw = a.in[6];
        const float w0 = cw[c], w1 = cw[512 + c], w2 = cw[1024 + c], w3 = cw[1536 + c], cb = a.in[7][c];
        float xm3 = bf2f(XR[c]), xm2 = bf2f(XR[XP + c]), xm1 = bf2f(XR[2 * XP + c]);
#pragma unroll 4
        for (int j = 0; j < 64; ++j) { const float x0 = bf2f(XR[(j + 3) * XP + c]); const float xc = w0 * xm3 + w1 * xm2 + w2 * xm1 + w3 * x0 + cb; XC[j * XP + c] = (bf16)f2bf(xc); xm3 = xm2; xm2 = xm1; xm1 = x0; }
    }
    LAS float* CAR = (LAS float*)(lds + 136448);
    if (PASS == 2) { float h = 0.f; const float* sp2 = SUM + ((size_t)(b * 128) * 512 + tid) * 2;
#pragma unroll 16
        for (int cc = 0; cc < ch; ++cc) { const f32x2 s2 = *(const f32x2*)(sp2 + (size_t)cc * 1024); h = s2.x * h + s2.y; }
        CAR[tid] = h; }
    __syncthreads();
    const int g = wave, hh = lane >> 5, l31 = lane & 31;
    const bf16* GW = (const bf16*)(ws + WS_GW);
#pragma unroll 1
    for (int ct = 0; ct < 2; ++ct) {
        const int j = 32 * ct + l31, c = 64 * g + j;
        bf16x8 Br[4], Bi[4];
#pragma unroll
        for (int s = 0; s < 4; ++s) { Br[s] = mk8(*(const u32x4*)(GW + ((size_t)(((0 * 8 + g) * 2 + ct) * 4 + s) * 64 + lane) * 8)); Bi[s] = mk8(*(const u32x4*)(GW + ((size_t)(((1 * 8 + g) * 2 + ct) * 4 + s) * 64 + lane) * 8)); }
        f32x16 Rr[2], Ii[2];
#pragma unroll
        for (int rt = 0; rt < 2; ++rt) { Rr[rt] = zero16(); Ii[rt] = zero16();
#pragma unroll
            for (int s = 0; s < 4; ++s) { const bf16x8 A = *(const LAS bf16x8*)(XC + (32 * rt + l31) * XP + 64 * g + 16 * s + 8 * hh); Rr[rt] = MFMA32(A, Br[s], Rr[rt]); Ii[rt] = MFMA32(A, Bi[s], Ii[rt]); } }
        const float rb = a.in[9][c], ib = a.in[11][c];
        const float sp = log1pf(__expf(-a.in[12][c]));
#pragma unroll
        for (int rt = 0; rt < 2; ++rt)
#pragma unroll
            for (int i = 0; i < 16; ++i) { const int tok = 32 * rt + crow(i, hh);
                const float r = sigm(Rr[rt][i] + rb), ig = sigm(Ii[rt][i] + ib);
                const float la = -8.f * r * sp; const float av = __expf(la); const float x2 = 2.f * la;
                const float ser = -x2 * (1.f + 0.5f * x2 * (1.f + (1.f / 3.f) * x2 * (1.f + 0.25f * x2 * (1.f + 0.2f * x2 * (1.f + (1.f / 6.f) * x2)))));
                const float om = (x2 > -0.25f) ? ser : (1.f - av * av); const float mult = __builtin_amdgcn_sqrtf(om);
                const float xv = bf2f(XC[tok * XP + c]);
                Rr[rt][i] = av; Ii[rt][i] = mult * ig * xv; if ((i & 3) == 3) __builtin_amdgcn_sched_barrier(0); }
        float Ag[8], Bg[8], Ao[8], Bo[8];
#pragma unroll
        for (int rt = 0; rt < 2; ++rt)
#pragma unroll
            for (int k = 0; k < 4; ++k) { float A = 1.f, Bv = 0.f;
#pragma unroll
                for (int e = 0; e < 4; ++e) { const float av = Rr[rt][4 * k + e]; Bv = av * Bv + Ii[rt][4 * k + e]; A *= av; }
                Ag[rt * 4 + k] = A; Bg[rt * 4 + k] = Bv; }
#pragma unroll
        for (int q = 0; q < 8; ++q) { Ao[q] = __shfl_xor(Ag[q], 32); Bo[q] = __shfl_xor(Bg[q], 32); }
        float h = (PASS == 2) ? CAR[c] : 0.f;
        float hs[8]; float Atot = 1.f;
#pragma unroll
        for (int q = 0; q < 8; ++q) {
            const float A1 = hh ? Ao[q] : Ag[q], B1 = hh ? Bo[q] : Bg[q], A2 = hh ? Ag[q] : Ao[q], B2 = hh ? Bg[q] : Bo[q];
            const float h1 = A1 * h + B1; hs[q] = hh ? h1 : h; h = A2 * h1 + B2; Atot *= A1 * A2; }
        if (PASS == 1) { if (hh == 0) { f32x2 o; o.x = Atot; o.y = h; *(f32x2*)(SUM + ((size_t)(b * 128 + ch) * 512 + c) * 2) = o; } }
        else {
#pragma unroll
            for (int rt = 0; rt < 2; ++rt)
#pragma unroll
                for (int k = 0; k < 4; ++k) { float hc = hs[rt * 4 + k];
#pragma unroll
                    for (int e = 0; e < 4; ++e) { const int i = 4 * k + e; hc = Rr[rt][i] * hc + Ii[rt][i]; HB[(32 * rt + 8 * k + 4 * hh + e) * XP + c] = (bf16)f2bf(hc); } }
        }
    }
    __syncthreads();
    if (PASS == 2) {
#pragma unroll
        for (int i = 0; i < 8; ++i) { const int idx = tid + 512 * i, tok = idx >> 6, c8 = idx & 63;
            const u32x4 hv = *(const LAS u32x4*)(HB + tok * XP + 8 * c8); const u32x4 gv = *(const u32x4*)(PROJ + (m0 + tok) * NP + 512 + 8 * c8);
            u32x4 o;
#pragma unroll
            for (int e = 0; e < 4; ++e) o[e] = pk2(bflo(hv[e]) * silu(bflo(gv[e])), bfhi(hv[e]) * silu(bfhi(gv[e])));
            *(u32x4*)(MIX + (m0 + tok) * 1024 + 8 * c8) = o; }
        __syncthreads();
    }
}

template <int LAYER>
DI void prep_item(const Args& a, LAS unsigned char* lds, int item, int tid) {
    unsigned char* ws = a.ws;
    bf16* PROJ = (bf16*)(ws + WS_PROJ); bf16* VF = (bf16*)(ws + WS_VT); bf16* KF = (bf16*)(ws + WS_KF);
    constexpr int qoff = LAYER ? 0 : 1024, koff = LAYER ? 512 : 1536, voff = LAYER ? 1024 : 2048;
    const float* qg = LAYER ? a.in[20] : a.in[13]; const float* kg = LAYER ? a.in[21] : a.in[14];
    const int h = item & 7, n = (item >> 3) & 31, b = item >> 8;
    LAS bf16* VL = (LAS bf16*)lds; LAS float* RED = (LAS float*)(lds + 40960);
    const int c8 = tid & 7, r0 = tid >> 3;
    float qgv[8], kgv[8], ksum[8];
#pragma unroll
    for (int e = 0; e < 8; ++e) { qgv[e] = qg[8 * c8 + e]; kgv[e] = kg[8 * c8 + e]; ksum[e] = 0.f; }
    u32x4 lq[4], lk[4], lv[4];
#pragma unroll
    for (int i = 0; i < 4; ++i) { const bf16* base = PROJ + ((size_t)b * T + 256 * n + r0 + 64 * i) * NP + 64 * h + 8 * c8; lq[i] = *(const u32x4*)(base + qoff); lk[i] = __builtin_nontemporal_load((const u32x4*)(base + koff)); lv[i] = __builtin_nontemporal_load((const u32x4*)(base + voff)); }
#pragma unroll
    for (int i = 0; i < 4; ++i) {
        const int row = r0 + 64 * i; bf16* base = PROJ + ((size_t)b * T + 256 * n + row) * NP + 64 * h + 8 * c8;
        {   u32x4 v = lq[i]; float f[8];
#pragma unroll
            for (int e = 0; e < 4; ++e) { f[2 * e] = bflo(v[e]); f[2 * e + 1] = bfhi(v[e]); }
            float ss = 0.f;
#pragma unroll
            for (int e = 0; e < 8; ++e) ss += f[e] * f[e];
            ss += __shfl_xor(ss, 1); ss += __shfl_xor(ss, 2); ss += __shfl_xor(ss, 4);
            const float rstd = rsqrtf(ss * (1.f / 64.f) + 1e-6f);
#pragma unroll
            for (int e = 0; e < 8; ++e) f[e] = f[e] * rstd * qgv[e];
            u32x4 o; o.x = pk2(f[0], f[1]); o.y = pk2(f[2], f[3]); o.z = pk2(f[4], f[5]); o.w = pk2(f[6], f[7]); *(u32x4*)(base + qoff) = o; }
        {   u32x4 v = lk[i]; float f[8];
#pragma unroll
            for (int e = 0; e < 4; ++e) { f[2 * e] = bflo(v[e]); f[2 * e + 1] = bfhi(v[e]); }
            float ss = 0.f;
#pragma unroll
            for (int e = 0; e < 8; ++e) ss += f[e] * f[e];
            ss += __shfl_xor(ss, 1); ss += __shfl_xor(ss, 2); ss += __shfl_xor(ss, 4);
            const float rstd = rsqrtf(ss * (1.f / 64.f) + 1e-6f);
#pragma unroll
            for (int e = 0; e < 8; ++e) { f[e] = f[e] * rstd * kgv[e]; ksum[e] += f[e]; }
            u32x4 o; o.x = pk2(f[0], f[1]); o.y = pk2(f[2], f[3]); o.z = pk2(f[4], f[5]); o.w = pk2(f[6], f[7]);
            *(u32x4*)(KF + ((((size_t)(b * 8 + h) * 256 + 8 * n + (row >> 5)) * 4 + (c8 >> 1)) * 64 + (c8 & 1) * 32 + (row & 31)) * 8) = o; }
        *(LAS u32x4*)(VL + row * 72 + 8 * c8) = lv[i];
    }
    if (LAYER == 0) {
#pragma unroll
        for (int e = 0; e < 8; ++e) RED[r0 * 64 + 8 * c8 + e] = ksum[e]; }
    __syncthreads();
    if (LAYER == 0 && tid < 64) { float s = 0.f;
        for (int r = 0; r < 64; ++r) s += RED[r * 64 + tid];
        ((float*)(ws + WS_KMEAN))[((size_t)(b * 8 + h) * 32 + n) * 64 + tid] = s * (1.f / 256.f); }
#pragma unroll
    for (int i = 0; i < 4; ++i) { const int idx = tid + 512 * i, ln = idx & 63, s = (idx >> 6) & 1, dt = (idx >> 7) & 1, kt = idx >> 8, l31 = ln & 31, hh = ln >> 5;
        const LAS bf16* vp = VL + (32 * kt + 16 * s + 4 * hh) * 72 + 32 * dt + l31;
        const unsigned short e0 = vp[0], e1 = vp[72], e2 = vp[144], e3 = vp[216], e4 = vp[8 * 72], e5 = vp[9 * 72], e6 = vp[10 * 72], e7 = vp[11 * 72];
        u32x4 o; o.x = e0 | ((unsigned)e1 << 16); o.y = e2 | ((unsigned)e3 << 16); o.z = e4 | ((unsigned)e5 << 16); o.w = e6 | ((unsigned)e7 << 16);
        *(u32x4*)(VF + (((((size_t)(b * 8 + h) * 256 + 8 * n + kt) * 2 + dt) * 2 + s) * 64 + ln) * 8) = o; }
    __syncthreads();
}

DI void moba_item(const Args& a, LAS unsigned char* lds, int item, int tid, int lane, int wave) {
    unsigned char* ws = a.ws;
    const bf16* PROJ = (const bf16*)(ws + WS_PROJ); const bf16* VT = (const bf16*)(ws + WS_VT); bf16* MIX = (bf16*)(ws + WS_MIX);
    const int bh = item & 31, m = item >> 5, b = bh >> 3, h = bh & 7;
    constexpr int QP = 72, SP = 68;
    LAS bf16* QS = (LAS bf16*)lds;
    LAS bf16* SLAB = (LAS bf16*)(lds + 36864);
    LAS float* KM = (LAS float*)(lds + 36864);
    LAS float* SL = (LAS float*)(lds + 141312);
    LAS unsigned short* LISTQ = (LAS unsigned short*)(lds + 144384);
    LAS unsigned short* SELROW = (LAS unsigned short*)(lds + 145920);
    LAS int* CNT = (LAS int*)(lds + 147968);
    LAS int* OFF = (LAS int*)(lds + 148096);
    LAS unsigned short* TILES = (LAS unsigned short*)(lds + 148224);
    LAS int* NTL = (LAS int*)(lds + 148352);
    const size_t mq0 = (size_t)b * T + 256 * m;
    {   const int row = tid >> 1, half = tid & 1; const bf16* src = PROJ + (mq0 + row) * NP + 1024 + 64 * h + 32 * half;
#pragma unroll
        for (int i = 0; i < 4; ++i) { const u32x4 v = *(const u32x4*)(src + 8 * i); u32x4 o;
#pragma unroll
            for (int e = 0; e < 4; ++e) o[e] = pk2(bflo(v[e]) * (0.125f * 1.4426950408889634f), bfhi(v[e]) * (0.125f * 1.4426950408889634f));
            *(LAS u32x4*)(QS + row * QP + 32 * half + 8 * i) = o; } }
    {   const float* km = (const float*)(ws + WS_KMEAN) + (size_t)(b * 8 + h) * 2048;
        for (int i = tid; i < m * 64; i += NTHR) KM[i] = km[i]; }
    if (tid < 32) CNT[tid] = 0;
    __syncthreads();
    int i0 = 255, i1 = 255, i2 = 255, ps0 = 0, ps1 = 0, ps2 = 0;
    if (tid < 256 && m > 0) {
        float q[64];
#pragma unroll
        for (int i = 0; i < 8; ++i) { const u32x4 v = *(const LAS u32x4*)(QS + tid * QP + 8 * i);
#pragma unroll
            for (int e = 0; e < 4; ++e) { q[8 * i + 2 * e] = bflo(v[e]); q[8 * i + 2 * e + 1] = bfhi(v[e]); } }
        float v0 = -INFINITY, v1 = -INFINITY, v2 = -INFINITY;
        for (int n = 0; n < m; ++n) { float dot = 0.f;
#pragma unroll
            for (int d4 = 0; d4 < 16; ++d4) { const f32x4 kv = *(const LAS f32x4*)(KM + n * 64 + 4 * d4); dot += q[4 * d4] * kv.x + q[4 * d4 + 1] * kv.y + q[4 * d4 + 2] * kv.z + q[4 * d4 + 3] * kv.w; }
            if (dot > v0) { v2 = v1; i2 = i1; v1 = v0; i1 = i0; v0 = dot; i0 = n; }
            else if (dot > v1) { v2 = v1; i2 = i1; v1 = dot; i1 = n; }
            else if (dot > v2) { v2 = dot; i2 = n; } }
        if (i0 != 255) ps0 = __hip_atomic_fetch_add(CNT + i0, 1, __ATOMIC_RELAXED, __HIP_MEMORY_SCOPE_WORKGROUP);
        if (i1 != 255) ps1 = __hip_atomic_fetch_add(CNT + i1, 1, __ATOMIC_RELAXED, __HIP_MEMORY_SCOPE_WORKGROUP);
        if (i2 != 255) ps2 = __hip_atomic_fetch_add(CNT + i2, 1, __ATOMIC_RELAXED, __HIP_MEMORY_SCOPE_WORKGROUP);
    }
    __syncthreads();
    if (tid < 64) {
        const int c = (lane < m) ? CNT[lane] : 0, ntile = (c + 31) >> 5;
        int pc = c, ptile = ntile;
#pragma unroll
        for (int o = 1; o < 32; o <<= 1) { const int uc = __shfl_up(pc, o), ut = __shfl_up(ptile, o); if ((lane & 31) >= o) { pc += uc; ptile += ut; } }
        if (lane < 32) { OFF[lane] = pc - c; for (int qt = 0; qt < ntile; ++qt) TILES[ptile - ntile + qt] = (unsigned short)(lane | (qt << 8)); if (lane == 31) NTL[0] = ptile; }
    }
    __syncthreads();
    if (tid < 256) {
        unsigned short r0 = 0xffff, r1 = 0xffff, r2 = 0xffff;
        if (i0 != 255) { r0 = (unsigned short)(OFF[i0] + ps0); LISTQ[r0] = (unsigned short)tid; }
        if (i1 != 255) { r1 = (unsigned short)(OFF[i1] + ps1); LISTQ[r1] = (unsigned short)tid; }
        if (i2 != 255) { r2 = (unsigned short)(OFF[i2] + ps2); LISTQ[r2] = (unsigned short)tid; }
        SELROW[tid * 4] = r0; SELROW[tid * 4 + 1] = r1; SELROW[tid * 4 + 2] = r2;
    }
    __syncthreads();
    const float cb2 = ((const float*)(ws + WS_MOD))[2 * 4 * 3072] * 1.4426950408889634f;
    f32x16 sinit;
#pragma unroll
    for (int i = 0; i < 16; ++i) sinit[i] = -cb2;
    const int hh = lane >> 5, l31 = lane & 31, w = wave;
    const bf16* Kb = (const bf16*)(ws + WS_KF) + ((size_t)(b * 8 + h) * 256 * 4 * 64 + lane) * 8;
    const bf16* Vb = VT + ((size_t)(b * 8 + h) * 256 * 4 * 64 + lane) * 8;
    const int nt = NTL[0];
#define MOBA_LOADKV(AK, AV, key0) do { const size_t kt_ = (size_t)((key0) >> 5) * 2048; \
    _Pragma("unroll") for (int s = 0; s < 4; ++s) AK[s] = mk8(*(const u32x4*)(Kb + kt_ + s * 512)); \
    _Pragma("unroll") for (int dt = 0; dt < 2; ++dt) _Pragma("unroll") for (int s = 0; s < 2; ++s) AV[dt][s] = mk8(*(const u32x4*)(Vb + kt_ + (dt * 2 + s) * 512)); } while (0)
    for (int t = w; t < nt; t += 8) {
        const int tl = TILES[t], n = tl & 255, qt = tl >> 8, cnt = CNT[n], rowb = OFF[n] + 32 * qt;
        const bool valid = (32 * qt + l31) < cnt; const int qrow = valid ? (int)LISTQ[rowb + l31] : 0;
        bf16x8 bq[4];
#pragma unroll
        for (int s = 0; s < 4; ++s) bq[s] = *(const LAS bf16x8*)(QS + qrow * QP + 16 * s + 8 * hh);
        f32x16 o0 = zero16(), o1 = zero16(); f32x2 ls2; ls2.x = 0.f; ls2.y = 0.f;
        bf16x8 ak[4], av[2][2], akn[4], avn[2][2];
        MOBA_LOADKV(ak, av, 256 * n);
#define MOBA_STEP(AK, AV, AKN, AVN, knext) do { \
            MOBA_LOADKV(AKN, AVN, knext); \
            f32x16 sacc = sinit; \
            _Pragma("unroll") for (int s = 0; s < 4; ++s) sacc = MFMA32(AK[s], bq[s], sacc); \
            _Pragma("unroll") for (int i = 0; i < 16; i += 2) { f32x2 p2; p2.x = __builtin_amdgcn_exp2f(sacc[i]); p2.y = __builtin_amdgcn_exp2f(sacc[i + 1]); sacc[i] = p2.x; sacc[i + 1] = p2.y; ls2 += p2; } \
            const bf16x8 p0 = pack8(sacc[0], sacc[1], sacc[2], sacc[3], sacc[4], sacc[5], sacc[6], sacc[7]); \
            const bf16x8 p1 = pack8(sacc[8], sacc[9], sacc[10], sacc[11], sacc[12], sacc[13], sacc[14], sacc[15]); \
            o0 = MFMA32(AV[0][0], p0, o0); o0 = MFMA32(AV[0][1], p1, o0); o1 = MFMA32(AV[1][0], p0, o1); o1 = MFMA32(AV[1][1], p1, o1); } while (0)
#pragma unroll 1
        for (int ks = 0; ks < 8; ks += 2) {
            MOBA_STEP(ak, av, akn, avn, 256 * n + 32 * (ks + 1));
            MOBA_STEP(akn, avn, ak, av, 256 * n + 32 * (ks < 6 ? ks + 2 : ks + 1));
        }
        float lsum = ls2.x + ls2.y;
        lsum += __shfl_xor(lsum, 32);
        if (valid) {
            LAS bf16* sr = SLAB + (rowb + l31) * SP + 4 * hh;
#pragma unroll
            for (int k = 0; k < 4; ++k) { u32x2 wv; wv.x = pk2(o0[4 * k], o0[4 * k + 1]); wv.y = pk2(o0[4 * k + 2], o0[4 * k + 3]); *(LAS u32x2*)(sr + 8 * k) = wv;
                u32x2 wu; wu.x = pk2(o1[4 * k], o1[4 * k + 1]); wu.y = pk2(o1[4 * k + 2], o1[4 * k + 3]); *(LAS u32x2*)(sr + 32 + 8 * k) = wu; }
            if (hh == 0) SL[rowb + l31] = lsum;
        }
    }
    f32x16 o0 = zero16(), o1 = zero16(); float lsum = 0.f;
    {
        const int qrow = 32 * w + l31;
        bf16x8 bq[4];
#pragma unroll
        for (int s = 0; s < 4; ++s) bq[s] = *(const LAS bf16x8*)(QS + qrow * QP + 16 * s + 8 * hh);
        bf16x8 ak[4], av[2][2], akn[4], avn[2][2];
        MOBA_LOADKV(ak, av, 256 * m);
#pragma unroll 1
        for (int ks = 0; ks <= w; ++ks) {
            const int kn = 256 * m + 32 * (ks < w ? ks + 1 : ks);
            MOBA_LOADKV(akn, avn, kn);
            f32x16 sacc = sinit;
#pragma unroll
            for (int s = 0; s < 4; ++s) sacc = MFMA32(ak[s], bq[s], sacc);
#pragma unroll
            for (int i = 0; i < 16; ++i) { float p = __builtin_amdgcn_exp2f(sacc[i]); if (ks == w && crow(i, hh) > l31) p = 0.f; sacc[i] = p; lsum += p; }
            const bf16x8 p0 = pack8(sacc[0], sacc[1], sacc[2], sacc[3], sacc[4], sacc[5], sacc[6], sacc[7]);
            const bf16x8 p1 = pack8(sacc[8], sacc[9], sacc[10], sacc[11], sacc[12], sacc[13], sacc[14], sacc[15]);
            o0 = MFMA32(av[0][0], p0, o0); o0 = MFMA32(av[0][1], p1, o0); o1 = MFMA32(av[1][0], p0, o1); o1 = MFMA32(av[1][1], p1, o1);
#pragma unroll
            for (int s = 0; s < 4; ++s) ak[s] = akn[s];
#pragma unroll
            for (int dt = 0; dt < 2; ++dt) { av[dt][0] = avn[dt][0]; av[dt][1] = avn[dt][1]; }
        }
        lsum += __shfl_xor(lsum, 32);
    }
    __syncthreads();
    {
        const int qrow = 32 * w + l31;
#pragma unroll
        for (int j = 0; j < 3; ++j) { const int r = SELROW[qrow * 4 + j];
            if (r != 0xffff) { lsum += SL[r]; const LAS bf16* sr = SLAB + r * SP + 4 * hh;
#pragma unroll
                for (int k = 0; k < 4; ++k) { const u32x2 u0 = *(const LAS u32x2*)(sr + 8 * k), u1 = *(const LAS u32x2*)(sr + 32 + 8 * k);
                    o0[4 * k] += bflo(u0.x); o0[4 * k + 1] += bfhi(u0.x); o0[4 * k + 2] += bflo(u0.y); o0[4 * k + 3] += bfhi(u0.y);
                    o1[4 * k] += bflo(u1.x); o1[4 * k + 1] += bfhi(u1.x); o1[4 * k + 2] += bflo(u1.y); o1[4 * k + 3] += bfhi(u1.y); } } }
        const float inv = 1.f / lsum;
        LAS bf16* sl = QS + (32 * w) * QP;
#pragma unroll
        for (int dt = 0; dt < 2; ++dt)
#pragma unroll
            for (int k = 0; k < 4; ++k) { const f32x16& o = dt ? o1 : o0; u32x2 wv; wv.x = pk2(o[4 * k] * inv, o[4 * k + 1] * inv); wv.y = pk2(o[4 * k + 2] * inv, o[4 * k + 3] * inv);
                *(LAS u32x2*)(sl + l31 * QP + 32 * dt + 8 * k + 4 * hh) = wv; }
#pragma unroll
        for (int i = 0; i < 4; ++i) { const int c = lane + 64 * i, row = c >> 3, part = c & 7;
            const u32x4 ov = *(const LAS u32x4*)(sl + row * QP + 8 * part); const u32x4 gv = *(const u32x4*)(PROJ + (mq0 + 32 * w + row) * NP + 2560 + 64 * h + 8 * part);
            u32x4 wv;
#pragma unroll
            for (int e = 0; e < 4; ++e) wv[e] = pk2(bflo(ov[e]) * silu(bflo(gv[e])), bfhi(ov[e]) * silu(bfhi(gv[e])));
            *(u32x4*)(MIX + (mq0 + 32 * w + row) * 1024 + 512 + 64 * h + 8 * part) = wv; }
    }
    __syncthreads();
#undef MOBA_LOADKV
#undef MOBA_STEP
}

DI void sb_item(const Args& a, LAS unsigned char* slab, int item, int lane) {
    unsigned char* ws = a.ws;
    const bf16* PROJ = (const bf16*)(ws + WS_PROJ); const bf16* VT = (const bf16*)(ws + WS_VT); const bf16* KF = (const bf16*)(ws + WS_KF); bf16* MIX = (bf16*)(ws + WS_MIX);
    const int qt = 255 - (item >> 5), bh = item & 31, b = bh >> 3, h = bh & 7;
    const int hh = lane >> 5, l31 = lane & 31;
    const size_t mq = (size_t)b * T + 32 * qt + l31;
    bf16x8 bq[4];
#pragma unroll
    for (int s = 0; s < 4; ++s) bq[s] = mk8(*(const u32x4*)(PROJ + mq * NP + 64 * h + 16 * s + 8 * hh));
    f32x16 o0 = zero16(), o1 = zero16();
    float carry = 0.f;
    const size_t kfb = (size_t)(b * 8 + h) * 256 * 2048 + lane * 8;
#define SB_LOADKV(AK, AV, kt_) do { const size_t kb_ = kfb + (size_t)(kt_) * 2048; \
    _Pragma("unroll") for (int s = 0; s < 4; ++s) AK[s] = mk8(*(const u32x4*)(KF + kb_ + s * 512)); \
    _Pragma("unroll") for (int dt = 0; dt < 2; ++dt) _Pragma("unroll") for (int s = 0; s < 2; ++s) AV[dt][s] = mk8(*(const u32x4*)(VT + kb_ + (dt * 2 + s) * 512)); } while (0)
    bf16x8 ak[4], av[2][2], akn[4], avn[2][2];
    SB_LOADKV(ak, av, qt);
#pragma unroll 1
    for (int kt = qt; kt >= 0; --kt) {
        SB_LOADKV(akn, avn, (kt > 0 ? kt - 1 : 0));
        f32x16 z = zero16();
#pragma unroll
        for (int s = 0; s < 4; ++s) z = MFMA32(ak[s], bq[s], z);
        float kp[16], bt[16];
        if (kt == qt) {
#pragma unroll
            for (int i = 0; i < 16; ++i) { const float zz = __builtin_amdgcn_fmed3f(z[i] * 0.125f, -80.f, 80.f); const bool strict = crow(i, hh) < l31;
                const float t = __expf(-zz), r = __builtin_amdgcn_rcpf(1.f + t);
                kp[i] = strict ? t * r : 1.f; bt[i] = strict ? r : 0.f; }
        } else {
#pragma unroll
            for (int i = 0; i < 16; ++i) { const float zz = __builtin_amdgcn_fmed3f(z[i] * 0.125f, -80.f, 80.f);
                const float t = __expf(-zz), r = __builtin_amdgcn_rcpf(1.f + t);
                kp[i] = t * r; bt[i] = r; }
        }
        float gs[4], go[4];
#pragma unroll
        for (int k = 0; k < 4; ++k) { gs[k] = (kp[4 * k] * kp[4 * k + 1]) * (kp[4 * k + 2] * kp[4 * k + 3]); go[k] = __shfl_xor(gs[k], 32); }
        float after[4]; float run = 1.f;
#pragma unroll
        for (int k = 3; k >= 0; --k) { after[k] = hh ? run : run * go[k]; run *= gs[k] * go[k]; }
        const float base = __expf(carry);
        float wv[16];
#pragma unroll
        for (int k = 0; k < 4; ++k) { float suf = base * after[k];
#pragma unroll
            for (int e = 3; e >= 0; --e) { wv[4 * k + e] = bt[4 * k + e] * suf; suf *= kp[4 * k + e]; } }
        carry += __logf(run);
        const bf16x8 p0 = pack8(wv[0], wv[1], wv[2], wv[3], wv[4], wv[5], wv[6], wv[7]);
        const bf16x8 p1 = pack8(wv[8], wv[9], wv[10], wv[11], wv[12], wv[13], wv[14], wv[15]);
        o0 = MFMA32(av[0][0], p0, o0); o0 = MFMA32(av[0][1], p1, o0);
        o1 = MFMA32(av[1][0], p0, o1); o1 = MFMA32(av[1][1], p1, o1);
        if (__all(carry < -104.f)) break;
#pragma unroll
        for (int s = 0; s < 4; ++s) ak[s] = akn[s];
#pragma unroll
        for (int dt = 0; dt < 2; ++dt) { av[dt][0] = avn[dt][0]; av[dt][1] = avn[dt][1]; }
    }
#undef SB_LOADKV
    {
        LAS bf16* sl = (LAS bf16*)slab;
#pragma unroll
        for (int dt = 0; dt < 2; ++dt)
#pragma unroll
            for (int k = 0; k < 4; ++k) { const f32x16& o = dt ? o1 : o0; u32x2 w; w.x = pk2(o[4 * k], o[4 * k + 1]); w.y = pk2(o[4 * k + 2], o[4 * k + 3]);
                *(LAS u32x2*)(sl + l31 * 72 + 32 * dt + 8 * k + 4 * hh) = w; }
        const size_t mb = (size_t)b * T + 32 * qt;
#pragma unroll
        for (int i = 0; i < 4; ++i) { const int c = lane + 64 * i, row = c >> 3, part = c & 7;
            const u32x4 ov = *(const LAS u32x4*)(sl + row * 72 + 8 * part); const u32x4 gv = *(const u32x4*)(PROJ + (mb + row) * NP + 1536 + 64 * h + 8 * part);
            u32x4 w;
#pragma unroll
            for (int e = 0; e < 4; ++e) w[e] = pk2(bflo(ov[e]) * silu(bflo(gv[e])), bfhi(ov[e]) * silu(bfhi(gv[e])));
            *(u32x4*)(MIX + (mb + row) * 1024 + 64 * h + 8 * part) = w; }
    }
}

DI void s5_pass1(const Args& a, LAS unsigned char* lds, int item, int tid, int lane, int wave) {
    unsigned char* ws = a.ws;
    const bf16* PROJ = (const bf16*)(ws + WS_PROJ); float* S5S = (float*)(ws + WS_S5S);
    const int g = item & 31, b = (item >> 5) & 3, ct = item >> 7;
    const int rt = wave & 3, kh = wave >> 2, hh = lane >> 5, l31 = lane & 31;
    constexpr int UP = 2064;
    LAS unsigned char* UL = lds + 16384;
#pragma unroll
    for (int i = 0; i < 8; ++i) { const int idx = tid + 512 * i, tok = idx >> 1, hf = idx & 1;
        const u32x4 v = *(const u32x4*)(PROJ + ((size_t)b * T + 2048 * ct + tok) * NP + 2048 + 16 * g + 8 * hf);
        *(LAS u32x4*)(UL + (tok >> 6) * UP + (tok & 63) * 32 + 16 * hf) = v; }
    __syncthreads();
    const unsigned char* vb = ws + WS_VBIG + ((size_t)((g * 4 + rt) * 64) * 64 + lane) * 16;
    f32x16 acc = zero16();
#pragma unroll 4
    for (int s = 32 * kh; s < 32 * kh + 32; ++s) { const bf16x8 A = mk8(*(const u32x4*)(vb + (size_t)s * 1024)); const bf16x8 Bf = *(const LAS bf16x8*)(UL + l31 * UP + s * 32 + 16 * hh); acc = MFMA32(A, Bf, acc); }
    LAS float* red = (LAS float*)lds;
    if (kh == 1) {
#pragma unroll
        for (int i = 0; i < 16; ++i) red[(rt * 16 + i) * 64 + lane] = acc[i]; }
    __syncthreads();
    if (kh == 0) {
        float* dst = S5S + ((size_t)((b * 32 + g) * 128 + 32 * ct + l31)) * 128 + 32 * rt;
#pragma unroll
        for (int k = 0; k < 4; ++k) { f32x4 o;
#pragma unroll
            for (int e = 0; e < 4; ++e) o[e] = acc[4 * k + e] + red[(rt * 16 + 4 * k + e) * 64 + lane];
            *(f32x4*)(dst + 8 * k + 4 * hh) = o; } }
    __syncthreads();
}
DI void s5_pass2(const Args& a, LAS unsigned char* lds, int item, int tid, int lane, int wave) {
    unsigned char* ws = a.ws;
    const bf16* PROJ = (const bf16*)(ws + WS_PROJ); const float* S5S = (const float*)(ws + WS_S5S); bf16* S5Y = (bf16*)(ws + WS_H);
    const int g = item & 31, b = (item >> 5) & 3, ct = item >> 7;
    constexpr int UP = 2064, XPP = 136;
    LAS unsigned char* FL = lds;
    LAS unsigned char* UL = lds + 65536;
    LAS bf16* XPl = (LAS bf16*)(lds + 65536 + 66048);
    {   const unsigned char* fsrc = ws + WS_F + (size_t)g * 65536;
#pragma unroll
        for (int i = 0; i < 8; ++i) { const int idx = tid + 512 * i; *(LAS u32x4*)(FL + idx * 16) = *(const u32x4*)(fsrc + (size_t)idx * 16); }
#pragma unroll
        for (int i = 0; i < 8; ++i) { const int idx = tid + 512 * i, tok = idx >> 1, half = idx & 1;
            const u32x4 v = __builtin_nontemporal_load((const u32x4*)(PROJ + ((size_t)b * T + 2048 * ct + tok) * NP + 2048 + 16 * g + 8 * half));
            *(LAS u32x4*)(UL + (tok >> 6) * UP + (tok & 63) * 32 + 16 * half) = v; } }
    {
        const int p = lane; const float ar = ((const float*)(ws + WS_ABL))[(g * 64 + p) * 2], ai = ((const float*)(ws + WS_ABL))[(g * 64 + p) * 2 + 1];
        const float* Sp = S5S + (size_t)((b * 32 + g) * 128) * 128;
        LAS float* SEG = (LAS float*)(lds + 65536 + 66048 + 8704);
        const int seg = 4 * ct;
        {   float xr = 0.f, xi = 0.f, qr = 1.f, qi = 0.f;
            for (int c = wave * seg; c < (wave + 1) * seg; ++c) { const float sr = Sp[c * 128 + p], si = Sp[c * 128 + 64 + p];
                const float nr = ar * xr - ai * xi + sr, ni = ar * xi + ai * xr + si; xr = nr; xi = ni; const float tr = qr * ar - qi * ai, ti = qr * ai + qi * ar; qr = tr; qi = ti; }
            SEG[(wave * 4 + 0) * 64 + p] = xr; SEG[(wave * 4 + 1) * 64 + p] = xi; SEG[(wave * 4 + 2) * 64 + p] = qr; SEG[(wave * 4 + 3) * 64 + p] = qi; }
        __syncthreads();
        if (wave == 0) {
            float xr = 0.f, xi = 0.f;
#pragma unroll
            for (int w = 0; w < 8; ++w) { const float sr = SEG[(w * 4 + 0) * 64 + p], si = SEG[(w * 4 + 1) * 64 + p], qr = SEG[(w * 4 + 2) * 64 + p], qi = SEG[(w * 4 + 3) * 64 + p];
                const float nr = qr * xr - qi * xi + sr, ni = qr * xi + qi * xr + si; xr = nr; xi = ni; }
#pragma unroll 8
            for (int n = 0; n < 32; ++n) { XPl[n * XPP + p] = (bf16)f2bf(xr); XPl[n * XPP + 64 + p] = (bf16)f2bf(xi);
                const int c = 32 * ct + n; const float sr = Sp[c * 128 + p], si = Sp[c * 128 + 64 + p]; const float nr = ar * xr - ai * xi + sr, ni = ar * xi + ai * xr + si; xr = nr; xi = ni; }
        }
    }
    __syncthreads();
    const int hh = lane >> 5, l31 = lane & 31;
    f32x16 acc[4];
#pragma unroll
    for (int i = 0; i < 4; ++i) acc[i] = zero16();
#define S5_SEG(I0, SLO, SHI) do { _Pragma("unroll 2") for (int s = (SLO); s <= (SHI); ++s) { \
        const bf16x8 Bf = *(const LAS bf16x8*)(UL + l31 * UP + s * 32 + 16 * hh); bf16x8 Af[4]; \
        _Pragma("unroll") for (int i = (I0); i < 4; ++i) Af[i] = *(const LAS bf16x8*)(FL + (2 * (wave + 8 * i) - s + 1) * 1024 + lane * 16); \
        _Pragma("unroll") for (int i = (I0); i < 4; ++i) acc[i] = MFMA32(Af[i], Bf, acc[i]); } } while (0)
    S5_SEG(0, 0, 2 * wave + 1);
    S5_SEG(1, 2 * wave + 2, 2 * wave + 17);
    S5_SEG(2, 2 * wave + 18, 2 * wave + 33);
    S5_SEG(3, 2 * wave + 34, 2 * wave + 49);
#undef S5_SEG
#pragma unroll
    for (int ks = 0; ks < 8; ++ks) { const bf16x8 Bf = *(const LAS bf16x8*)(XPl + l31 * XPP + 16 * ks + 8 * hh);
#pragma unroll
        for (int i = 0; i < 4; ++i) { const int R = wave + 8 * i;
            const bf16x8 A = mk8(*(const u32x4*)(ws + WS_WBIG + ((size_t)((g * 32 + R) * 8 + ks) * 64 + lane) * 16)); acc[i] = MFMA32(A, Bf, acc[i]); } }
#pragma unroll
    for (int i = 0; i < 4; ++i) { const int R = wave + 8 * i;
#pragma unroll
        for (int k = 0; k < 4; ++k) { const int jj = k >> 1; const size_t tok = (size_t)b * T + 2048 * ct + 64 * l31 + 2 * R + jj;
            u32x2 w; w.x = pk2(acc[i][4 * k], acc[i][4 * k + 1]); w.y = pk2(acc[i][4 * k + 2], acc[i][4 * k + 3]);
            *(u32x2*)(S5Y + tok * 512 + 16 * g + 8 * (k & 1) + 4 * hh) = w; } }
    __syncthreads();
}

__global__ void __launch_bounds__(NTHR, 2) hybrid_fwd(Args a) {
    extern __shared__ __attribute__((aligned(16))) unsigned char lds_raw[];
    LAS unsigned char* lds = (LAS unsigned char*)lds_raw;
    cg::grid_group grid = cg::this_grid();
    const int tid = threadIdx.x, lane = tid & 63, wave = __builtin_amdgcn_readfirstlane(tid >> 6);
    const int bx = blockIdx.x, G = gridDim.x, gw = bx * NWAVES + wave, NGW = G * NWAVES;
    unsigned char* ws = a.ws;
    const float* MOD = (const float*)(ws + WS_MOD);
    bf16* H = (bf16*)(ws + WS_H); bf16* PROJ = (bf16*)(ws + WS_PROJ); bf16* MIX = (bf16*)(ws + WS_MIX);

    if (tid < 4) ((LAS unsigned*)(lds + LDS_BYTES - 16))[tid] = 0u;
    __syncthreads();
    XcdBarrier xbar = xcd_barrier_post((unsigned*)ws, (volatile LAS unsigned*)(lds + LDS_BYTES - 16));
    phase0(a, lds, tid, lane, wave);
    xcd_barrier(xbar);
    norm_rows(a.in[0], a.in[2], MOD, H, gw, NGW, lane);
    __syncthreads();
    s5_tables(a, lds, bx * NTHR + tid, G * NTHR);
    {
        const bf16* WT = (const bf16*)(ws + WS_WIN1); float* SHW = (float*)(ws + WS_SHW);
        for (int col = gw; col < NP; col += NGW) {
            const u32x4 w0 = *(const u32x4*)(WT + (size_t)col * D + 16 * lane), w1 = *(const u32x4*)(WT + (size_t)col * D + 16 * lane + 8);
            float wf[16];
#pragma unroll
            for (int e = 0; e < 4; ++e) { wf[2 * e] = bflo(w0[e]); wf[2 * e + 1] = bfhi(w0[e]); wf[8 + 2 * e] = bflo(w1[e]); wf[8 + 2 * e + 1] = bfhi(w1[e]); }
#pragma unroll
            for (int b = 0; b < 4; ++b) { const float* sh = MOD + (4 + b) * 3072 + 16 * lane; float s = 0.f;
#pragma unroll
                for (int e = 0; e < 16; ++e) s += sh[e] * wf[e];
                s = wave_sum(s); if (lane == 0) SHW[b * 3072 + col] = s; } } }
    xcd_barrier(xbar);
    {   pg8::Gemm g{H, (const bf16*)(ws + WS_WIN0), M, NP, D}; pg8::StaticOrder S; S.init(M, NP, G, bx); pg8::EpiStore E{PROJ, NP};
        pg8::gemm_phase<pg8::EpiStore, pg8::StaticOrder, true, true>(lds, g, S, E); }
    xcd_barrier(xbar);
    for (int it = bx; it < 1024; it += G) prep_item<0>(a, lds, it, tid);
    for (int it = bx; it < 512; it += G) lru_item<1>(a, lds, it, tid, lane, wave);
    {
        const bf16* WT = (const bf16*)(ws + WS_WIN1); bf16* W1S = (bf16*)(ws + WS_W1S); const float* gain = a.in[16];
        for (int c = bx * NTHR + tid; c < 4 * 3072 * 128; c += G * NTHR) { const int b = c / (3072 * 128), rem = c % (3072 * 128), k8 = (rem & 127) * 8;
            const u32x4 wv = *(const u32x4*)(WT + (size_t)rem * 8); const float* sc = MOD + (4 + b) * 3072 + 1024 + k8; u32x4 o;
#pragma unroll
            for (int e = 0; e < 4; ++e) o[e] = pk2(bflo(wv[e]) * gain[k8 + 2 * e] * (1.f + sc[2 * e]), bfhi(wv[e]) * gain[k8 + 2 * e + 1] * (1.f + sc[2 * e + 1]));
            *(u32x4*)(W1S + (size_t)c * 8) = o; } }
    xcd_barrier(xbar);
    if (G == 256) {
        const int xcd = bx & 7, j = bx >> 3;
#pragma unroll 1
        for (int r = 0; r < 4; ++r) { const int bh = 4 * xcd + r, m = (r & 1) ? 31 - j : j; moba_item(a, lds, m * 32 + bh, tid, lane, wave); }
    } else {
#pragma unroll 1
        for (int it = bx; it < 1024; it += G) moba_item(a, lds, 1023 - it, tid, lane, wave);
    }
    for (int it = bx; it < 512; it += G) lru_item<2>(a, lds, it, tid, lane, wave);
    xcd_barrier(xbar);
    {   pg8::Gemm g{MIX, (const bf16*)(ws + WS_WOUT0), M, D, D}; pg8::StaticOrder S; S.init(M, D, G, bx);
        pg8::EpiRes1 E{a.in[0], MOD + 2048, (bf16*)(ws + WS_X1B), (float*)(ws + WS_SS)};
        pg8::gemm_phase<pg8::EpiRes1, pg8::StaticOrder, true, true>(lds, g, S, E); }
    xcd_barrier(xbar);
    {   pg8::Gemm g{(const bf16*)(ws + WS_X1B), (const bf16*)(ws + WS_W1S), M, NP, D, (size_t)3072 * 1024 * 2}; pg8::StaticOrder S; S.init(M, NP, G, bx); pg8::EpiStoreN E{PROJ, NP, (const float*)(ws + WS_SS), (const float*)(ws + WS_SHW)};
        pg8::gemm_phase<pg8::EpiStoreN, pg8::StaticOrder, true, true>(lds, g, S, E); }
    xcd_barrier(xbar);
    for (int it = bx; it < 1024; it += G) prep_item<1>(a, lds, it, tid);
    for (int it = bx; it < 512; it += G) s5_pass1(a, lds, it, tid, lane, wave);
    xcd_barrier(xbar);
    for (int it = bx; it < 512; it += G) s5_pass2(a, lds, it, tid, lane, wave);
    if (G == 256) {
#pragma unroll 1
        for (int k = 0; k < 4; ++k) { const int bh = (bx & 7) + 8 * k, qi = 8 * (bx >> 3) + wave; sb_item(a, lds + wave * 4608, (qi << 5) | bh, lane); }
    } else {
        for (int it = gw; it < 8192; it += NGW) sb_item(a, lds + wave * 4608, it, lane);
    }
    xcd_barrier(xbar);
    {   pg8::Gemm g{H, (const bf16*)(ws + WS_WGLU), M, 1024, 512}; pg8::StaticOrder S; S.init(M, 1024, G, bx); pg8::EpiGlu E{a.in[31], PROJ, MIX};
        pg8::gemm_phase<pg8::EpiGlu, pg8::StaticOrder, true, true>(lds, g, S, E); }
    xcd_barrier(xbar);
    {   pg8::Gemm g{MIX, (const bf16*)(ws + WS_WOUT1), M, D, D}; pg8::StaticOrder S; S.init(M, D, G, bx); pg8::EpiRes2 E{(const bf16*)(ws + WS_X1B), a.out, MOD + 4 * 3072 + 2048};
        pg8::gemm_phase<pg8::EpiRes2, pg8::StaticOrder, true, true>(lds, g, S, E); }
    if (gridDim.y == 0x7fffu) grid.sync();
}

extern "C" void kernel_launch(void* const* d_in, const int* in_sizes, int n_in, void* d_out, int out_size, void* d_ws, size_t ws_size, hipStream_t stream) {
    static int grid = 0;
    if (grid == 0) {
        if (n_in != 33 || out_size != M * D || ws_size < WS_END) { fprintf(stderr, "kernel_launch: unexpected shapes (n_in %d out %d ws %zu)\n", n_in, out_size, ws_size); grid = -1; return; }
        int dev = 0, cus = 0, per_cu = 0;
        hipGetDevice(&dev); hipDeviceGetAttribute(&cus, hipDeviceAttributeMultiprocessorCount, dev);
        hipFuncSetAttribute((const void*)hybrid_fwd, hipFuncAttributeMaxDynamicSharedMemorySize, LDS_BYTES);
        hipOccupancyMaxActiveBlocksPerMultiprocessor(&per_cu, (const void*)hybrid_fwd, NTHR, LDS_BYTES);
        if (per_cu < 1) per_cu = 1;
        grid = cus * per_cu; if (grid > 256) grid = 256;
        (void)hipGetLastError();
    }
    if (grid < 0) return;
    if (hipMemsetAsync(d_ws, 0, 262144, stream) != hipSuccess) { fprintf(stderr, "kernel_launch: memset failed\n"); return; }
    Args a{};
    for (int i = 0; i < 33; ++i) a.in[i] = (const float*)d_in[i];
    a.out = (float*)d_out; a.ws = (unsigned char*)d_ws;
    void* args[] = {&a};
    hipError_t e = hipLaunchCooperativeKernel((const void*)hybrid_fwd, dim3(grid), dim3(NTHR), args, LDS_BYTES, stream);
    if (e != hipSuccess) fprintf(stderr, "cooperative launch failed: %s (grid %d)\n", hipGetErrorString(e), grid);
}
```
